# Optimizing an MI355X kernel written in HIP

```python
import jax, jax.numpy as jnp
from jax import lax
import numpy as np

D_MODEL = 2048
BATCH = 8
SEQ = 2048
DEPTH = 2

GRID_W = 64
CTX_LEN = 256
N_MIXERS = 2
N_POOL_LAYERS = (DEPTH + N_MIXERS - 1) // N_MIXERS
N_MLA_LAYERS = DEPTH // N_MIXERS
POOL_WIDTH = D_MODEL
POOL_GROUPS = 4
POOL_GROUP_DIM = POOL_WIDTH // POOL_GROUPS
POOL_WINDOWS = (2, 4, 8, 16)
MLA_HEADS = 16
Q_LORA_RANK = 512
KV_LORA_RANK = 512
QK_NOPE_DIM = 128
QK_ROPE_DIM = 64
V_HEAD_DIM = 128
MLA_WIDTH = MLA_HEADS * V_HEAD_DIM
MLA_IN_WIDTH = Q_LORA_RANK + KV_LORA_RANK + QK_ROPE_DIM + MLA_WIDTH
MLA_SCALE = (QK_NOPE_DIM + QK_ROPE_DIM) ** -0.5
ROPE_BASE = 10000.0
Q_BLOCK = 128
NORM_EPS = 1e-6

kernel_name = "hybrid_pool_mla_dit_prefix"


def rms_norm(x, g):
    xf = x.astype(jnp.float32)
    y = xf * lax.rsqrt(jnp.mean(xf * xf, axis=-1, keepdims=True) + NORM_EPS)
    return (y * g.astype(jnp.float32)).astype(x.dtype)


def centred_multiscale_pool(u):
    L = u.shape[1]
    uf = u.astype(jnp.float32)
    cs = jnp.concatenate([jnp.zeros_like(uf[:, :1]), jnp.cumsum(uf, axis=1)], axis=1)
    win = jnp.array(POOL_WINDOWS, dtype=jnp.int32)
    left = win // 2
    right = win - 1 - left
    t = jnp.arange(L, dtype=jnp.int32)[:, None]
    hi = jnp.minimum(t + right + 1, L)
    lo = jnp.maximum(t - left, 0)
    g = jnp.arange(POOL_GROUPS, dtype=jnp.int32)[None, :]
    s = cs[:, hi, g] - cs[:, lo, g]
    mean = s / (hi - lo).astype(jnp.float32)[None, :, :, None]
    return (mean - uf).astype(u.dtype)


def pool_branch(h, w_in, w_grp, b_grp, scale, w_out):
    B, L, _ = h.shape
    u, gate = jnp.split(h @ w_in, 2, axis=-1)
    p = centred_multiscale_pool(u.reshape(B, L, POOL_GROUPS, POOL_GROUP_DIM))
    p = jnp.einsum('blgc,gcd->blgd', p, w_grp) + b_grp
    y = p.reshape(B, L, POOL_WIDTH) * scale
    return (y * jax.nn.silu(gate)) @ w_out


def axial_rope_tables(L):
    rows = L // GRID_W
    row = jnp.repeat(jnp.arange(rows, dtype=jnp.float32), GRID_W)
    col = jnp.tile(jnp.arange(GRID_W, dtype=jnp.float32), rows)
    n = QK_ROPE_DIM // 4
    freqs = ROPE_BASE ** (-jnp.arange(n, dtype=jnp.float32) / n)
    ang = jnp.stack([row[:, None] * freqs, col[:, None] * freqs], axis=1)
    return jnp.cos(ang), jnp.sin(ang)


def apply_axial_rope(x, cos, sin):
    xs = x.reshape(x.shape[:-1] + (2, 2, QK_ROPE_DIM // 4))
    x1, x2 = xs[..., 0, :], xs[..., 1, :]
    cos = cos.astype(x.dtype)
    sin = sin.astype(x.dtype)
    out = jnp.stack([x1 * cos - x2 * sin, x1 * sin + x2 * cos], axis=-2)
    return out.reshape(x.shape)


def mla_project(h, w_in, q_norm, kv_norm, w_uq, w_ukv, rope):
    B, L, _ = h.shape
    proj = h @ w_in
    c_q, c_kv, k_r, gate = jnp.split(
        proj, [Q_LORA_RANK, Q_LORA_RANK + KV_LORA_RANK, Q_LORA_RANK + KV_LORA_RANK + QK_ROPE_DIM], axis=-1)
    q = (rms_norm(c_q, q_norm) @ w_uq).reshape(B, L, MLA_HEADS, QK_NOPE_DIM + QK_ROPE_DIM)
    q_nope, q_rope = q[..., :QK_NOPE_DIM], q[..., QK_NOPE_DIM:]
    kv = (rms_norm(c_kv, kv_norm) @ w_ukv).reshape(B, L, MLA_HEADS, QK_NOPE_DIM + V_HEAD_DIM)
    k_nope, v = kv[..., :QK_NOPE_DIM], kv[..., QK_NOPE_DIM:]
    if rope is not None:
        cos, sin = rope
        q_rope = apply_axial_rope(q_rope, cos[:, None], sin[:, None])
        k_r = apply_axial_rope(k_r, cos, sin)
    return q_nope, q_rope, k_nope, k_r, v, gate


def mla_attend(q_nope, q_rope, k_nope, k_rope, v):
    s = (jnp.einsum('bqhd,bkhd->bhqk', q_nope, k_nope)
         + jnp.einsum('bqhr,bkr->bhqk', q_rope, k_rope)).astype(jnp.float32) * MLA_SCALE
    p = jax.nn.softmax(s, axis=-1).astype(v.dtype)
    return jnp.einsum('bhqk,bkhd->bqhd', p, v)


def blocked_mla_attend(q_nope, q_rope, k_nope, k_rope, v):
    B, L, H, _ = q_nope.shape
    nb = L // Q_BLOCK
    qn = q_nope.reshape(B, nb, Q_BLOCK, H, QK_NOPE_DIM).transpose(1, 0, 2, 3, 4)
    qr = q_rope.reshape(B, nb, Q_BLOCK, H, QK_ROPE_DIM).transpose(1, 0, 2, 3, 4)
    out = lax.map(lambda qb: mla_attend(qb[0], qb[1], k_nope, k_rope, v), (qn, qr))
    return out.transpose(1, 0, 2, 3, 4).reshape(B, L, H * V_HEAD_DIM)


def mla_branch(h_lat, h_ctx, w_in, q_norm, kv_norm, w_uq, w_ukv, w_out, need_ctx_out):
    L = h_lat.shape[1]
    rope = axial_rope_tables(L)
    qn_l, qr_l, kn_l, kr_l, v_l, g_l = mla_project(h_lat, w_in, q_norm, kv_norm, w_uq, w_ukv, rope)
    qn_c, qr_c, kn_c, kr_c, v_c, g_c = mla_project(h_ctx, w_in, q_norm, kv_norm, w_uq, w_ukv, None)
    kn = jnp.concatenate([kn_c, kn_l], axis=1)
    kr = jnp.concatenate([kr_c, kr_l], axis=1)
    v = jnp.concatenate([v_c, v_l], axis=1)
    o_lat = blocked_mla_attend(qn_l, qr_l, kn, kr, v)
    y_lat = (o_lat * jax.nn.silu(g_l)) @ w_out
    if not need_ctx_out:
        return y_lat, None
    B, Lc = h_ctx.shape[:2]
    o_ctx = mla_attend(qn_c, qr_c, kn_c, kr_c, v_c).reshape(B, Lc, MLA_WIDTH)
    y_ctx = (o_ctx * jax.nn.silu(g_c)) @ w_out
    return y_lat, y_ctx


def setup_inputs(seed: int = 0) -> dict:
    key = jax.random.key(seed)
    ks = jax.random.split(key, 20)
    nrm = jax.random.normal
    f32 = jnp.float32
    return {
        "x": nrm(ks[0], (BATCH, SEQ, D_MODEL), f32),
        "c": nrm(ks[1], (BATCH, D_MODEL), f32),
        "ctx": nrm(ks[2], (BATCH, CTX_LEN, D_MODEL), f32),
        "c_ctx": nrm(ks[3], (D_MODEL,), f32),
        "ada_w": nrm(ks[4], (DEPTH, D_MODEL, 3 * D_MODEL), f32) * D_MODEL ** -0.5,
        "ada_b": nrm(ks[5], (DEPTH, 3 * D_MODEL), f32) * 0.01,
        "pre_norm": 1.0 + 0.1 * nrm(ks[6], (DEPTH, D_MODEL), f32),
        "post_norm": 1.0 + 0.1 * nrm(ks[7], (DEPTH, D_MODEL), f32),
        "pool_w_in": nrm(ks[8], (N_POOL_LAYERS, D_MODEL, 2 * POOL_WIDTH), f32) * D_MODEL ** -0.5,
        "pool_w_grp": nrm(ks[9], (N_POOL_LAYERS, POOL_GROUPS, POOL_GROUP_DIM, POOL_GROUP_DIM), f32) * POOL_GROUP_DIM ** -0.5,
        "pool_b_grp": nrm(ks[10], (N_POOL_LAYERS, POOL_GROUPS, POOL_GROUP_DIM), f32) * 0.01,
        "pool_scale": 1.0 + 0.1 * nrm(ks[11], (N_POOL_LAYERS, POOL_WIDTH), f32),
        "pool_w_out": nrm(ks[12], (N_POOL_LAYERS, POOL_WIDTH, D_MODEL), f32) * POOL_WIDTH ** -0.5,
        "mla_w_in": nrm(ks[13], (N_MLA_LAYERS, D_MODEL, MLA_IN_WIDTH), f32) * D_MODEL ** -0.5,
        "mla_q_norm": 1.0 + 0.1 * nrm(ks[14], (N_MLA_LAYERS, Q_LORA_RANK), f32),
        "mla_kv_norm": 1.0 + 0.1 * nrm(ks[15], (N_MLA_LAYERS, KV_LORA_RANK), f32),
        "mla_w_uq": nrm(ks[16], (N_MLA_LAYERS, Q_LORA_RANK, MLA_HEADS * (QK_NOPE_DIM + QK_ROPE_DIM)), f32) * Q_LORA_RANK ** -0.5,
        "mla_w_ukv": nrm(ks[17], (N_MLA_LAYERS, KV_LORA_RANK, MLA_HEADS * (QK_NOPE_DIM + V_HEAD_DIM)), f32) * KV_LORA_RANK ** -0.5,
        "mla_w_out": nrm(ks[18], (N_MLA_LAYERS, MLA_WIDTH, D_MODEL), f32) * MLA_WIDTH ** -0.5,
    }


def reference(x, c, ctx, c_ctx, ada_w, ada_b, pre_norm, post_norm,
              pool_w_in, pool_w_grp, pool_b_grp, pool_scale, pool_w_out,
              mla_w_in, mla_q_norm, mla_kv_norm, mla_w_uq, mla_w_ukv, mla_w_out):
    for i in range(DEPTH):
        last = i == DEPTH - 1
        j = i // N_MIXERS
        is_pool = (i % N_MIXERS) == 0
        need_ctx_out = not last
        need_ctx_in = need_ctx_out or not is_pool
        shift, scale, gate = jnp.split(jax.nn.silu(c) @ ada_w[i] + ada_b[i], 3, axis=-1)
        h_lat = rms_norm(x, pre_norm[i]) * (1 + scale[:, None]) + shift[:, None]
        h_ctx = None
        gate_c = None
        if need_ctx_in:
            shift_c, scale_c, gate_c = jnp.split(jax.nn.silu(c_ctx) @ ada_w[i] + ada_b[i], 3, axis=-1)
            h_ctx = rms_norm(ctx, pre_norm[i]) * (1 + scale_c) + shift_c
        if is_pool:
            y_lat = pool_branch(h_lat, pool_w_in[j], pool_w_grp[j], pool_b_grp[j], pool_scale[j], pool_w_out[j])
            y_ctx = (pool_branch(h_ctx, pool_w_in[j], pool_w_grp[j], pool_b_grp[j], pool_scale[j], pool_w_out[j])
                     if need_ctx_out else None)
        else:
            y_lat, y_ctx = mla_branch(h_lat, h_ctx, mla_w_in[j], mla_q_norm[j], mla_kv_norm[j],
                                      mla_w_uq[j], mla_w_ukv[j], mla_w_out[j], need_ctx_out)
        x = x + gate[:, None] * rms_norm(y_lat, post_norm[i])
        if need_ctx_out:
            ctx = ctx + gate_c * rms_norm(y_ctx, post_norm[i])
    return x
```

```cpp
#include <hip/hip_runtime.h>
#include <hip/hip_cooperative_groups.h>
#include <hip/hip_bf16.h>
#include <cstdio>
#include <cstdint>
namespace cg = cooperative_groups;

#ifndef MK_N_LAUNCHES
#define MK_N_LAUNCHES 12
#endif

#define LAS __attribute__((address_space(3)))
typedef unsigned short bf16_t;
typedef short bf16x8 __attribute__((ext_vector_type(8)));
typedef short s16x4 __attribute__((ext_vector_type(4)));
typedef float f32x4 __attribute__((ext_vector_type(4)));
typedef float f32x2 __attribute__((ext_vector_type(2)));
typedef float f32x16 __attribute__((ext_vector_type(16)));
typedef unsigned u32x4 __attribute__((ext_vector_type(4)));
typedef unsigned u32x2 __attribute__((ext_vector_type(2)));

constexpr int DM = 2048, NB = 8, SEQ = 2048, CTXL = 256;
constexpr int ML = NB * SEQ, MC = NB * CTXL, MT = ML + MC;
constexpr int NMLA = 3328;
constexpr float EPS = 1e-6f;
constexpr float QSCALE = 0.07216878364870322f * 1.4426950408889634f;

constexpr size_t MiB = 1u << 20;
constexpr size_t WS_MOD = 0;
constexpr size_t WS_SSQ = 512 * 1024;
constexpr size_t WS_BAR = 768 * 1024;
constexpr size_t CTL_ZERO_BYTES = 1 * MiB;
constexpr size_t WS_TAB = 1 * MiB;
constexpr size_t WS_WIN = 2 * MiB, WS_WG = 18 * MiB, WS_WOUT = 20 * MiB, WS_WMLA = 28 * MiB, WS_WUQ = 41 * MiB, WS_WUKV = 44 * MiB, WS_WMO = 48 * MiB;
constexpr size_t WS_H = 64 * MiB, WS_SG = 136 * MiB, WS_Z = 208 * MiB, WS_Y = 280 * MiB, WS_U = 352 * MiB, WS_P = 424 * MiB;
constexpr size_t WS_Q = 352 * MiB, WS_CQ = 448 * MiB, WS_CKV = 466 * MiB, WS_KR = 484 * MiB, WS_KN = WS_H, WS_V = WS_Y;
constexpr size_t WS_END = 496 * MiB;

__device__ __forceinline__ unsigned cvt_pk_bf16(float lo, float hi) { unsigned r; asm volatile("v_cvt_pk_bf16_f32 %0, %1, %2" : "=v"(r) : "v"(lo), "v"(hi)); return r; }
__device__ __forceinline__ float bf_lo(unsigned w) { return __uint_as_float(w << 16); }
__device__ __forceinline__ float bf_hi(unsigned w) { return __uint_as_float(w & 0xffff0000u); }
__device__ __forceinline__ float silu_f(float v) { return v * __builtin_amdgcn_rcpf(1.f + __builtin_amdgcn_exp2f(-1.4426950408889634f * v)); }
__device__ __forceinline__ float wave_sum(float v) {
#pragma unroll
    for (int o = 1; o < 64; o <<= 1) v += __shfl_xor(v, o);
    return v;
}

namespace pg8 {
constexpr int BM = 256, BK = 64, HALF = 128, HTB = HALF * BK * 2, STAGE_BYTES = 8 * HTB, NXCD = 8, WGM = 8;
__host__ __device__ __forceinline__ int lds_byte(int r, int c) { const int st = (r >> 4) * 2 + (c >> 5), rr = r & 15, cc = c & 31, ob = rr * 64 + cc * 2; return st * 1024 + (ob ^ (((ob >> 9) & 1) << 5)); }
__host__ __device__ __forceinline__ void stage_rc(int b, int& R, int& C) { const int st = b / 1024, sb = b % 1024, swz = sb ^ (((sb >> 9) & 1) << 5); R = (st >> 1) * 16 + swz / 64; C = (st & 1) * 32 + (swz % 64) / 2; }
__host__ __device__ __forceinline__ int perm32(int rho) { const int n = rho >> 4, i = rho & 15; return 8 * (i >> 2) + 4 * n + (i & 3); }

struct Unit { int pm, pn; };
struct Gemm { const bf16_t* A; const bf16_t* Bt; int M, N, K, lda, ldb, agrp; };

struct StaticOrder {
    int nM, nN, nwg, G, c;
    __host__ __device__ void init(int M, int N, int G_, int c_) { nM = M / BM; nN = N / BM; nwg = nM * nN; G = G_; c = c_; }
    __host__ __device__ bool next(int i, Unit& u) const {
        const long L = (long)i * G + c; if (L >= nwg) return false;
        int wgid = (int)L; { const int q = nwg / NXCD, r = nwg % NXCD, xcd = wgid % NXCD, off = wgid / NXCD; wgid = (xcd < r ? xcd * (q + 1) : r * (q + 1) + (xcd - r) * q) + off; }
        const int nig = WGM * nN, gid = wgid / nig, fm = gid * WGM, gsz = (nM - fm) < WGM ? (nM - fm) : WGM;
        u.pm = fm + ((wgid % nig) % gsz); u.pn = (wgid % nig) / gsz; return true;
    }
};

template <class Epi>
__device__ __forceinline__ void gemm_phase(LAS unsigned char* lds, const Gemm g, const StaticOrder& S, const Epi& E) {
    const int tid = threadIdx.x, wid = __builtin_amdgcn_readfirstlane(tid >> 6), lane = tid & 63, wr = wid >> 2, wc = wid & 3, fr = lane & 15, fq = lane >> 4;
    const int K = g.K, nt = K / BK;
    unsigned voffA[2], voffB[2];
#pragma unroll
    for (int i = 0; i < 2; ++i) { int R, C; stage_rc(tid * 16 + i * 8192, R, C); const int Rb = Epi::PERM ? ((R & ~31) + perm32(R & 31)) : R;
        voffA[i] = (unsigned)(R * g.lda + C) * 2u; voffB[i] = (unsigned)(Rb * g.ldb + C) * 2u; }
    const size_t kstep = (size_t)(BK * 2);
    const size_t hsA = (size_t)HALF * g.lda * 2, hsB = (size_t)HALF * g.ldb * 2;
    const size_t tsA = 2 * hsA, tsB = 2 * hsB;
    const unsigned ldsw = (unsigned)wid * 1024u;
    const int aoff = lds_byte(wr * 64 + fr, fq * 8), boff = lds_byte(wc * 32 + fr, fq * 8);
#define PG8_SA(b, h) (((b) * 2 + (h)) * HTB)
#define PG8_SB(b, h) ((4 + (b) * 2 + (h)) * HTB)
#define PG8_STAGE(bufoff, gbase, voff) do { _Pragma("unroll") for (int _i = 0; _i < 2; ++_i) \
        __builtin_amdgcn_global_load_lds((const unsigned*)((const char*)(gbase) + (voff)[_i]), (LAS unsigned*)(lds + (bufoff) + ldsw + _i * 8192), 16, 0, 0); } while (0)
#define PG8_LDA(dst, b, h) do { _Pragma("unroll") for (int m = 0; m < 4; ++m) _Pragma("unroll") for (int k = 0; k < 2; ++k) dst[m][k] = *(const LAS bf16x8*)(lds + PG8_SA(b, h) + aoff + m * 2048 + k * 1024); } while (0)
#define PG8_LDB(dst, b, h) do { _Pragma("unroll") for (int n = 0; n < 2; ++n) _Pragma("unroll") for (int k = 0; k < 2; ++k) dst[n][k] = *(const LAS bf16x8*)(lds + PG8_SB(b, h) + boff + n * 2048 + k * 1024); } while (0)
#define PG8_MMA(ai, bj, At, Bt) do { __builtin_amdgcn_s_setprio(1); _Pragma("unroll") for (int m = 0; m < 4; ++m) _Pragma("unroll") for (int n = 0; n < 2; ++n) _Pragma("unroll") for (int k = 0; k < 2; ++k) \
        acc[ai][bj][m][n] = __builtin_amdgcn_mfma_f32_16x16x32_bf16(Bt[n][k], At[m][k], acc[ai][bj][m][n], 0, 0, 0); __builtin_amdgcn_s_setprio(0); } while (0)
#define PG8_WAIT_V(n) asm volatile("s_waitcnt vmcnt(" #n ")" ::: "memory")
#define PG8_WAIT_L(n) asm volatile("s_waitcnt lgkmcnt(" #n ")" ::: "memory")
#define PG8_BAR __builtin_amdgcn_s_barrier()
#define PG8_SCHED __builtin_amdgcn_sched_barrier(0)
#define PG8_AOFF(u) ((g.agrp > 0) ? (size_t)((u).pn / g.agrp) * (size_t)K * 2 : (size_t)0)
    Unit cur, nxt; int ui = 0;
    if (!S.next(0, cur)) return;
    f32x4 acc[2][2][4][2];
#pragma unroll
    for (int a = 0; a < 2; ++a)
#pragma unroll
        for (int b = 0; b < 2; ++b)
#pragma unroll
            for (int m = 0; m < 4; ++m)
#pragma unroll
                for (int n = 0; n < 2; ++n) acc[a][b][m][n] = (f32x4){0.f, 0.f, 0.f, 0.f};
    bf16x8 At[4][2], B0[2][2], B1[2][2];
    const char* cA = (const char*)g.A + (size_t)cur.pm * tsA + PG8_AOFF(cur); const char* cB = (const char*)g.Bt + (size_t)cur.pn * tsB;
    PG8_STAGE(PG8_SB(0, 0), cB, voffB); PG8_STAGE(PG8_SB(0, 1), cB + hsB, voffB); PG8_STAGE(PG8_SA(0, 0), cA, voffA); PG8_STAGE(PG8_SA(0, 1), cA + hsA, voffA);
    if (wr == 1) PG8_BAR;
    PG8_WAIT_V(2); PG8_BAR;
    PG8_STAGE(PG8_SB(1, 0), cB + kstep, voffB); PG8_STAGE(PG8_SA(1, 0), cA + kstep, voffA); PG8_STAGE(PG8_SB(1, 1), cB + hsB + kstep, voffB);
    PG8_WAIT_V(6); PG8_BAR;
    for (;;) {
        const bool has_next = S.next(ui + 1, nxt);
        const char* nA = has_next ? (const char*)g.A + (size_t)nxt.pm * tsA + PG8_AOFF(nxt) : cA; const char* nB = has_next ? (const char*)g.Bt + (size_t)nxt.pn * tsB : cB;
        for (int t = 0; t < nt; t += 2) {
            const bool last = (t == nt - 2);
            const char* a1 = cA + (size_t)(t + 1) * kstep;
            const char* a2 = last ? nA : cA + (size_t)(t + 2) * kstep; const char* b2 = last ? nB : cB + (size_t)(t + 2) * kstep;
            const char* a3 = a2 + kstep; const char* b3 = b2 + kstep;
            PG8_LDB(B0, 0, 0); PG8_LDB(B1, 0, 1); PG8_SCHED; PG8_LDA(At, 0, 0); PG8_STAGE(PG8_SA(1, 1), a1 + hsA, voffA);
            PG8_WAIT_V(8); PG8_WAIT_L(0); PG8_BAR; PG8_MMA(0, 0, At, B0); PG8_MMA(0, 1, At, B1); PG8_BAR; PG8_SCHED;
            PG8_LDA(At, 0, 1); PG8_STAGE(PG8_SB(0, 0), b2, voffB); PG8_STAGE(PG8_SB(0, 1), b2 + hsB, voffB); PG8_STAGE(PG8_SA(0, 0), a2, voffA);
            PG8_WAIT_V(8); PG8_WAIT_L(0); PG8_BAR; PG8_MMA(1, 0, At, B0); PG8_MMA(1, 1, At, B1); PG8_BAR; PG8_SCHED;
            PG8_LDB(B0, 1, 0); PG8_LDB(B1, 1, 1); PG8_SCHED; PG8_LDA(At, 1, 0); PG8_STAGE(PG8_SA(0, 1), a2 + hsA, voffA);
            PG8_WAIT_V(8); PG8_WAIT_L(0); PG8_BAR; PG8_MMA(0, 0, At, B0); PG8_MMA(0, 1, At, B1); PG8_BAR; PG8_SCHED;
            PG8_LDA(At, 1, 1); PG8_STAGE(PG8_SB(1, 0), b3, voffB); PG8_STAGE(PG8_SB(1, 1), b3 + hsB, voffB); PG8_STAGE(PG8_SA(1, 0), a3, voffA);
            PG8_WAIT_V(8); PG8_WAIT_L(0); PG8_BAR; PG8_MMA(1, 0, At, B0); PG8_MMA(1, 1, At, B1); PG8_BAR; PG8_SCHED;
        }
        if (wr == 0) PG8_BAR;
        E(acc, cur, wr, wc, fr, fq);
        if (!has_next) break;
#pragma unroll
        for (int a = 0; a < 2; ++a)
#pragma unroll
            for (int b = 0; b < 2; ++b)
#pragma unroll
                for (int m = 0; m < 4; ++m)
#pragma unroll
                    for (int n = 0; n < 2; ++n) acc[a][b][m][n] = (f32x4){0.f, 0.f, 0.f, 0.f};
        cur = nxt; cA = nA; cB = nB; ++ui;
        if (wr == 1) PG8_BAR;
    }
    PG8_WAIT_V(0);
    PG8_BAR;
#undef PG8_SA
#undef PG8_SB
#undef PG8_STAGE
#undef PG8_LDA
#undef PG8_LDB
#undef PG8_MMA
#undef PG8_WAIT_V
#undef PG8_WAIT_L
#undef PG8_BAR
#undef PG8_SCHED
#undef PG8_AOFF
}

__device__ __forceinline__ u32x4 pack8(f32x4 v0, f32x4 v1) { u32x4 w; w.x = cvt_pk_bf16(v0[0], v0[1]); w.y = cvt_pk_bf16(v0[2], v0[3]); w.z = cvt_pk_bf16(v1[0], v1[1]); w.w = cvt_pk_bf16(v1[2], v1[3]); return w; }
__device__ __forceinline__ f32x4 silu4(f32x4 v) { return (f32x4){silu_f(v[0]), silu_f(v[1]), silu_f(v[2]), silu_f(v[3])}; }

struct EpiPlain {
    static constexpr bool PERM = true;
    bf16_t* O; int ldc;
    __device__ __forceinline__ void operator()(const f32x4 (&acc)[2][2][4][2], const Unit& u, int wr, int wc, int fr, int fq) const {
        const int row0 = u.pm * BM + wr * 64 + fr, col0 = u.pn * BM + wc * 32 + 8 * fq;
#pragma unroll
        for (int ai = 0; ai < 2; ++ai)
#pragma unroll
            for (int m = 0; m < 4; ++m) { bf16_t* rowp = O + (size_t)(row0 + ai * HALF + m * 16) * ldc + col0;
#pragma unroll
                for (int bj = 0; bj < 2; ++bj) *(u32x4*)(rowp + bj * HALF) = pack8(acc[ai][bj][m][0], acc[ai][bj][m][1]); }
    }
};
struct EpiPoolIn {
    static constexpr bool PERM = true;
    bf16_t* U; bf16_t* SG;
    __device__ __forceinline__ void operator()(const f32x4 (&acc)[2][2][4][2], const Unit& u, int wr, int wc, int fr, int fq) const {
        const int t = u.pn >> 3; bf16_t* base = t ? SG : U;
        const int row0 = u.pm * BM + wr * 64 + fr, col0 = (u.pn & 7) * BM + wc * 32 + 8 * fq;
#pragma unroll
        for (int ai = 0; ai < 2; ++ai)
#pragma unroll
            for (int m = 0; m < 4; ++m) { bf16_t* rowp = base + (size_t)(row0 + ai * HALF + m * 16) * DM + col0;
#pragma unroll
                for (int bj = 0; bj < 2; ++bj) { f32x4 v0 = acc[ai][bj][m][0], v1 = acc[ai][bj][m][1];
                    if (t) { v0 = silu4(v0); v1 = silu4(v1); }
                    *(u32x4*)(rowp + bj * HALF) = pack8(v0, v1); } }
    }
};
struct EpiGrp {
    static constexpr bool PERM = true;
    const bf16_t* SG; bf16_t* Z; const float* bias; const float* scale;
    __device__ __forceinline__ void operator()(const f32x4 (&acc)[2][2][4][2], const Unit& u, int wr, int wc, int fr, int fq) const {
        const int row0 = u.pm * BM + wr * 64 + fr, col0 = u.pn * BM + wc * 32 + 8 * fq;
        f32x4 bv[2][2], sv[2][2];
#pragma unroll
        for (int bj = 0; bj < 2; ++bj)
#pragma unroll
            for (int n = 0; n < 2; ++n) { bv[bj][n] = *(const f32x4*)(bias + col0 + bj * HALF + 4 * n); sv[bj][n] = *(const f32x4*)(scale + col0 + bj * HALF + 4 * n); }
#pragma unroll
        for (int ai = 0; ai < 2; ++ai)
#pragma unroll
            for (int m = 0; m < 4; ++m) { const size_t off = (size_t)(row0 + ai * HALF + m * 16) * DM + col0;
#pragma unroll
                for (int bj = 0; bj < 2; ++bj) { const u32x4 gw = *(const u32x4*)(SG + off + bj * HALF);
                    f32x4 v0 = (acc[ai][bj][m][0] + bv[bj][0]) * sv[bj][0], v1 = (acc[ai][bj][m][1] + bv[bj][1]) * sv[bj][1];
                    v0 = v0 * (f32x4){bf_lo(gw.x), bf_hi(gw.x), bf_lo(gw.y), bf_hi(gw.y)}; v1 = v1 * (f32x4){bf_lo(gw.z), bf_hi(gw.z), bf_lo(gw.w), bf_hi(gw.w)};
                    *(u32x4*)(Z + off + bj * HALF) = pack8(v0, v1); } }
    }
};
struct EpiMlaIn {
    static constexpr bool PERM = true;
    bf16_t *CQ, *CKV, *KR, *SG; float* ssq; const f32x2* tab;
    __device__ __forceinline__ void operator()(const f32x4 (&acc)[2][2][4][2], const Unit& u, int wr, int wc, int fr, int fq) const {
        const int pn = u.pn, row0 = u.pm * BM + wr * 64 + fr;
        if (pn < 4) {
            bf16_t* base = pn < 2 ? CQ : CKV; float* ss = ssq + (pn < 2 ? 0 : MT);
            const int col0 = (pn & 1) * BM + wc * 32 + 8 * fq;
#pragma unroll
            for (int ai = 0; ai < 2; ++ai)
#pragma unroll
                for (int m = 0; m < 4; ++m) { const int row = row0 + ai * HALF + m * 16; bf16_t* rowp = base + (size_t)row * 512 + col0; float s = 0.f;
#pragma unroll
                    for (int bj = 0; bj < 2; ++bj) { const f32x4 v0 = acc[ai][bj][m][0], v1 = acc[ai][bj][m][1];
                        s += (v0[0] * v0[0] + v0[1] * v0[1]) + (v0[2] * v0[2] + v0[3] * v0[3]) + (v1[0] * v1[0] + v1[1] * v1[1]) + (v1[2] * v1[2] + v1[3] * v1[3]);
                        *(u32x4*)(rowp + bj * HALF) = pack8(v0, v1); }
                    s += __shfl_xor(s, 16); s += __shfl_xor(s, 32);
                    if (fq == 0) atomicAdd(ss + row, s); }
        } else if (pn < 12) {
            if (u.pm < ML / BM) {
                const int col0 = (pn - 4) * BM + wc * 32 + 8 * fq;
#pragma unroll
                for (int ai = 0; ai < 2; ++ai)
#pragma unroll
                    for (int m = 0; m < 4; ++m) { bf16_t* rowp = SG + (size_t)(row0 + ai * HALF + m * 16) * DM + col0;
#pragma unroll
                        for (int bj = 0; bj < 2; ++bj) *(u32x4*)(rowp + bj * HALF) = pack8(silu4(acc[ai][bj][m][0]), silu4(acc[ai][bj][m][1])); }
            }
        } else {
            if (wc < 2) {
                const bool lat = u.pm < ML / BM;
#pragma unroll
                for (int ai = 0; ai < 2; ++ai)
#pragma unroll
                    for (int m = 0; m < 4; ++m) { const int row = row0 + ai * HALF + m * 16;
                        f32x4 v0 = acc[ai][0][m][0], v1 = acc[ai][0][m][1];
                        if (lat) {
                            const int t = row & (SEQ - 1), pos = wc == 0 ? (t >> 6) : (t & 63);
                            const f32x2* tp = tab + pos * 16 + 8 * (fq & 1);
                            f32x4 p0, p1;
#pragma unroll
                            for (int j = 0; j < 4; ++j) { p0[j] = __shfl_xor(v0[j], 32); p1[j] = __shfl_xor(v1[j], 32); }
                            const bool first = fq < 2;
#pragma unroll
                            for (int j = 0; j < 4; ++j) { const f32x2 c0 = tp[j], c1 = tp[4 + j];
                                v0[j] = first ? (v0[j] * c0.x - p0[j] * c0.y) : (p0[j] * c0.y + v0[j] * c0.x);
                                v1[j] = first ? (v1[j] * c1.x - p1[j] * c1.y) : (p1[j] * c1.y + v1[j] * c1.x); }
                        }
                        *(u32x4*)(KR + (size_t)row * 64 + wc * 32 + 8 * fq) = pack8(v0, v1); }
            }
        }
    }
};
struct EpiQ {
    static constexpr bool PERM = false;
    bf16_t* Q; const float* ssq; const f32x2* tab;
    __device__ __forceinline__ void operator()(const f32x4 (&acc)[2][2][4][2], const Unit& u, int wr, int wc, int fr, int fq) const {
        const int row0 = u.pm * BM + wr * 64 + fr;
#pragma unroll
        for (int ai = 0; ai < 2; ++ai)
#pragma unroll
            for (int m = 0; m < 4; ++m) { const int row = row0 + ai * HALF + m * 16; const float rs = __builtin_amdgcn_rsqf(ssq[row] * (1.f / 512.f) + EPS) * QSCALE; const int t = row & (SEQ - 1);
#pragma unroll
                for (int bj = 0; bj < 2; ++bj) { const int gcol = u.pn * 8 + bj * 4 + wc, hg = gcol % 6;
                    f32x4 x1 = acc[ai][bj][m][0] * rs, x2 = acc[ai][bj][m][1] * rs;
                    if (hg >= 4) { const int pos = hg == 4 ? (t >> 6) : (t & 63); const f32x2* tp = tab + pos * 16 + 4 * fq;
#pragma unroll
                        for (int j = 0; j < 4; ++j) { const f32x2 cs = tp[j]; const float a = x1[j], b = x2[j]; x1[j] = a * cs.x - b * cs.y; x2[j] = a * cs.y + b * cs.x; } }
                    bf16_t* p = Q + (size_t)row * 3072 + gcol * 32 + 4 * fq;
                    u32x2 w0, w1; w0.x = cvt_pk_bf16(x1[0], x1[1]); w0.y = cvt_pk_bf16(x1[2], x1[3]); w1.x = cvt_pk_bf16(x2[0], x2[1]); w1.y = cvt_pk_bf16(x2[2], x2[3]);
                    *(u32x2*)p = w0; *(u32x2*)(p + 16) = w1; } }
    }
};
struct EpiKV {
    static constexpr bool PERM = true;
    bf16_t* KN; bf16_t* V; const float* ssq;
    __device__ __forceinline__ void operator()(const f32x4 (&acc)[2][2][4][2], const Unit& u, int wr, int wc, int fr, int fq) const {
        const int row0 = u.pm * BM + wr * 64 + fr, col0 = u.pn * 128 + wc * 32 + 8 * fq;
#pragma unroll
        for (int ai = 0; ai < 2; ++ai)
#pragma unroll
            for (int m = 0; m < 4; ++m) { const int row = row0 + ai * HALF + m * 16; const float rs = __builtin_amdgcn_rsqf(ssq[row] * (1.f / 512.f) + EPS);
                *(u32x4*)(KN + (size_t)row * DM + col0) = pack8(acc[ai][0][m][0] * rs, acc[ai][0][m][1] * rs);
                *(u32x4*)(V + (size_t)row * DM + col0) = pack8(acc[ai][1][m][0] * rs, acc[ai][1][m][1] * rs); }
    }
};
}

namespace att {
constexpr int NW = 8, QBLK = 32, KVBLK = 64, NT = (CTXL + SEQ) / KVBLK;
constexpr int SHM_V = KVBLK * 128 * 2, SHM_K = KVBLK * 192 * 2;
constexpr int NQREG = 6, SHM_QR = (12 - NQREG) * 8192, SHM_ATTN = 2 * SHM_V + 2 * SHM_K + NW * 64 * 4 + SHM_QR;
constexpr float THRL = 8.f * 1.4426950408889634f;
#define KSWZ(row, colB) ((row) * 384 + ((colB) ^ (((row) & 7) << 4)))
#define SBAR() __builtin_amdgcn_sched_barrier(0)
__device__ __forceinline__ int crow(int r, int hi) { return (r & 3) + 8 * (r >> 2) + 4 * hi; }
__device__ __forceinline__ void partialSM(f32x16& p0, f32x16& p1, float& m_reg, float& mn, float& alpha) {
  float pmax = p0[0];
#pragma unroll
  for (int r = 1; r < 16; ++r) pmax = fmaxf(pmax, p0[r]);
#pragma unroll
  for (int r = 0; r < 16; ++r) pmax = fmaxf(pmax, p1[r]);
  { auto rr = __builtin_amdgcn_permlane32_swap(__float_as_uint(pmax), __float_as_uint(pmax), false, false);
    pmax = fmaxf(__uint_as_float(rr[0]), __uint_as_float(rr[1])); }
  if (__builtin_expect(__all(pmax - m_reg <= THRL), 1)) { mn = m_reg; alpha = 1.f; }
  else { mn = fmaxf(m_reg, pmax); alpha = __builtin_amdgcn_exp2f(m_reg - mn); m_reg = mn; }
#pragma unroll
  for (int r = 0; r < 16; ++r) p0[r] = p0[r] - mn;
#pragma unroll
  for (int r = 0; r < 16; ++r) p1[r] = p1[r] - mn;
#pragma unroll
  for (int r = 0; r < 16; ++r) p0[r] = __builtin_amdgcn_exp2f(p0[r]);
}
__device__ __forceinline__ void finishSM(f32x16& p0, f32x16& p1, float alpha, float& l_reg, bf16x8& pa0, bf16x8& pa1, bf16x8& pa2, bf16x8& pa3) {
#pragma unroll
  for (int r = 0; r < 16; ++r) p1[r] = __builtin_amdgcn_exp2f(p1[r]);
  float ps = 0;
#pragma unroll
  for (int r = 0; r < 16; ++r) ps += p0[r];
#pragma unroll
  for (int r = 0; r < 16; ++r) ps += p1[r];
  { auto rr = __builtin_amdgcn_permlane32_swap(__float_as_uint(ps), __float_as_uint(ps), false, false);
    ps = __uint_as_float(rr[0]) + __uint_as_float(rr[1]); }
  l_reg = l_reg * alpha + ps;
#define PK4(P, BASE, OUT) do { unsigned a0 = cvt_pk_bf16(P[BASE + 0], P[BASE + 1]), a1 = cvt_pk_bf16(P[BASE + 2], P[BASE + 3]);   \
    unsigned b0 = cvt_pk_bf16(P[BASE + 4], P[BASE + 5]), b1 = cvt_pk_bf16(P[BASE + 6], P[BASE + 7]);                              \
    auto r0 = __builtin_amdgcn_permlane32_swap(a0, b0, false, false); auto r1 = __builtin_amdgcn_permlane32_swap(a1, b1, false, false); \
    u32x4 w = {r0[0], r1[0], r0[1], r1[1]}; OUT = *reinterpret_cast<bf16x8*>(&w); } while (0)
  PK4(p0, 0, pa0); PK4(p0, 8, pa1); PK4(p1, 0, pa2); PK4(p1, 8, pa3);
#undef PK4
}
__device__ __forceinline__ void qkt(f32x16& p0, f32x16& p1, const char* Ks, const bf16x8* qr, const char* Qr, int r32, int hi) {
  p0 = f32x16{}; p1 = f32x16{};
#pragma unroll
  for (int d0 = 0; d0 < 12; ++d0) { const int cb = (d0 * 16 + hi * 8) * 2;
    bf16x8 b0 = *reinterpret_cast<const bf16x8*>(Ks + KSWZ(r32, cb));
    bf16x8 b1 = *reinterpret_cast<const bf16x8*>(Ks + KSWZ(32 + r32, cb));
    const bf16x8 qf = d0 < NQREG ? qr[d0 < NQREG ? d0 : 0] : *reinterpret_cast<const bf16x8*>(Qr + (d0 - NQREG) * 8192);
    p0 = __builtin_amdgcn_mfma_f32_32x32x16_bf16(b0, qf, p0, 0, 0, 0);
    p1 = __builtin_amdgcn_mfma_f32_32x32x16_bf16(b1, qf, p1, 0, 0, 0); }
}
__device__ __forceinline__ int v_st(int k, int c) { const int kk = (k & ~0xC) | ((k & 4) << 1) | ((k & 8) >> 1); return ((kk >> 3) * 4 + (c >> 5)) * 512 + ((kk & 7) * 32 + (c & 31)) * 2; }
__device__ __forceinline__ int v_rd_base(int lane) { return ((lane & 3) << 3) | (((lane >> 2) & 3) << 6) | (((lane >> 4) & 1) << 5) | (((lane >> 5) & 1) << 8); }
constexpr int v_rd_off(int d0, int ks, int half) { return d0 * 512 + ks * 4096 + half * 2048; }
template <int OFF> __device__ __forceinline__ s16x4 tr_read(int vb) {
  s16x4 r; asm volatile("ds_read_b64_tr_b16 %0, %1 offset:%2" : "=&v"(r) : "v"(vb), "i"(OFF) : "memory"); return r;
}
template <int D0> __device__ __forceinline__ void pv_one(f32x16& od, int vb, bf16x8 pa0, bf16x8 pa1, bf16x8 pa2, bf16x8 pa3) {
  const s16x4 l0 = tr_read<v_rd_off(D0, 0, 0)>(vb), h0 = tr_read<v_rd_off(D0, 0, 1)>(vb), l1 = tr_read<v_rd_off(D0, 1, 0)>(vb), h1 = tr_read<v_rd_off(D0, 1, 1)>(vb);
  const s16x4 l2 = tr_read<v_rd_off(D0, 2, 0)>(vb), h2 = tr_read<v_rd_off(D0, 2, 1)>(vb), l3 = tr_read<v_rd_off(D0, 3, 0)>(vb), h3 = tr_read<v_rd_off(D0, 3, 1)>(vb);
  asm volatile("s_waitcnt lgkmcnt(0)" ::: "memory"); SBAR();
#define PK(L, H) (bf16x8){L[0], L[1], L[2], L[3], H[0], H[1], H[2], H[3]}
  od = __builtin_amdgcn_mfma_f32_32x32x16_bf16(pa0, PK(l0, h0), od, 0, 0, 0);
  od = __builtin_amdgcn_mfma_f32_32x32x16_bf16(pa1, PK(l1, h1), od, 0, 0, 0);
  od = __builtin_amdgcn_mfma_f32_32x32x16_bf16(pa2, PK(l2, h2), od, 0, 0, 0);
  od = __builtin_amdgcn_mfma_f32_32x32x16_bf16(pa3, PK(l3, h3), od, 0, 0, 0);
#undef PK
}
__device__ __forceinline__ void pv_d0(f32x16* o, int vb, bf16x8 pa0, bf16x8 pa1, bf16x8 pa2, bf16x8 pa3) {
  pv_one<0>(o[0], vb, pa0, pa1, pa2, pa3); pv_one<1>(o[1], vb, pa0, pa1, pa2, pa3); pv_one<2>(o[2], vb, pa0, pa1, pa2, pa3); pv_one<3>(o[3], vb, pa0, pa1, pa2, pa3);
}
__device__ __forceinline__ void attn_unit(const bf16_t* __restrict__ Q, const bf16_t* __restrict__ KN, const bf16_t* __restrict__ KR, const bf16_t* __restrict__ V,
                                          const bf16_t* __restrict__ SG, bf16_t* __restrict__ Z, int b, int h, int q0, char* lds) {
  const int tid = threadIdx.x, wid = tid >> 6, lane = tid & 63, r32 = lane & 31, hi = lane >> 5;
  char* V_lds = lds; char* K_lds = lds + 2 * SHM_V;
  float* wsf = (float*)(lds + 2 * SHM_V + 2 * SHM_K) + wid * 64; float* li_l = wsf; float* al_l = wsf + 32;
  char* Qr = lds + 2 * SHM_V + 2 * SHM_K + NW * 64 * 4 + tid * 16;
  float m_reg = -1e30f, l_reg = 0; f32x16 o[4] = {}; bf16x8 qr[NQREG];
  const bf16_t* Qw = Q + (size_t)(q0 + wid * QBLK + r32) * 3072 + h * 192 + hi * 8;
  __syncthreads();
#pragma unroll
  for (int d0 = 0; d0 < NQREG; ++d0) qr[d0] = *reinterpret_cast<const bf16x8*>(Qw + d0 * 16);
#pragma unroll
  for (int d0 = NQREG; d0 < 12; ++d0) *reinterpret_cast<bf16x8*>(Qr + (d0 - NQREG) * 8192) = *reinterpret_cast<const bf16x8*>(Qw + d0 * 16);
  const int sr = tid >> 4, sc = (tid & 15) * 8, vst0 = v_st(sr, sc), vst1 = v_st(32 + sr, sc);
  const int rr = tid >> 3, rc = (tid & 7) * 8;
  const int vb0 = (int)(uintptr_t)V_lds + v_rd_base(lane);
  const bf16_t* KNh = KN + h * 128 + sc; const bf16_t* Vh = V + h * 128 + sc; const bf16_t* KRh = KR + rc;
  bf16x8 vs0, vs1, ks0, ks1, kr0;
#define KROW(j) ((j) < 4 ? ML + b * CTXL + (j) * KVBLK : b * SEQ + ((j) - 4) * KVBLK)
#define SLOAD(j) do { const int rb_ = KROW(j); vs0 = *reinterpret_cast<const bf16x8*>(Vh + (size_t)(rb_ + sr) * DM); vs1 = *reinterpret_cast<const bf16x8*>(Vh + (size_t)(rb_ + 32 + sr) * DM); \
    ks0 = *reinterpret_cast<const bf16x8*>(KNh + (size_t)(rb_ + sr) * DM); ks1 = *reinterpret_cast<const bf16x8*>(KNh + (size_t)(rb_ + 32 + sr) * DM); \
    kr0 = *reinterpret_cast<const bf16x8*>(KRh + (size_t)(rb_ + rr) * 64); } while (0)
#define SWRITE(bb) do { *(bf16x8*)(V_lds + (bb) * SHM_V + vst0) = vs0; *(bf16x8*)(V_lds + (bb) * SHM_V + vst1) = vs1; const int kc = sc * 2;               \
    *(bf16x8*)(K_lds + (bb) * SHM_K + KSWZ(sr, kc)) = ks0; *(bf16x8*)(K_lds + (bb) * SHM_K + KSWZ(32 + sr, kc)) = ks1;                       \
    *(bf16x8*)(K_lds + (bb) * SHM_K + KSWZ(rr, 256 + rc * 2)) = kr0; } while (0)
#define SWAIT() asm volatile("s_waitcnt vmcnt(0)" ::: "memory")
#define RESC(a) do { if (__any((a) < 1.f)) { if (hi == 0) al_l[r32] = (a); asm volatile("s_waitcnt lgkmcnt(0)" ::: "memory"); \
    _Pragma("unroll") for (int d = 0; d < 4; ++d) _Pragma("unroll") for (int r = 0; r < 16; ++r) o[d][r] *= al_l[crow(r, hi)]; } } while (0)
  f32x16 pA0, pA1, pB0, pB1; float mnA, mnB, alA, alB; bf16x8 pa0, pa1, pa2, pa3;
  SLOAD(0); SWAIT(); SWRITE(0); __syncthreads();
  qkt(pA0, pA1, K_lds, qr, Qr, r32, hi); partialSM(pA0, pA1, m_reg, mnA, alA);
  SLOAD(1);
  SWAIT(); SWRITE(1); __syncthreads();
  for (int j = 1; j + 1 < NT; j += 2) {
    SBAR(); qkt(pB0, pB1, K_lds + SHM_K, qr, Qr, r32, hi);
    finishSM(pA0, pA1, alA, l_reg, pa0, pa1, pa2, pa3); SBAR();
    SLOAD(j + 1); SBAR();
    pv_d0(o, vb0, pa0, pa1, pa2, pa3); partialSM(pB0, pB1, m_reg, mnB, alB);
    __syncthreads(); SWAIT(); SWRITE(0);
    RESC(alB); __syncthreads();
    SBAR(); qkt(pA0, pA1, K_lds, qr, Qr, r32, hi);
    finishSM(pB0, pB1, alB, l_reg, pa0, pa1, pa2, pa3); SBAR();
    SLOAD(j + 2); SBAR();
    pv_d0(o, vb0 + SHM_V, pa0, pa1, pa2, pa3); partialSM(pA0, pA1, m_reg, mnA, alA);
    __syncthreads(); SWAIT(); SWRITE(1);
    RESC(alA); __syncthreads();
  }
  SBAR(); qkt(pB0, pB1, K_lds + SHM_K, qr, Qr, r32, hi);
  finishSM(pA0, pA1, alA, l_reg, pa0, pa1, pa2, pa3); SBAR();
  pv_d0(o, vb0, pa0, pa1, pa2, pa3); partialSM(pB0, pB1, m_reg, mnB, alB);
  __syncthreads(); RESC(alB);
  finishSM(pB0, pB1, alB, l_reg, pa0, pa1, pa2, pa3); SBAR();
  pv_d0(o, vb0 + SHM_V, pa0, pa1, pa2, pa3);
  if (hi == 0) li_l[r32] = l_reg; asm volatile("s_waitcnt lgkmcnt(0)" ::: "memory");
  float rli[16];
#pragma unroll
  for (int r = 0; r < 16; ++r) rli[r] = __builtin_amdgcn_rcpf(li_l[crow(r, hi)]);
  const size_t ob = (size_t)(q0 + wid * QBLK) * DM + h * 128 + r32;
#pragma unroll
  for (int r = 0; r < 16; ++r) { const size_t orow = ob + (size_t)crow(r, hi) * DM;
#pragma unroll
    for (int d0 = 0; d0 < 4; ++d0) { const float g = __uint_as_float((unsigned)SG[orow + d0 * 32] << 16); const float z = o[d0][r] * rli[r] * g;
      Z[orow + d0 * 32] = (bf16_t)(cvt_pk_bf16(z, 0.f) & 0xffffu); } }
#undef KROW
#undef SLOAD
#undef SWRITE
#undef SWAIT
#undef RESC
}
}


#define XB_TMO      128
#define XB_XCNT(j)  (256  + 64 * (j))
#define XB_XSUB(j)  (1280 + 64 * (j))
#define XB_XGEN(j)  (2304 + 64 * (j))
#define XB_TOP      3328
#define XB_TOPGEN   3392
#define XCD_BAR_WORDS 3456
#define XB_SPIN_CAP (1u << 22)
__device__ __forceinline__ unsigned xb_ld(unsigned* p)              { return __hip_atomic_load(p, __ATOMIC_RELAXED, __HIP_MEMORY_SCOPE_AGENT); }
__device__ __forceinline__ unsigned xb_add(unsigned* p, unsigned v) { return __hip_atomic_fetch_add(p, v, __ATOMIC_RELAXED, __HIP_MEMORY_SCOPE_AGENT); }
__device__ __forceinline__ unsigned xb_xcc_id() { return (unsigned)__builtin_amdgcn_s_getreg((3 << 11) | 20) & 0xFu; }
#define XB_SPIN(cond, bar) do { unsigned _sp = 0; while (cond) { __builtin_amdgcn_s_sleep(1); \
    if ((++_sp & 255u) == 0u) { if (xb_ld(&(bar)[XB_TMO])) break; if (_sp > XB_SPIN_CAP) { atomicAdd(&(bar)[XB_TMO], 1u); break; } } } } while (0)
struct XcdBarrier { unsigned* bar; unsigned x; volatile LAS unsigned* st; };
__device__ __forceinline__ XcdBarrier xcd_barrier_post(unsigned* bar, volatile LAS unsigned* st) {
    XcdBarrier b; b.bar = bar; b.x = xb_xcc_id(); b.st = st;
    if (threadIdx.x == 0) (void)xb_add(&bar[XB_XCNT(b.x)], 1u);
    return b;
}
__device__ __forceinline__ void xcd_barrier_complete(unsigned* bar, unsigned x, unsigned& nloc, unsigned& nx) {
    const unsigned G = gridDim.x;
    unsigned sum, cnt, mine, sp = 0u;
    for (;;) {
        sum = 0u; cnt = 0u; mine = 0u;
#pragma unroll
        for (unsigned j = 0; j < 16; ++j) { const unsigned c = xb_ld(&bar[XB_XCNT(j)]); sum += c; cnt += (c > 0u) ? 1u : 0u; mine = (j == x) ? c : mine; }
        if (sum == G) break;
        __builtin_amdgcn_s_sleep(1);
        if ((++sp & 255u) == 0u) { if (xb_ld(&bar[XB_TMO])) break; if (sp > XB_SPIN_CAP) { atomicAdd(&bar[XB_TMO], 1u); break; } }
    }
    nloc = mine > 0u ? mine : 1u; nx = cnt > 0u ? cnt : 1u;
}
__device__ __forceinline__ void xcd_barrier(const XcdBarrier& b) {
    asm volatile("s_waitcnt vmcnt(0)" ::: "memory");
    __syncthreads();
    if (threadIdx.x == 0) {
        unsigned* bar = b.bar;
        __builtin_amdgcn_s_waitcnt(0);
        unsigned nloc = b.st[0], nx = b.st[1];
        if (nloc == 0u) { xcd_barrier_complete(bar, b.x, nloc, nx); b.st[0] = nloc; b.st[1] = nx; }
        const unsigned old = xb_add(&bar[XB_XSUB(b.x)], 1u);
        const unsigned gen = old / nloc;
        if (old + 1u == (gen + 1u) * nloc) {
            __builtin_amdgcn_fence(__ATOMIC_RELEASE, "agent");
            asm volatile("s_waitcnt vmcnt(0)" ::: "memory");
            const unsigned og = xb_add(&bar[XB_TOP], 1u);
            const unsigned tg = og / nx;
            if (og + 1u == (tg + 1u) * nx) xb_add(&bar[XB_TOPGEN], 1u);
            else XB_SPIN(xb_ld(&bar[XB_TOPGEN]) == tg, bar);
            __builtin_amdgcn_fence(__ATOMIC_ACQUIRE, "agent");
            xb_add(&bar[XB_XGEN(b.x)], 1u);
            asm volatile("s_waitcnt vmcnt(0)" ::: "memory");
        } else {
            XB_SPIN(xb_ld(&bar[XB_XGEN(b.x)]) == gen, bar);
            __builtin_amdgcn_fence(__ATOMIC_ACQUIRE, "agent");
            asm volatile("s_waitcnt vmcnt(0)" ::: "memory");
        }
    }
    __syncthreads();
}
constexpr int NWAVES = 8;
constexpr int LDS_BYTES = 147456;
constexpr int N_PHASES = 12;
constexpr int MISC_OFF = 135168;

struct Args { const float* in[19]; float* out; unsigned char* ws; int ph_lo, ph_hi; };

struct Frame {
    LAS unsigned char* lds;
    int tid, lane, wave, gw, NGW, G;
    unsigned char* ws;
};

__device__ __forceinline__ void tr_item(const float* W, int K, int N, bf16_t* WT, const float* gk, LAS float* scr, int item, int lane, bool mla_reorder = false) {
    const int nblk = N / 32, kb = item / nblk, nb = item % nblk, k0 = 64 * kb, n0 = 32 * nb;
    const int d0 = mla_reorder ? (nb < 32 ? n0 : (nb < 34 ? n0 + 2048 : n0 - 64)) : n0;
#pragma unroll 8
    for (int i = 0; i < 32; ++i) { const int kk = 2 * i + (lane >> 5); float v = W[(size_t)(k0 + kk) * N + n0 + (lane & 31)]; if (gk) v *= gk[k0 + kk]; scr[kk * 33 + (lane & 31)] = v; }
    asm volatile("s_waitcnt lgkmcnt(0)" ::: "memory");
    const int c = lane & 7;
#pragma unroll
    for (int j = 0; j < 4; ++j) { const int n = (lane >> 3) + 8 * j; const LAS float* s = scr + (8 * c) * 33 + n;
        u32x4 o; o.x = cvt_pk_bf16(s[0 * 33], s[1 * 33]); o.y = cvt_pk_bf16(s[2 * 33], s[3 * 33]); o.z = cvt_pk_bf16(s[4 * 33], s[5 * 33]); o.w = cvt_pk_bf16(s[6 * 33], s[7 * 33]);
        *(u32x4*)(WT + (size_t)(d0 + n) * K + k0 + 8 * c) = o; }
    asm volatile("s_waitcnt lgkmcnt(0)" ::: "memory");
}

__device__ __forceinline__ void gemv_item(const float* c, const float* c_ctx, const float* ada_w, const float* ada_b, float* mod, int it, int lane) {
    const int l = it / 768, rem = it % 768, kc = rem / 24, cgp = rem % 24, k0 = kc * 64;
    float s[9];
#pragma unroll
    for (int r = 0; r < 8; ++r) s[r] = silu_f(c[r * DM + k0 + lane]);
    s[8] = silu_f(c_ctx[k0 + lane]);
    const float* W = ada_w + (size_t)l * DM * 6144 + (size_t)k0 * 6144 + cgp * 256 + lane * 4;
    f32x4 acc[9];
#pragma unroll
    for (int r = 0; r < 9; ++r) acc[r] = (f32x4){0.f, 0.f, 0.f, 0.f};
#pragma unroll 8
    for (int kk = 0; kk < 64; ++kk) { const f32x4 w = *(const f32x4*)(W + (size_t)kk * 6144);
#pragma unroll
        for (int r = 0; r < 9; ++r) { const float sk = __uint_as_float(__builtin_amdgcn_readlane(__float_as_uint(s[r]), kk)); acc[r] += w * sk; } }
    const int col = cgp * 256 + lane * 4;
    f32x4 bv = (f32x4){0.f, 0.f, 0.f, 0.f};
    if (kc == 0) bv = *(const f32x4*)(ada_b + l * 6144 + col);
#pragma unroll
    for (int r = 0; r < 9; ++r) { float* m = mod + (size_t)(l * 9 + r) * 6144 + col;
#pragma unroll
        for (int j = 0; j < 4; ++j) atomicAdd(m + j, acc[r][j] + bv[j]); }
}

__device__ __forceinline__ void load_row_f32(const float* p, int lane, f32x4 (&v)[8]) {
#pragma unroll
    for (int j = 0; j < 8; ++j) v[j] = *(const f32x4*)(p + 4 * lane + 256 * j);
}
__device__ __forceinline__ float sumsq8(const f32x4 (&v)[8]) {
    float s = 0.f;
#pragma unroll
    for (int j = 0; j < 8; ++j) s += (v[j][0] * v[j][0] + v[j][1] * v[j][1]) + (v[j][2] * v[j][2] + v[j][3] * v[j][3]);
    return wave_sum(s);
}
__device__ __forceinline__ void modulate_store(const f32x4 (&v)[8], float rstd, const float* pn, const float* modr, bf16_t* orow, int lane) {
#pragma unroll
    for (int j = 0; j < 8; ++j) { const int col = 4 * lane + 256 * j;
        const f32x4 g = *(const f32x4*)(pn + col), sh = *(const f32x4*)(modr + col), sc = *(const f32x4*)(modr + DM + col);
        const f32x4 hh = v[j] * rstd * g * (sc + 1.f) + sh;
        u32x2 w; w.x = cvt_pk_bf16(hh[0], hh[1]); w.y = cvt_pk_bf16(hh[2], hh[3]);
        *(u32x2*)(orow + col) = w; }
}

__global__ void __launch_bounds__(NWAVES * 64, 2) mk_fwd(Args args) {
    extern __shared__ __attribute__((aligned(16))) unsigned char lds[];
    cg::grid_group grid = cg::this_grid();
    Frame F;
    F.lds = (LAS unsigned char*)lds;
    F.tid = threadIdx.x; F.lane = F.tid & 63; F.wave = __builtin_amdgcn_readfirstlane(F.tid >> 6);
    F.G = gridDim.x; F.gw = blockIdx.x * NWAVES + F.wave; F.NGW = F.G * NWAVES; F.ws = args.ws;
    unsigned char* ws = args.ws;
    const int lo = args.ph_lo, hi = args.ph_hi;
#ifndef PHASE_MASK
#define PHASE_MASK 0xFFF
#endif
#define IN(k) (((PHASE_MASK >> (k)) & 1) && lo <= (k) && (k) < hi)
#define SEAM(k) do { if (IN(k) && IN((k) + 1)) { if ((k) == 0) grid.sync(); else xcd_barrier(bar); } } while (0)
    volatile LAS unsigned* MISC = (volatile LAS unsigned*)(F.lds + MISC_OFF);
    if (F.tid < 16) MISC[F.tid] = 0u;
    __syncthreads();
    XcdBarrier bar; bar.bar = (unsigned*)(args.ws + WS_BAR); bar.x = 0; bar.st = MISC;
    if (hi - lo > 1) bar = xcd_barrier_post((unsigned*)(args.ws + WS_BAR), MISC);
    const float* x = args.in[0]; const float* c = args.in[1]; const float* ctx = args.in[2]; const float* c_ctx = args.in[3];
    const float* ada_w = args.in[4]; const float* ada_b = args.in[5]; const float* pre_norm = args.in[6]; const float* post_norm = args.in[7];
    float* mod = (float*)(ws + WS_MOD); float* ssq = (float*)(ws + WS_SSQ); f32x2* tab = (f32x2*)(ws + WS_TAB);
    bf16_t* WIN = (bf16_t*)(ws + WS_WIN); bf16_t* WG = (bf16_t*)(ws + WS_WG); bf16_t* WOUT = (bf16_t*)(ws + WS_WOUT); bf16_t* WMLA = (bf16_t*)(ws + WS_WMLA);
    bf16_t* WUQ = (bf16_t*)(ws + WS_WUQ); bf16_t* WUKV = (bf16_t*)(ws + WS_WUKV); bf16_t* WMO = (bf16_t*)(ws + WS_WMO);
    bf16_t* H = (bf16_t*)(ws + WS_H); bf16_t* SG = (bf16_t*)(ws + WS_SG); bf16_t* Z = (bf16_t*)(ws + WS_Z); bf16_t* Y = (bf16_t*)(ws + WS_Y);
    bf16_t* U = (bf16_t*)(ws + WS_U); bf16_t* P = (bf16_t*)(ws + WS_P); bf16_t* Q = (bf16_t*)(ws + WS_Q); bf16_t* CQ = (bf16_t*)(ws + WS_CQ);
    bf16_t* CKV = (bf16_t*)(ws + WS_CKV); bf16_t* KR = (bf16_t*)(ws + WS_KR); bf16_t* KN = (bf16_t*)(ws + WS_KN); bf16_t* V = (bf16_t*)(ws + WS_V);
    const int NTHR = F.G * NWAVES * 64;
#define FRESH() int gtid; do { int t_ = threadIdx.x; asm volatile("" : "+v"(t_)); F.tid = t_; F.lane = t_ & 63; gtid = blockIdx.x * (NWAVES * 64) + t_; (void)gtid; } while (0)

    if (IN(0)) { FRESH();
        LAS float* scr = (LAS float*)(F.lds + F.wave * 16384);
        constexpr int I_GEMV = 2 * 32 * 24;
        constexpr int I_WIN = 32 * 128, I_WG = 4 * 8 * 16, I_WOUT = 32 * 64, I_WMLA = 32 * 98, I_WUQ = 8 * 96, I_WUKV = 8 * 128, I_WMO = 32 * 64;
        constexpr int NITEMS = I_GEMV + I_WIN + I_WG + I_WOUT + I_WMLA + I_WUQ + I_WUKV + I_WMO;
        for (int it = F.gw; it < NITEMS; it += F.NGW) {
            int r = it;
            if (r < I_GEMV) { gemv_item(c, c_ctx, ada_w, ada_b, mod, r, F.lane); continue; } r -= I_GEMV;
            if (r < I_WIN) { tr_item(args.in[8], DM, 4096, WIN, nullptr, scr, r, F.lane); continue; } r -= I_WIN;
            if (r < I_WG) { const int g = r / 128; tr_item(args.in[9] + (size_t)g * 512 * 512, 512, 512, WG + (size_t)g * 512 * 512, nullptr, scr, r % 128, F.lane); continue; } r -= I_WG;
            if (r < I_WOUT) { tr_item(args.in[12], DM, DM, WOUT, nullptr, scr, r, F.lane); continue; } r -= I_WOUT;
            if (r < I_WMLA) { tr_item(args.in[13], DM, 3136, WMLA, nullptr, scr, r, F.lane, true); continue; } r -= I_WMLA;
            if (r < I_WUQ) { tr_item(args.in[16], 512, 3072, WUQ, args.in[14], scr, r, F.lane); continue; } r -= I_WUQ;
            if (r < I_WUKV) { tr_item(args.in[17], 512, 4096, WUKV, args.in[15], scr, r, F.lane); continue; } r -= I_WUKV;
            tr_item(args.in[18], DM, DM, WMO, nullptr, scr, r, F.lane);
        }
        for (int i = gtid; i < (NMLA - 3136) * DM / 8; i += NTHR) *(u32x4*)(WMLA + (size_t)3136 * DM + (size_t)i * 8) = (u32x4){0u, 0u, 0u, 0u};
        if (gtid < 1024) { const int pos = gtid >> 4, i = gtid & 15; const float fr = powf(10000.f, -(float)i / 16.f); const float ang = (float)pos * fr; float sn, cs; sincosf(ang, &sn, &cs); tab[gtid] = (f32x2){cs, sn}; }
    }
    SEAM(0);
    if (IN(1)) { FRESH();
        for (int row = F.gw; row < MT; row += F.NGW) {
            const bool lat = row < ML; const float* src = lat ? x + (size_t)row * DM : ctx + (size_t)(row - ML) * DM; const int r = lat ? row / SEQ : 8;
            f32x4 v[8]; load_row_f32(src, F.lane, v);
            const float rstd = __builtin_amdgcn_rsqf(sumsq8(v) * (1.f / DM) + EPS);
            modulate_store(v, rstd, pre_norm, mod + (size_t)r * 6144, H + (size_t)row * DM, F.lane);
        }
    }
    SEAM(1);
    if (IN(2)) {
        pg8::Gemm g{H, WIN, MT, 4096, DM, DM, DM, 0}; pg8::StaticOrder S; S.init(MT, 4096, F.G, (int)blockIdx.x);
        pg8::EpiPoolIn E{U, SG};
        pg8::gemm_phase<pg8::EpiPoolIn>(F.lds, g, S, E);
    }
    SEAM(2);
    if (IN(3)) { FRESH();
        for (int item = gtid; item < (MT / 16) * 256; item += NTHR) {
            const int cc = item & 255, row0 = (item >> 8) * 16;
            int base, L; if (row0 < ML) { base = row0 & ~(SEQ - 1); L = SEQ; } else { base = ML + ((row0 - ML) & ~(CTXL - 1)); L = CTXL; }
            const int t0 = row0 - base, gidx = cc >> 6, win = 2 << gidx, left = win >> 1, right = win - 1 - left;
            const bf16_t* Ub = U + (size_t)base * DM + cc * 8; bf16_t* Pb = P + (size_t)base * DM + cc * 8;
            float S8[8];
#pragma unroll
            for (int e = 0; e < 8; ++e) S8[e] = 0.f;
            const int ta = t0 - left < 0 ? 0 : t0 - left, tb = t0 + right > L - 1 ? L - 1 : t0 + right;
            for (int t = ta; t <= tb; ++t) { const u32x4 w = *(const u32x4*)(Ub + (size_t)t * DM);
                S8[0] += bf_lo(w.x); S8[1] += bf_hi(w.x); S8[2] += bf_lo(w.y); S8[3] += bf_hi(w.y); S8[4] += bf_lo(w.z); S8[5] += bf_hi(w.z); S8[6] += bf_lo(w.w); S8[7] += bf_hi(w.w); }
#pragma unroll 4
            for (int i = 0; i < 16; ++i) { const int t = t0 + i; const int lo_ = t - left < 0 ? 0 : t - left, hi_ = t + right + 1 > L ? L : t + right + 1;
                const float inv = 1.f / (float)(hi_ - lo_);
                const u32x4 w = *(const u32x4*)(Ub + (size_t)t * DM);
                u32x4 o; o.x = cvt_pk_bf16(S8[0] * inv - bf_lo(w.x), S8[1] * inv - bf_hi(w.x)); o.y = cvt_pk_bf16(S8[2] * inv - bf_lo(w.y), S8[3] * inv - bf_hi(w.y));
                o.z = cvt_pk_bf16(S8[4] * inv - bf_lo(w.z), S8[5] * inv - bf_hi(w.z)); o.w = cvt_pk_bf16(S8[6] * inv - bf_lo(w.w), S8[7] * inv - bf_hi(w.w));
                *(u32x4*)(Pb + (size_t)t * DM) = o;
                const int tn = t + 1 + right, to = t - left;
                if (tn < L) { const u32x4 a = *(const u32x4*)(Ub + (size_t)tn * DM);
                    S8[0] += bf_lo(a.x); S8[1] += bf_hi(a.x); S8[2] += bf_lo(a.y); S8[3] += bf_hi(a.y); S8[4] += bf_lo(a.z); S8[5] += bf_hi(a.z); S8[6] += bf_lo(a.w); S8[7] += bf_hi(a.w); }
                if (to >= 0) { const u32x4 a = *(const u32x4*)(Ub + (size_t)to * DM);
                    S8[0] -= bf_lo(a.x); S8[1] -= bf_hi(a.x); S8[2] -= bf_lo(a.y); S8[3] -= bf_hi(a.y); S8[4] -= bf_lo(a.z); S8[5] -= bf_hi(a.z); S8[6] -= bf_lo(a.w); S8[7] -= bf_hi(a.w); }
            }
        }
    }
    SEAM(3);
    if (IN(4)) {
        pg8::Gemm g{P, WG, MT, DM, 512, DM, 512, 2}; pg8::StaticOrder S; S.init(MT, DM, F.G, (int)blockIdx.x);
        pg8::EpiGrp E{SG, Z, args.in[10], args.in[11]};
        pg8::gemm_phase<pg8::EpiGrp>(F.lds, g, S, E);
    }
    SEAM(4);
    if (IN(5)) {
        pg8::Gemm g{Z, WOUT, MT, DM, DM, DM, DM, 0}; pg8::StaticOrder S; S.init(MT, DM, F.G, (int)blockIdx.x);
        pg8::EpiPlain E{Y, DM};
        pg8::gemm_phase<pg8::EpiPlain>(F.lds, g, S, E);
    }
    SEAM(5);
    if (IN(6)) { FRESH();
        for (int row = F.gw; row < MT; row += F.NGW) {
            const bool lat = row < ML; const float* src = lat ? x + (size_t)row * DM : ctx + (size_t)(row - ML) * DM; const int r = lat ? row / SEQ : 8;
            f32x4 v[8], y[8]; load_row_f32(src, F.lane, v);
            const bf16_t* yr = Y + (size_t)row * DM;
#pragma unroll
            for (int j = 0; j < 8; ++j) { const u32x2 w = *(const u32x2*)(yr + 4 * F.lane + 256 * j); y[j] = (f32x4){bf_lo(w.x), bf_hi(w.x), bf_lo(w.y), bf_hi(w.y)}; }
            const float rsy = __builtin_amdgcn_rsqf(sumsq8(y) * (1.f / DM) + EPS);
            const float* m0 = mod + (size_t)r * 6144;
#pragma unroll
            for (int j = 0; j < 8; ++j) { const int col = 4 * F.lane + 256 * j; const f32x4 gt = *(const f32x4*)(m0 + 2 * DM + col), pn = *(const f32x4*)(post_norm + col);
                v[j] = v[j] + gt * (y[j] * rsy * pn);
                if (lat) *(f32x4*)(args.out + (size_t)row * DM + col) = v[j]; }
            const float rstd = __builtin_amdgcn_rsqf(sumsq8(v) * (1.f / DM) + EPS);
            modulate_store(v, rstd, pre_norm + DM, mod + (size_t)(9 + r) * 6144, H + (size_t)row * DM, F.lane);
        }
    }
    SEAM(6);
    if (IN(7)) {
        pg8::Gemm g{H, WMLA, MT, NMLA, DM, DM, DM, 0}; pg8::StaticOrder S; S.init(MT, NMLA, F.G, (int)blockIdx.x);
        pg8::EpiMlaIn E{CQ, CKV, KR, SG, ssq, tab};
        pg8::gemm_phase<pg8::EpiMlaIn>(F.lds, g, S, E);
    }
    SEAM(7);
    if (IN(8)) {
        { pg8::Gemm g{CQ, WUQ, ML, 3072, 512, 512, 512, 0}; pg8::StaticOrder S; S.init(ML, 3072, F.G, (int)blockIdx.x);
          pg8::EpiQ E{Q, ssq, tab};
          pg8::gemm_phase<pg8::EpiQ>(F.lds, g, S, E); }
        { pg8::Gemm g{CKV, WUKV, MT, 4096, 512, 512, 512, 0}; pg8::StaticOrder S; S.init(MT, 4096, F.G, (int)blockIdx.x);
          pg8::EpiKV E{KN, V, ssq + MT};
          pg8::gemm_phase<pg8::EpiKV>(F.lds, g, S, E); }
    }
    SEAM(8);
    if (IN(9)) {
        const int bx = blockIdx.x, vcu = (F.G % 8 == 0) ? (bx % 8) * (F.G / 8) + bx / 8 : bx;
        for (int un = vcu; un < NB * 16 * (SEQ / 256); un += F.G) {
            const int qb = un & 7, h = (un >> 3) & 15, b = un >> 7;
            att::attn_unit(Q, KN, KR, V, SG, Z, b, h, b * SEQ + qb * 256, (char*)lds);
        }
    }
    SEAM(9);
    if (IN(10)) {
        pg8::Gemm g{Z, WMO, ML, DM, DM, DM, DM, 0}; pg8::StaticOrder S; S.init(ML, DM, F.G, (int)blockIdx.x);
        pg8::EpiPlain E{Y, DM};
        pg8::gemm_phase<pg8::EpiPlain>(F.lds, g, S, E);
    }
    SEAM(10);
    if (IN(11)) { FRESH();
        for (int row = F.gw; row < ML; row += F.NGW) {
            const int r = row / SEQ;
            f32x4 v[8], y[8]; load_row_f32(args.out + (size_t)row * DM, F.lane, v);
            const bf16_t* yr = Y + (size_t)row * DM;
#pragma unroll
            for (int j = 0; j < 8; ++j) { const u32x2 w = *(const u32x2*)(yr + 4 * F.lane + 256 * j); y[j] = (f32x4){bf_lo(w.x), bf_hi(w.x), bf_lo(w.y), bf_hi(w.y)}; }
            const float rsy = __builtin_amdgcn_rsqf(sumsq8(y) * (1.f / DM) + EPS);
            const float* m1 = mod + (size_t)(9 + r) * 6144;
#pragma unroll
            for (int j = 0; j < 8; ++j) { const int col = 4 * F.lane + 256 * j; const f32x4 gt = *(const f32x4*)(m1 + 2 * DM + col), pn = *(const f32x4*)(post_norm + DM + col);
                *(f32x4*)(args.out + (size_t)row * DM + col) = v[j] + gt * (y[j] * rsy * pn); }
        }
    }
#undef IN
#undef SEAM
}

extern "C" void kernel_launch(void* const* d_in, const int* in_sizes, int n_in, void* d_out, int out_size, void* d_ws, size_t ws_size, hipStream_t stream) {
    static int grid = 0;
    if (grid == 0) {
        if (n_in != 19 || out_size != ML * DM || ws_size < WS_END) { fprintf(stderr, "kernel_launch: unexpected shapes (n_in %d out %d ws %zu)\n", n_in, out_size, ws_size); grid = -1; return; }
        int dev = 0, cus = 0, per_cu = 0;
        hipGetDevice(&dev); hipDeviceGetAttribute(&cus, hipDeviceAttributeMultiprocessorCount, dev);
        if (hipFuncSetAttribute((const void*)mk_fwd, hipFuncAttributeMaxDynamicSharedMemorySize, LDS_BYTES) != hipSuccess) { fprintf(stderr, "kernel_launch: hipFuncSetAttribute failed\n"); grid = -1; return; }
        hipOccupancyMaxActiveBlocksPerMultiprocessor(&per_cu, (const void*)mk_fwd, NWAVES * 64, LDS_BYTES);
        (void)hipGetLastError();
        if (per_cu < 1) per_cu = 1;
        grid = cus * 1;
        (void)per_cu;
    }
    if (grid < 0) return;
    hipMemsetAsync((char*)d_ws, 0, CTL_ZERO_BYTES, stream);
    Args a{};
    for (int i = 0; i < 19; ++i) a.in[i] = (const float*)d_in[i];
    a.out = (float*)d_out; a.ws = (unsigned char*)d_ws;
#if MK_N_LAUNCHES == 1
    a.ph_lo = 0; a.ph_hi = N_PHASES;
    void* kargs[] = {&a};
    hipError_t e = hipLaunchCooperativeKernel((const void*)mk_fwd, dim3(grid), dim3(NWAVES * 64), kargs, LDS_BYTES, stream);
    if (e != hipSuccess) fprintf(stderr, "cooperative launch failed: %s (grid %d)\n", hipGetErrorString(e), grid);
#else
    for (int p = 0; p < N_PHASES; ++p) { a.ph_lo = p; a.ph_hi = p + 1; hipLaunchKernelGGL(mk_fwd, dim3(grid), dim3(NWAVES * 64), LDS_BYTES, stream, a); }
#endif
}
```

```cpp
#include <hip/hip_runtime.h>
#include <hip/hip_cooperative_groups.h>
#include <hip/hip_bf16.h>
#include <cstdio>
#include <cstdint>
namespace cg = cooperative_groups;

#ifndef MK_N_LAUNCHES
#define MK_N_LAUNCHES 1
#endif

#define LAS __attribute__((address_space(3)))
typedef unsigned short bf16_t;
typedef short bf16x8 __attribute__((ext_vector_type(8)));
typedef short s16x4 __attribute__((ext_vector_type(4)));
typedef float f32x4 __attribute__((ext_vector_type(4)));
typedef float f32x2 __attribute__((ext_vector_type(2)));
typedef float f32x16 __attribute__((ext_vector_type(16)));
typedef unsigned u32x4 __attribute__((ext_vector_type(4)));
typedef unsigned u32x2 __attribute__((ext_vector_type(2)));

constexpr int DM = 2048, NB = 8, SEQ = 2048, CTXL = 256;
constexpr int ML = NB * SEQ, MC = NB * CTXL, MT = ML + MC;
constexpr int NMLA = 3328;
constexpr float EPS = 1e-6f;
constexpr float QSCALE = 0.07216878364870322f * 1.4426950408889634f;

constexpr size_t MiB = 1u << 20;
constexpr size_t WS_MOD = 0;
constexpr size_t WS_SSQ = 512 * 1024;
constexpr size_t WS_BAR = 768 * 1024;
constexpr size_t CTL_ZERO_BYTES = 1 * MiB;
constexpr size_t WS_TAB = 1 * MiB;
constexpr size_t WS_WIN = 2 * MiB, WS_WG = 18 * MiB, WS_WOUT = 20 * MiB, WS_WMLA = 28 * MiB, WS_WUQ = 41 * MiB, WS_WUKV = 44 * MiB, WS_WMO = 48 * MiB;
constexpr size_t WS_H = 64 * MiB, WS_SG = 136 * MiB, WS_Z = 208 * MiB, WS_Y = 280 * MiB, WS_U = 352 * MiB, WS_P = 424 * MiB;
constexpr size_t WS_Q = 352 * MiB, WS_CQ = 448 * MiB, WS_CKV = 466 * MiB, WS_KR = 484 * MiB, WS_KN = WS_H, WS_V = WS_Y;
constexpr size_t WS_END = 496 * MiB;

__device__ __forceinline__ unsigned cvt_pk_bf16(float lo, float hi) { unsigned r; asm volatile("v_cvt_pk_bf16_f32 %0, %1, %2" : "=v"(r) : "v"(lo), "v"(hi)); return r; }
__device__ __forceinline__ float bf_lo(unsigned w) { return __uint_as_float(w << 16); }
__device__ __forceinline__ float bf_hi(unsigned w) { return __uint_as_float(w & 0xffff0000u); }
__device__ __forceinline__ float silu_f(float v) { return v * __builtin_amdgcn_rcpf(1.f + __builtin_amdgcn_exp2f(-1.4426950408889634f * v)); }
__device__ __forceinline__ float wave_sum(float v) {
#pragma unroll
    for (int o = 1; o < 64; o <<= 1) v += __shfl_xor(v, o);
    return v;
}

namespace pg8 {
constexpr int BM = 256, BK = 64, HALF = 128, HTB = HALF * BK * 2, STAGE_BYTES = 8 * HTB, NXCD = 8, WGM = 8;
__host__ __device__ __forceinline__ int lds_byte(int r, int c) { const int st = (r >> 4) * 2 + (c >> 5), rr = r & 15, cc = c & 31, ob = rr * 64 + cc * 2; return st * 1024 + (ob ^ (((ob >> 9) & 1) << 5)); }
__host__ __device__ __forceinline__ void stage_rc(int b, int& R, int& C) { const int st = b / 1024, sb = b % 1024, swz = sb ^ (((sb >> 9) & 1) << 5); R = (st >> 1) * 16 + swz / 64; C = (st & 1) * 32 + (swz % 64) / 2; }
__host__ __device__ __forceinline__ int perm32(int rho) { const int n = rho >> 4, i = rho & 15; return 8 * (i >> 2) + 4 * n + (i & 3); }

struct Unit { int pm, pn; };
struct Gemm { const bf16_t* A; const bf16_t* Bt; int M, N, K, lda, ldb, agrp; };

struct StaticOrder {
    int nM, nN, nwg, G, c;
    __host__ __device__ void init(int M, int N, int G_, int c_) { nM = M / BM; nN = N / BM; nwg = nM * nN; G = G_; c = c_; }
    __host__ __device__ bool next(int i, Unit& u) const {
        const long L = (long)i * G + c; if (L >= nwg) return false;
        int wgid = (int)L; { const int q = nwg / NXCD, r = nwg % NXCD, xcd = wgid % NXCD, off = wgid / NXCD; wgid = (xcd < r ? xcd * (q + 1) : r * (q + 1) + (xcd - r) * q) + off; }
        const int nig = WGM * nN, gid = wgid / nig, fm = gid * WGM, gsz = (nM - fm) < WGM ? (nM - fm) : WGM;
        u.pm = fm + ((wgid % nig) % gsz); u.pn = (wgid % nig) / gsz; return true;
    }
};

template <class Epi>
__device__ __forceinline__ void gemm_phase(LAS unsigned char* lds, const Gemm g, const StaticOrder& S, const Epi& E) {
    const int tid = threadIdx.x, wid = __builtin_amdgcn_readfirstlane(tid >> 6), lane = tid & 63, wr = wid >> 2, wc = wid & 3, fr = lane & 15, fq = lane >> 4;
    const int K = g.K, nt = K / BK;
    unsigned voffA[2], voffB[2];
#pragma unroll
    for (int i = 0; i < 2; ++i) { int R, C; stage_rc(tid * 16 + i * 8192, R, C); const int Rb = Epi::PERM ? ((R & ~31) + perm32(R & 31)) : R;
        voffA[i] = (unsigned)(R * g.lda + C) * 2u; voffB[i] = (unsigned)(Rb * g.ldb + C) * 2u; }
    const size_t kstep = (size_t)(BK * 2);
    const size_t hsA = (size_t)HALF * g.lda * 2, hsB = (size_t)HALF * g.ldb * 2;
    const size_t tsA = 2 * hsA, tsB = 2 * hsB;
    const unsigned ldsw = (unsigned)wid * 1024u;
    const int aoff = lds_byte(wr * 64 + fr, fq * 8), boff = lds_byte(wc * 32 + fr, fq * 8);
#define PG8_SA(b, h) (((b) * 2 + (h)) * HTB)
#define PG8_SB(b, h) ((4 + (b) * 2 + (h)) * HTB)
#define PG8_STAGE(bufoff, gbase, voff) do { _Pragma("unroll") for (int _i = 0; _i < 2; ++_i) \
        __builtin_amdgcn_global_load_lds((const unsigned*)((const char*)(gbase) + (voff)[_i]), (LAS unsigned*)(lds + (bufoff) + ldsw + _i * 8192), 16, 0, 0); } while (0)
#define PG8_LDA(dst, b, h) do { _Pragma("unroll") for (int m = 0; m < 4; ++m) _Pragma("unroll") for (int k = 0; k < 2; ++k) dst[m][k] = *(const LAS bf16x8*)(lds + PG8_SA(b, h) + aoff + m * 2048 + k * 1024); } while (0)
#define PG8_LDB(dst, b, h) do { _Pragma("unroll") for (int n = 0; n < 2; ++n) _Pragma("unroll") for (int k = 0; k < 2; ++k) dst[n][k] = *(const LAS bf16x8*)(lds + PG8_SB(b, h) + boff + n * 2048 + k * 1024); } while (0)
#define PG8_MMA(ai, bj, At, Bt) do { __builtin_amdgcn_s_setprio(1); _Pragma("unroll") for (int m = 0; m < 4; ++m) _Pragma("unroll") for (int n = 0; n < 2; ++n) _Pragma("unroll") for (int k = 0; k < 2; ++k) \
        acc[ai][bj][m][n] = __builtin_amdgcn_mfma_f32_16x16x32_bf16(Bt[n][k], At[m][k], acc[ai][bj][m][n], 0, 0, 0); __builtin_amdgcn_s_setprio(0); } while (0)
#define PG8_WAIT_V(n) asm volatile("s_waitcnt vmcnt(" #n ")" ::: "memory")
#define PG8_WAIT_L(n) asm volatile("s_waitcnt lgkmcnt(" #n ")" ::: "memory")
#define PG8_BAR __builtin_amdgcn_s_barrier()
#define PG8_SCHED __builtin_amdgcn_sched_barrier(0)
#define PG8_AOFF(u) ((g.agrp > 0) ? (size_t)((u).pn / g.agrp) * (size_t)K * 2 : (size_t)0)
    Unit cur, nxt; int ui = 0;
    if (!S.next(0, cur)) return;
    f32x4 acc[2][2][4][2];
#pragma unroll
    for (int a = 0; a < 2; ++a)
#pragma unroll
        for (int b = 0; b < 2; ++b)
#pragma unroll
            for (int m = 0; m < 4; ++m)
#pragma unroll
                for (int n = 0; n < 2; ++n) acc[a][b][m][n] = (f32x4){0.f, 0.f, 0.f, 0.f};
    bf16x8 At[4][2], B0[2][2], B1[2][2];
    const char* cA = (const char*)g.A + (size_t)cur.pm * tsA + PG8_AOFF(cur); const char* cB = (const char*)g.Bt + (size_t)cur.pn * tsB;
    PG8_STAGE(PG8_SB(0, 0), cB, voffB); PG8_STAGE(PG8_SB(0, 1), cB + hsB, voffB); PG8_STAGE(PG8_SA(0, 0), cA, voffA); PG8_STAGE(PG8_SA(0, 1), cA + hsA, voffA);
    if (wr == 1) PG8_BAR;
    PG8_WAIT_V(2); PG8_BAR;
    PG8_STAGE(PG8_SB(1, 0), cB + kstep, voffB); PG8_STAGE(PG8_SA(1, 0), cA + kstep, voffA); PG8_STAGE(PG8_SB(1, 1), cB + hsB + kstep, voffB);
    PG8_WAIT_V(6); PG8_BAR;
    for (;;) {
        const bool has_next = S.next(ui + 1, nxt);
        const char* nA = has_next ? (const char*)g.A + (size_t)nxt.pm * tsA + PG8_AOFF(nxt) : cA; const char* nB = has_next ? (const char*)g.Bt + (size_t)nxt.pn * tsB : cB;
        for (int t = 0; t < nt; t += 2) {
            const bool last = (t == nt - 2);
            const char* a1 = cA + (size_t)(t + 1) * kstep;
            const char* a2 = last ? nA : cA + (size_t)(t + 2) * kstep; const char* b2 = last ? nB : cB + (size_t)(t + 2) * kstep;
            const char* a3 = a2 + kstep; const char* b3 = b2 + kstep;
            PG8_LDB(B0, 0, 0); PG8_LDB(B1, 0, 1); PG8_SCHED; PG8_LDA(At, 0, 0); PG8_STAGE(PG8_SA(1, 1), a1 + hsA, voffA);
            PG8_WAIT_V(8); PG8_WAIT_L(0); PG8_BAR; PG8_MMA(0, 0, At, B0); PG8_MMA(0, 1, At, B1); PG8_BAR; PG8_SCHED;
            PG8_LDA(At, 0, 1); PG8_STAGE(PG8_SB(0, 0), b2, voffB); PG8_STAGE(PG8_SB(0, 1), b2 + hsB, voffB); PG8_STAGE(PG8_SA(0, 0), a2, voffA);
            PG8_WAIT_V(8); PG8_WAIT_L(0); PG8_BAR; PG8_MMA(1, 0, At, B0); PG8_MMA(1, 1, At, B1); PG8_BAR; PG8_SCHED;
            PG8_LDB(B0, 1, 0); PG8_LDB(B1, 1, 1); PG8_SCHED; PG8_LDA(At, 1, 0); PG8_STAGE(PG8_SA(0, 1), a2 + hsA, voffA);
            PG8_WAIT_V(8); PG8_WAIT_L(0); PG8_BAR; PG8_MMA(0, 0, At, B0); PG8_MMA(0, 1, At, B1); PG8_BAR; PG8_SCHED;
            PG8_LDA(At, 1, 1); PG8_STAGE(PG8_SB(1, 0), b3, voffB); PG8_STAGE(PG8_SB(1, 1), b3 + hsB, voffB); PG8_STAGE(PG8_SA(1, 0), a3, voffA);
            PG8_WAIT_V(8); PG8_WAIT_L(0); PG8_BAR; PG8_MMA(1, 0, At, B0); PG8_MMA(1, 1, At, B1); PG8_BAR; PG8_SCHED;
        }
        if (wr == 0) PG8_BAR;
        E(acc, cur, wr, wc, fr, fq);
        if (!has_next) break;
#pragma unroll
        for (int a = 0; a < 2; ++a)
#pragma unroll
            for (int b = 0; b < 2; ++b)
#pragma unroll
                for (int m = 0; m < 4; ++m)
#pragma unroll
                    for (int n = 0; n < 2; ++n) acc[a][b][m][n] = (f32x4){0.f, 0.f, 0.f, 0.f};
        cur = nxt; cA = nA; cB = nB; ++ui;
        if (wr == 1) PG8_BAR;
    }
    PG8_WAIT_V(0);
    PG8_BAR;
#undef PG8_SA
#undef PG8_SB
#undef PG8_STAGE
#undef PG8_LDA
#undef PG8_LDB
#undef PG8_MMA
#undef PG8_WAIT_V
#undef PG8_WAIT_L
#undef PG8_BAR
#undef PG8_SCHED
#undef PG8_AOFF
}

__device__ __forceinline__ u32x4 pack8(f32x4 v0, f32x4 v1) { u32x4 w; w.x = cvt_pk_bf16(v0[0], v0[1]); w.y = cvt_pk_bf16(v0[2], v0[3]); w.z = cvt_pk_bf16(v1[0], v1[1]); w.w = cvt_pk_bf16(v1[2], v1[3]); return w; }
__device__ __forceinline__ f32x4 silu4(f32x4 v) { return (f32x4){silu_f(v[0]), silu_f(v[1]), silu_f(v[2]), silu_f(v[3])}; }

struct EpiPlain {
    static constexpr bool PERM = true;
    bf16_t* O; int ldc;
    __device__ __forceinline__ void operator()(const f32x4 (&acc)[2][2][4][2], const Unit& u, int wr, int wc, int fr, int fq) const {
        const int row0 = u.pm * BM + wr * 64 + fr, col0 = u.pn * BM + wc * 32 + 8 * fq;
#pragma unroll
        for (int ai = 0; ai < 2; ++ai)
#pragma unroll
            for (int m = 0; m < 4; ++m) { bf16_t* rowp = O + (size_t)(row0 + ai * HALF + m * 16) * ldc + col0;
#pragma unroll
                for (int bj = 0; bj < 2; ++bj) *(u32x4*)(rowp + bj * HALF) = pack8(acc[ai][bj][m][0], acc[ai][bj][m][1]); }
    }
};
struct EpiPoolIn {
    static constexpr bool PERM = true;
    bf16_t* U; bf16_t* SG;
    __device__ __forceinline__ void operator()(const f32x4 (&acc)[2][2][4][2], const Unit& u, int wr, int wc, int fr, int fq) const {
        const int t = u.pn >> 3; bf16_t* base = t ? SG : U;
        const int row0 = u.pm * BM + wr * 64 + fr, col0 = (u.pn & 7) * BM + wc * 32 + 8 * fq;
#pragma unroll
        for (int ai = 0; ai < 2; ++ai)
#pragma unroll
            for (int m = 0; m < 4; ++m) { bf16_t* rowp = base + (size_t)(row0 + ai * HALF + m * 16) * DM + col0;
#pragma unroll
                for (int bj = 0; bj < 2; ++bj) { f32x4 v0 = acc[ai][bj][m][0], v1 = acc[ai][bj][m][1];
                    if (t) { v0 = silu4(v0); v1 = silu4(v1); }
                    *(u32x4*)(rowp + bj * HALF) = pack8(v0, v1); } }
    }
};
struct EpiGrp {
    static constexpr bool PERM = true;
    const bf16_t* SG; bf16_t* Z; const float* bias; const float* scale;
    __device__ __forceinline__ void operator()(const f32x4 (&acc)[2][2][4][2], const Unit& u, int wr, int wc, int fr, int fq) const {
        const int row0 = u.pm * BM + wr * 64 + fr, col0 = u.pn * BM + wc * 32 + 8 * fq;
        f32x4 bv[2][2], sv[2][2];
#pragma unroll
        for (int bj = 0; bj < 2; ++bj)
#pragma unroll
            for (int n = 0; n < 2; ++n) { bv[bj][n] = *(const f32x4*)(bias + col0 + bj * HALF + 4 * n); sv[bj][n] = *(const f32x4*)(scale + col0 + bj * HALF + 4 * n); }
#pragma unroll
        for (int ai = 0; ai < 2; ++ai)
#pragma unroll
            for (int m = 0; m < 4; ++m) { const size_t off = (size_t)(row0 + ai * HALF + m * 16) * DM + col0;
#pragma unroll
                for (int bj = 0; bj < 2; ++bj) { const u32x4 gw = *(const u32x4*)(SG + off + bj * HALF);
                    f32x4 v0 = (acc[ai][bj][m][0] + bv[bj][0]) * sv[bj][0], v1 = (acc[ai][bj][m][1] + bv[bj][1]) * sv[bj][1];
                    v0 = v0 * (f32x4){bf_lo(gw.x), bf_hi(gw.x), bf_lo(gw.y), bf_hi(gw.y)}; v1 = v1 * (f32x4){bf_lo(gw.z), bf_hi(gw.z), bf_lo(gw.w), bf_hi(gw.w)};
                    *(u32x4*)(Z + off + bj * HALF) = pack8(v0, v1); } }
    }
};
struct EpiMlaIn {
    static constexpr bool PERM = true;
    bf16_t *CQ, *CKV, *KR, *SG; float* ssq; const f32x2* tab;
    __device__ __forceinline__ void operator()(const f32x4 (&acc)[2][2][4][2], const Unit& u, int wr, int wc, int fr, int fq) const {
        const int pn = u.pn, row0 = u.pm * BM + wr * 64 + fr;
        if (pn < 4) {
            bf16_t* base = pn < 2 ? CQ : CKV; float* ss = ssq + (pn < 2 ? 0 : MT);
            const int col0 = (pn & 1) * BM + wc * 32 + 8 * fq;
#pragma unroll
            for (int ai = 0; ai < 2; ++ai)
#pragma unroll
                for (int m = 0; m < 4; ++m) { const int row = row0 + ai * HALF + m * 16; bf16_t* rowp = base + (size_t)row * 512 + col0; float s = 0.f;
#pragma unroll
                    for (int bj = 0; bj < 2; ++bj) { const f32x4 v0 = acc[ai][bj][m][0], v1 = acc[ai][bj][m][1];
                        s += (v0[0] * v0[0] + v0[1] * v0[1]) + (v0[2] * v0[2] + v0[3] * v0[3]) + (v1[0] * v1[0] + v1[1] * v1[1]) + (v1[2] * v1[2] + v1[3] * v1[3]);
                        *(u32x4*)(rowp + bj * HALF) = pack8(v0, v1); }
                    s += __shfl_xor(s, 16); s += __shfl_xor(s, 32);
                    if (fq == 0) atomicAdd(ss + row, s); }
        } else if (pn < 12) {
            if (u.pm < ML / BM) {
                const int col0 = (pn - 4) * BM + wc * 32 + 8 * fq;
#pragma unroll
                for (int ai = 0; ai < 2; ++ai)
#pragma unroll
                    for (int m = 0; m < 4; ++m) { bf16_t* rowp = SG + (size_t)(row0 + ai * HALF + m * 16) * DM + col0;
#pragma unroll
                        for (int bj = 0; bj < 2; ++bj) *(u32x4*)(rowp + bj * HALF) = pack8(silu4(acc[ai][bj][m][0]), silu4(acc[ai][bj][m][1])); }
            }
        } else {
            if (wc < 2) {
                const bool lat = u.pm < ML / BM;
#pragma unroll
                for (int ai = 0; ai < 2; ++ai)
#pragma unroll
                    for (int m = 0; m < 4; ++m) { const int row = row0 + ai * HALF + m * 16;
                        f32x4 v0 = acc[ai][0][m][0], v1 = acc[ai][0][m][1];
                        if (lat) {
                            const int t = row & (SEQ - 1), pos = wc == 0 ? (t >> 6) : (t & 63);
                            const f32x2* tp = tab + pos * 16 + 8 * (fq & 1);
                            f32x4 p0, p1;
#pragma unroll
                            for (int j = 0; j < 4; ++j) { p0[j] = __shfl_xor(v0[j], 32); p1[j] = __shfl_xor(v1[j], 32); }
                            const bool first = fq < 2;
#pragma unroll
                            for (int j = 0; j < 4; ++j) { const f32x2 c0 = tp[j], c1 = tp[4 + j];
                                v0[j] = first ? (v0[j] * c0.x - p0[j] * c0.y) : (p0[j] * c0.y + v0[j] * c0.x);
                                v1[j] = first ? (v1[j] * c1.x - p1[j] * c1.y) : (p1[j] * c1.y + v1[j] * c1.x); }
                        }
                        *(u32x4*)(KR + (size_t)row * 64 + wc * 32 + 8 * fq) = pack8(v0, v1); }
            }
        }
    }
};
struct EpiQ {
    static constexpr bool PERM = false;
    bf16_t* Q; const float* ssq; const f32x2* tab;
    __device__ __forceinline__ void operator()(const f32x4 (&acc)[2][2][4][2], const Unit& u, int wr, int wc, int fr, int fq) const {
        const int row0 = u.pm * BM + wr * 64 + fr;
#pragma unroll
        for (int ai = 0; ai < 2; ++ai)
#pragma unroll
            for (int m = 0; m < 4; ++m) { const int row = row0 + ai * HALF + m * 16; const float rs = __builtin_amdgcn_rsqf(ssq[row] * (1.f / 512.f) + EPS) * QSCALE; const int t = row & (SEQ - 1);
#pragma unroll
                for (int bj = 0; bj < 2; ++bj) { const int gcol = u.pn * 8 + bj * 4 + wc, hg = gcol % 6;
                    f32x4 x1 = acc[ai][bj][m][0] * rs, x2 = acc[ai][bj][m][1] * rs;
                    if (hg >= 4) { const int pos = hg == 4 ? (t >> 6) : (t & 63); const f32x2* tp = tab + pos * 16 + 4 * fq;
#pragma unroll
                        for (int j = 0; j < 4; ++j) { const f32x2 cs = tp[j]; const float a = x1[j], b = x2[j]; x1[j] = a * cs.x - b * cs.y; x2[j] = a * cs.y + b * cs.x; } }
                    bf16_t* p = Q + (size_t)row * 3072 + gcol * 32 + 4 * fq;
                    u32x2 w0, w1; w0.x = cvt_pk_bf16(x1[0], x1[1]); w0.y = cvt_pk_bf16(x1[2], x1[3]); w1.x = cvt_pk_bf16(x2[0], x2[1]); w1.y = cvt_pk_bf16(x2[2], x2[3]);
                    *(u32x2*)p = w0; *(u32x2*)(p + 16) = w1; } }
    }
};
struct EpiKV {
    static constexpr bool PERM = true;
    bf16_t* KN; bf16_t* V; const float* ssq;
    __device__ __forceinline__ void operator()(const f32x4 (&acc)[2][2][4][2], const Unit& u, int wr, int wc, int fr, int fq) const {
        const int row0 = u.pm * BM + wr * 64 + fr, col0 = u.pn * 128 + wc * 32 + 8 * fq;
#pragma unroll
        for (int ai = 0; ai < 2; ++ai)
#pragma unroll
            for (int m = 0; m < 4; ++m) { const int row = row0 + ai * HALF + m * 16; const float rs = __builtin_amdgcn_rsqf(ssq[row] * (1.f / 512.f) + EPS);
                *(u32x4*)(KN + (size_t)row * DM + col0) = pack8(acc[ai][0][m][0] * rs, acc[ai][0][m][1] * rs);
                *(u32x4*)(V + (size_t)row * DM + col0) = pack8(acc[ai][1][m][0] * rs, acc[ai][1][m][1] * rs); }
    }
};
}

namespace att {
constexpr int NW = 8, QBLK = 32, KVBLK = 64, NT = (CTXL + SEQ) / KVBLK;
constexpr int SHM_V = KVBLK * 128 * 2, SHM_K = KVBLK * 192 * 2;
constexpr int NQREG = 6, SHM_QR = (12 - NQREG) * 8192, SHM_ATTN = 2 * SHM_V + 2 * SHM_K + NW * 64 * 4 + SHM_QR;
constexpr float THRL = 8.f * 1.4426950408889634f;
#define KSWZ(row, colB) ((row) * 384 + ((colB) ^ (((row) & 7) << 4)))
#define SBAR() __builtin_amdgcn_sched_barrier(0)
__device__ __forceinline__ int crow(int r, int hi) { return (r & 3) + 8 * (r >> 2) + 4 * hi; }
__device__ __forceinline__ void partialSM(f32x16& p0, f32x16& p1, float& m_reg, float& mn, float& alpha) {
  float pmax = p0[0];
#pragma unroll
  for (int r = 1; r < 16; ++r) pmax = fmaxf(pmax, p0[r]);
#pragma unroll
  for (int r = 0; r < 16; ++r) pmax = fmaxf(pmax, p1[r]);
  { auto rr = __builtin_amdgcn_permlane32_swap(__float_as_uint(pmax), __float_as_uint(pmax), false, false);
    pmax = fmaxf(__uint_as_float(rr[0]), __uint_as_float(rr[1])); }
  if (__builtin_expect(__all(pmax - m_reg <= THRL), 1)) { mn = m_reg; alpha = 1.f; }
  else { mn = fmaxf(m_reg, pmax); alpha = __builtin_amdgcn_exp2f(m_reg - mn); m_reg = mn; }
#pragma unroll
  for (int r = 0; r < 16; ++r) p0[r] = p0[r] - mn;
#pragma unroll
  for (int r = 0; r < 16; ++r) p1[r] = p1[r] - mn;
#pragma unroll
  for (int r = 0; r < 16; ++r) p0[r] = __builtin_amdgcn_exp2f(p0[r]);
}
__device__ __forceinline__ void finishSM(f32x16& p0, f32x16& p1, float alpha, float& l_reg, bf16x8& pa0, bf16x8& pa1, bf16x8& pa2, bf16x8& pa3) {
#pragma unroll
  for (int r = 0; r < 16; ++r) p1[r] = __builtin_amdgcn_exp2f(p1[r]);
  float ps = 0;
#pragma unroll
  for (int r = 0; r < 16; ++r) ps += p0[r];
#pragma unroll
  for (int r = 0; r < 16; ++r) ps += p1[r];
  { auto rr = __builtin_amdgcn_permlane32_swap(__float_as_uint(ps), __float_as_uint(ps), false, false);
    ps = __uint_as_float(rr[0]) + __uint_as_float(rr[1]); }
  l_reg = l_reg * alpha + ps;
#define PK4(P, BASE, OUT) do { unsigned a0 = cvt_pk_bf16(P[BASE + 0], P[BASE + 1]), a1 = cvt_pk_bf16(P[BASE + 2], P[BASE + 3]);   \
    unsigned b0 = cvt_pk_bf16(P[BASE + 4], P[BASE + 5]), b1 = cvt_pk_bf16(P[BASE + 6], P[BASE + 7]);                              \
    auto r0 = __builtin_amdgcn_permlane32_swap(a0, b0, false, false); auto r1 = __builtin_amdgcn_permlane32_swap(a1, b1, false, false); \
    u32x4 w = {r0[0], r1[0], r0[1], r1[1]}; OUT = *reinterpret_cast<bf16x8*>(&w); } while (0)
  PK4(p0, 0, pa0); PK4(p0, 8, pa1); PK4(p1, 0, pa2); PK4(p1, 8, pa3);
#undef PK4
}
__device__ __forceinline__ void qkt(f32x16& p0, f32x16& p1, const char* Ks, const bf16x8* qr, const char* Qr, int r32, int hi) {
  p0 = f32x16{}; p1 = f32x16{};
#pragma unroll
  for (int d0 = 0; d0 < 12; ++d0) { const int cb = (d0 * 16 + hi * 8) * 2;
    bf16x8 b0 = *reinterpret_cast<const bf16x8*>(Ks + KSWZ(r32, cb));
    bf16x8 b1 = *reinterpret_cast<const bf16x8*>(Ks + KSWZ(32 + r32, cb));
    const bf16x8 qf = d0 < NQREG ? qr[d0 < NQREG ? d0 : 0] : *reinterpret_cast<const bf16x8*>(Qr + (d0 - NQREG) * 8192);
    p0 = __builtin_amdgcn_mfma_f32_32x32x16_bf16(b0, qf, p0, 0, 0, 0);
    p1 = __builtin_amdgcn_mfma_f32_32x32x16_bf16(b1, qf, p1, 0, 0, 0); }
}
__device__ __forceinline__ int v_st(int k, int c) { const int kk = (k & ~0xC) | ((k & 4) << 1) | ((k & 8) >> 1); return ((kk >> 3) * 4 + (c >> 5)) * 512 + ((kk & 7) * 32 + (c & 31)) * 2; }
__device__ __forceinline__ int v_rd_base(int lane) { return ((lane & 3) << 3) | (((lane >> 2) & 3) << 6) | (((lane >> 4) & 1) << 5) | (((lane >> 5) & 1) << 8); }
constexpr int v_rd_off(int d0, int ks, int half) { return d0 * 512 + ks * 4096 + half * 2048; }
template <int OFF> __device__ __forceinline__ s16x4 tr_read(int vb) {
  s16x4 r; asm volatile("ds_read_b64_tr_b16 %0, %1 offset:%2" : "=&v"(r) : "v"(vb), "i"(OFF) : "memory"); return r;
}
template <int D0> __device__ __forceinline__ void pv_one(f32x16& od, int vb, bf16x8 pa0, bf16x8 pa1, bf16x8 pa2, bf16x8 pa3) {
  const s16x4 l0 = tr_read<v_rd_off(D0, 0, 0)>(vb), h0 = tr_read<v_rd_off(D0, 0, 1)>(vb), l1 = tr_read<v_rd_off(D0, 1, 0)>(vb), h1 = tr_read<v_rd_off(D0, 1, 1)>(vb);
  const s16x4 l2 = tr_read<v_rd_off(D0, 2, 0)>(vb), h2 = tr_read<v_rd_off(D0, 2, 1)>(vb), l3 = tr_read<v_rd_off(D0, 3, 0)>(vb), h3 = tr_read<v_rd_off(D0, 3, 1)>(vb);
  asm volatile("s_waitcnt lgkmcnt(0)" ::: "memory"); SBAR();
#define PK(L, H) (bf16x8){L[0], L[1], L[2], L[3], H[0], H[1], H[2], H[3]}
  od = __builtin_amdgcn_mfma_f32_32x32x16_bf16(pa0, PK(l0, h0), od, 0, 0, 0);
  od = __builtin_amdgcn_mfma_f32_32x32x16_bf16(pa1, PK(l1, h1), od, 0, 0, 0);
  od = __builtin_amdgcn_mfma_f32_32x32x16_bf16(pa2, PK(l2, h2), od, 0, 0, 0);
  od = __builtin_amdgcn_mfma_f32_32x32x16_bf16(pa3, PK(l3, h3), od, 0, 0, 0);
#undef PK
}
__device__ __forceinline__ void pv_d0(f32x16* o, int vb, bf16x8 pa0, bf16x8 pa1, bf16x8 pa2, bf16x8 pa3) {
  pv_one<0>(o[0], vb, pa0, pa1, pa2, pa3); pv_one<1>(o[1], vb, pa0, pa1, pa2, pa3); pv_one<2>(o[2], vb, pa0, pa1, pa2, pa3); pv_one<3>(o[3], vb, pa0, pa1, pa2, pa3);
}
__device__ __forceinline__ void attn_unit(const bf16_t* __restrict__ Q, const bf16_t* __restrict__ KN, const bf16_t* __restrict__ KR, const bf16_t* __restrict__ V,
                                          const bf16_t* __restrict__ SG, bf16_t* __restrict__ Z, int b, int h, int q0, char* lds) {
  const int tid = threadIdx.x, wid = tid >> 6, lane = tid & 63, r32 = lane & 31, hi = lane >> 5;
  char* V_lds = lds; char* K_lds = lds + 2 * SHM_V;
  float* wsf = (float*)(lds + 2 * SHM_V + 2 * SHM_K) + wid * 64; float* li_l = wsf; float* al_l = wsf + 32;
  char* Qr = lds + 2 * SHM_V + 2 * SHM_K + NW * 64 * 4 + tid * 16;
  float m_reg = -1e30f, l_reg = 0; f32x16 o[4] = {}; bf16x8 qr[NQREG];
  const bf16_t* Qw = Q + (size_t)(q0 + wid * QBLK + r32) * 3072 + h * 192 + hi * 8;
  __syncthreads();
#pragma unroll
  for (int d0 = 0; d0 < NQREG; ++d0) qr[d0] = *reinterpret_cast<const bf16x8*>(Qw + d0 * 16);
#pragma unroll
  for (int d0 = NQREG; d0 < 12; ++d0) *reinterpret_cast<bf16x8*>(Qr + (d0 - NQREG) * 8192) = *reinterpret_cast<const bf16x8*>(Qw + d0 * 16);
  const int sr = tid >> 4, sc = (tid & 15) * 8, vst0 = v_st(sr, sc), vst1 = v_st(32 + sr, sc);
  const int rr = tid >> 3, rc = (tid & 7) * 8;
  const int vb0 = (int)(uintptr_t)V_lds + v_rd_base(lane);
  const bf16_t* KNh = KN + h * 128 + sc; const bf16_t* Vh = V + h * 128 + sc; const bf16_t* KRh = KR + rc;
  bf16x8 vs0, vs1, ks0, ks1, kr0;
#define KROW(j) ((j) < 4 ? ML + b * CTXL + (j) * KVBLK : b * SEQ + ((j) - 4) * KVBLK)
#define SLOAD(j) do { const int rb_ = KROW(j); vs0 = *reinterpret_cast<const bf16x8*>(Vh + (size_t)(rb_ + sr) * DM); vs1 = *reinterpret_cast<const bf16x8*>(Vh + (size_t)(rb_ + 32 + sr) * DM); \
    ks0 = *reinterpret_cast<const bf16x8*>(KNh + (size_t)(rb_ + sr) * DM); ks1 = *reinterpret_cast<const bf16x8*>(KNh + (size_t)(rb_ + 32 + sr) * DM); \
    kr0 = *reinterpret_cast<const bf16x8*>(KRh + (size_t)(rb_ + rr) * 64); } while (0)
#define SWRITE(bb) do { *(bf16x8*)(V_lds + (bb) * SHM_V + vst0) = vs0; *(bf16x8*)(V_lds + (bb) * SHM_V + vst1) = vs1; const int kc = sc * 2;               \
    *(bf16x8*)(K_lds + (bb) * SHM_K + KSWZ(sr, kc)) = ks0; *(bf16x8*)(K_lds + (bb) * SHM_K + KSWZ(32 + sr, kc)) = ks1;                       \
    *(bf16x8*)(K_lds + (bb) * SHM_K + KSWZ(rr, 256 + rc * 2)) = kr0; } while (0)
#define SWAIT() asm volatile("s_waitcnt vmcnt(0)" ::: "memory")
#define RESC(a) do { if (__any((a) < 1.f)) { if (hi == 0) al_l[r32] = (a); asm volatile("s_waitcnt lgkmcnt(0)" ::: "memory"); \
    _Pragma("unroll") for (int d = 0; d < 4; ++d) _Pragma("unroll") for (int r = 0; r < 16; ++r) o[d][r] *= al_l[crow(r, hi)]; } } while (0)
  f32x16 pA0, pA1, pB0, pB1; float mnA, mnB, alA, alB; bf16x8 pa0, pa1, pa2, pa3;
  SLOAD(0); SWAIT(); SWRITE(0); __syncthreads();
  qkt(pA0, pA1, K_lds, qr, Qr, r32, hi); partialSM(pA0, pA1, m_reg, mnA, alA);
  SLOAD(1);
  SWAIT(); SWRITE(1); __syncthreads();
  for (int j = 1; j + 1 < NT; j += 2) {
    SBAR(); qkt(pB0, pB1, K_lds + SHM_K, qr, Qr, r32, hi);
    finishSM(pA0, pA1, alA, l_reg, pa0, pa1, pa2, pa3); SBAR();
    SLOAD(j + 1); SBAR();
    pv_d0(o, vb0, pa0, pa1, pa2, pa3); partialSM(pB0, pB1, m_reg, mnB, alB);
    __syncthreads(); SWAIT(); SWRITE(0);
    RESC(alB); __syncthreads();
    SBAR(); qkt(pA0, pA1, K_lds, qr, Qr, r32, hi);
    finishSM(pB0, pB1, alB, l_reg, pa0, pa1, pa2, pa3); SBAR();
    SLOAD(j + 2); SBAR();
    pv_d0(o, vb0 + SHM_V, pa0, pa1, pa2, pa3); partialSM(pA0, pA1, m_reg, mnA, alA);
    __syncthreads(); SWAIT(); SWRITE(1);
    RESC(alA); __syncthreads();
  }
  SBAR(); qkt(pB0, pB1, K_lds + SHM_K, qr, Qr, r32, hi);
  finishSM(pA0, pA1, alA, l_reg, pa0, pa1, pa2, pa3); SBAR();
  pv_d0(o, vb0, pa0, pa1, pa2, pa3); partialSM(pB0, pB1, m_reg, mnB, alB);
  __syncthreads(); RESC(alB);
  finishSM(pB0, pB1, alB, l_reg, pa0, pa1, pa2, pa3); SBAR();
  pv_d0(o, vb0 + SHM_V, pa0, pa1, pa2, pa3);
  if (hi == 0) li_l[r32] = l_reg; asm volatile("s_waitcnt lgkmcnt(0)" ::: "memory");
  float rli[16];
#pragma unroll
  for (int r = 0; r < 16; ++r) rli[r] = __builtin_amdgcn_rcpf(li_l[crow(r, hi)]);
  const size_t ob = (size_t)(q0 + wid * QBLK) * DM + h * 128 + r32;
#pragma unroll
  for (int r = 0; r < 16; ++r) { const size_t orow = ob + (size_t)crow(r, hi) * DM;
#pragma unroll
    for (int d0 = 0; d0 < 4; ++d0) { const float g = __uint_as_float((unsigned)SG[orow + d0 * 32] << 16); const float z = o[d0][r] * rli[r] * g;
      Z[orow + d0 * 32] = (bf16_t)(cvt_pk_bf16(z, 0.f) & 0xffffu); } }
#undef KROW
#undef SLOAD
#undef SWRITE
#undef SWAIT
#undef RESC
}
}


#define XB_TMO      128
#define XB_XCNT(j)  (256  + 64 * (j))
#define XB_XSUB(j)  (1280 + 64 * (j))
#define XB_XGEN(j)  (2304 + 64 * (j))
#define XB_TOP      3328
#define XB_TOPGEN   3392
#define XCD_BAR_WORDS 3456
#define XB_SPIN_CAP (1u << 22)
__device__ __forceinline__ unsigned xb_ld(unsigned* p)              { return __hip_atomic_load(p, __ATOMIC_RELAXED, __HIP_MEMORY_SCOPE_AGENT); }
__device__ __forceinline__ unsigned xb_add(unsigned* p, unsigned v) { return __hip_atomic_fetch_add(p, v, __ATOMIC_RELAXED, __HIP_MEMORY_SCOPE_AGENT); }
__device__ __forceinline__ unsigned xb_xcc_id() { return (unsigned)__builtin_amdgcn_s_getreg((3 << 11) | 20) & 0xFu; }
#define XB_SPIN(cond, bar) do { unsigned _sp = 0; while (cond) { __builtin_amdgcn_s_sleep(1); \
    if ((++_sp & 255u) == 0u) { if (xb_ld(&(bar)[XB_TMO])) break; if (_sp > XB_SPIN_CAP) { atomicAdd(&(bar)[XB_TMO], 1u); break; } } } } while (0)
struct XcdBarrier { unsigned* bar; unsigned x; volatile LAS unsigned* st; };
__device__ __forceinline__ XcdBarrier xcd_barrier_post(unsigned* bar, volatile LAS unsigned* st) {
    XcdBarrier b; b.bar = bar; b.x = xb_xcc_id(); b.st = st;
    if (threadIdx.x == 0) (void)xb_add(&bar[XB_XCNT(b.x)], 1u);
    return b;
}
__device__ __forceinline__ void xcd_barrier_complete(unsigned* bar, unsigned x, unsigned& nloc, unsigned& nx) {
    const unsigned G = gridDim.x;
    unsigned sum, cnt, mine, sp = 0u;
    for (;;) {
        sum = 0u; cnt = 0u; mine = 0u;
#pragma unroll
        for (unsigned j = 0; j < 16; ++j) { const unsigned c = xb_ld(&bar[XB_XCNT(j)]); sum += c; cnt += (c > 0u) ? 1u : 0u; mine = (j == x) ? c : mine; }
        if (sum == G) break;
        __builtin_amdgcn_s_sleep(1);
        if ((++sp & 255u) == 0u) { if (xb_ld(&bar[XB_TMO])) break; if (sp > XB_SPIN_CAP) { atomicAdd(&bar[XB_TMO], 1u); break; } }
    }
    nloc = mine > 0u ? mine : 1u; nx = cnt > 0u ? cnt : 1u;
}
__device__ __forceinline__ void xcd_barrier(const XcdBarrier& b) {
    asm volatile("s_waitcnt vmcnt(0)" ::: "memory");
    __syncthreads();
    if (threadIdx.x == 0) {
        unsigned* bar = b.bar;
        __builtin_amdgcn_s_waitcnt(0);
        unsigned nloc = b.st[0], nx = b.st[1];
        if (nloc == 0u) { xcd_barrier_complete(bar, b.x, nloc, nx); b.st[0] = nloc; b.st[1] = nx; }
        const unsigned old = xb_add(&bar[XB_XSUB(b.x)], 1u);
        const unsigned gen = old / nloc;
        if (old + 1u == (gen + 1u) * nloc) {
            __builtin_amdgcn_fence(__ATOMIC_RELEASE, "agent");
            asm volatile("s_waitcnt vmcnt(0)" ::: "memory");
            const unsigned og = xb_add(&bar[XB_TOP], 1u);
            const unsigned tg = og / nx;
            if (og + 1u == (tg + 1u) * nx) xb_add(&bar[XB_TOPGEN], 1u);
            else XB_SPIN(xb_ld(&bar[XB_TOPGEN]) == tg, bar);
            __builtin_amdgcn_fence(__ATOMIC_ACQUIRE, "agent");
            xb_add(&bar[XB_XGEN(b.x)], 1u);
            asm volatile("s_waitcnt vmcnt(0)" ::: "memory");
        } else {
            XB_SPIN(xb_ld(&bar[XB_XGEN(b.x)]) == gen, bar);
            __builtin_amdgcn_fence(__ATOMIC_ACQUIRE, "agent");
            asm volatile("s_waitcnt vmcnt(0)" ::: "memory");
        }
    }
    __syncthreads();
}
constexpr int NWAVES = 8;
constexpr int LDS_BYTES = 147456;
constexpr int N_PHASES = 12;
constexpr int MISC_OFF = 135168;

struct Args { const float* in[19]; float* out; unsigned char* ws; int ph_lo, ph_hi; };

struct Frame {
    LAS unsigned char* lds;
    int tid, lane, wave, gw, NGW, G;
    unsigned char* ws;
};

__device__ __forceinline__ void tr_item(const float* W, int K, int N, bf16_t* WT, const float* gk, LAS float* scr, int item, int lane, bool mla_reorder = false) {
    const int nblk = N / 32, kb = item / nblk, nb = item % nblk, k0 = 64 * kb, n0 = 32 * nb;
    const int d0 = mla_reorder ? (nb < 32 ? n0 : (nb < 34 ? n0 + 2048 : n0 - 64)) : n0;
#pragma unroll 8
    for (int i = 0; i < 32; ++i) { const int kk = 2 * i + (lane >> 5); float v = W[(size_t)(k0 + kk) * N + n0 + (lane & 31)]; if (gk) v *= gk[k0 + kk]; scr[kk * 33 + (lane & 31)] = v; }
    asm volatile("s_waitcnt lgkmcnt(0)" ::: "memory");
    const int c = lane & 7;
#pragma unroll
    for (int j = 0; j < 4; ++j) { const int n = (lane >> 3) + 8 * j; const LAS float* s = scr + (8 * c) * 33 + n;
        u32x4 o; o.x = cvt_pk_bf16(s[0 * 33], s[1 * 33]); o.y = cvt_pk_bf16(s[2 * 33], s[3 * 33]); o.z = cvt_pk_bf16(s[4 * 33], s[5 * 33]); o.w = cvt_pk_bf16(s[6 * 33], s[7 * 33]);
        *(u32x4*)(WT + (size_t)(d0 + n) * K + k0 + 8 * c) = o; }
    asm volatile("s_waitcnt lgkmcnt(0)" ::: "memory");
}

__device__ __forceinline__ void gemv_item(const float* c, const float* c_ctx, const float* ada_w, const float* ada_b, float* mod, int it, int lane) {
    const int l = it / 768, rem = it % 768, kc = rem / 24, cgp = rem % 24, k0 = kc * 64;
    float s[9];
#pragma unroll
    for (int r = 0; r < 8; ++r) s[r] = silu_f(c[r * DM + k0 + lane]);
    s[8] = silu_f(c_ctx[k0 + lane]);
    const float* W = ada_w + (size_t)l * DM * 6144 + (size_t)k0 * 6144 + cgp * 256 + lane * 4;
    f32x4 acc[9];
#pragma unroll
    for (int r = 0; r < 9; ++r) acc[r] = (f32x4){0.f, 0.f, 0.f, 0.f};
#pragma unroll 8
    for (int kk = 0; kk < 64; ++kk) { const f32x4 w = *(const f32x4*)(W + (size_t)kk * 6144);
#pragma unroll
        for (int r = 0; r < 9; ++r) { const float sk = __uint_as_float(__builtin_amdgcn_readlane(__float_as_uint(s[r]), kk)); acc[r] += w * sk; } }
    const int col = cgp * 256 + lane * 4;
    f32x4 bv = (f32x4){0.f, 0.f, 0.f, 0.f};
    if (kc == 0) bv = *(const f32x4*)(ada_b + l * 6144 + col);
#pragma unroll
    for (int r = 0; r < 9; ++r) { float* m = mod + (size_t)(l * 9 + r) * 6144 + col;
#pragma unroll
        for (int j = 0; j < 4; ++j) atomicAdd(m + j, acc[r][j] + bv[j]); }
}

__device__ __forceinline__ void load_row_f32(const float* p, int lane, f32x4 (&v)[8]) {
#pragma unroll
    for (int j = 0; j < 8; ++j) v[j] = *(const f32x4*)(p + 4 * lane + 256 * j);
}
__device__ __forceinline__ float sumsq8(const f32x4 (&v)[8]) {
    float s = 0.f;
#pragma unroll
    for (int j = 0; j < 8; ++j) s += (v[j][0] * v[j][0] + v[j][1] * v[j][1]) + (v[j][2] * v[j][2] + v[j][3] * v[j][3]);
    return wave_sum(s);
}
__device__ __forceinline__ void modulate_store(const f32x4 (&v)[8], float rstd, const float* pn, const float* modr, bf16_t* orow, int lane) {
#pragma unroll
    for (int j = 0; j < 8; ++j) { const int col = 4 * lane + 256 * j;
        const f32x4 g = *(const f32x4*)(pn + col), sh = *(const f32x4*)(modr + col), sc = *(const f32x4*)(modr + DM + col);
        const f32x4 hh = v[j] * rstd * g * (sc + 1.f) + sh;
        u32x2 w; w.x = cvt_pk_bf16(hh[0], hh[1]); w.y = cvt_pk_bf16(hh[2], hh[3]);
        *(u32x2*)(orow + col) = w; }
}

__global__ void __launch_bounds__(NWAVES * 64, 2) mk_fwd(Args args) {
    extern __shared__ __attribute__((aligned(16))) unsigned char lds[];
    cg::grid_group grid = cg::this_grid();
    Frame F;
    F.lds = (LAS unsigned char*)lds;
    F.tid = threadIdx.x; F.lane = F.tid & 63; F.wave = __builtin_amdgcn_readfirstlane(F.tid >> 6);
    F.G = gridDim.x; F.gw = blockIdx.x * NWAVES + F.wave; F.NGW = F.G * NWAVES; F.ws = args.ws;
    unsigned char* ws = args.ws;
    const int lo = args.ph_lo, hi = args.ph_hi;
#ifndef PHASE_MASK
#define PHASE_MASK 0xFFF
#endif
#define IN(k) (((PHASE_MASK >> (k)) & 1) && lo <= (k) && (k) < hi)
#define SEAM(k) do { if (IN(k) && IN((k) + 1)) { if ((k) == 0) grid.sync(); else xcd_barrier(bar); } } while (0)
    volatile LAS unsigned* MISC = (volatile LAS unsigned*)(F.lds + MISC_OFF);
    if (F.tid < 16) MISC[F.tid] = 0u;
    __syncthreads();
    XcdBarrier bar; bar.bar = (unsigned*)(args.ws + WS_BAR); bar.x = 0; bar.st = MISC;
    if (hi - lo > 1) bar = xcd_barrier_post((unsigned*)(args.ws + WS_BAR), MISC);
    const float* x = args.in[0]; const float* c = args.in[1]; const float* ctx = args.in[2]; const float* c_ctx = args.in[3];
    const float* ada_w = args.in[4]; const float* ada_b = args.in[5]; const float* pre_norm = args.in[6]; const float* post_norm = args.in[7];
    float* mod = (float*)(ws + WS_MOD); float* ssq = (float*)(ws + WS_SSQ); f32x2* tab = (f32x2*)(ws + WS_TAB);
    bf16_t* WIN = (bf16_t*)(ws + WS_WIN); bf16_t* WG = (bf16_t*)(ws + WS_WG); bf16_t* WOUT = (bf16_t*)(ws + WS_WOUT); bf16_t* WMLA = (bf16_t*)(ws + WS_WMLA);
    bf16_t* WUQ = (bf16_t*)(ws + WS_WUQ); bf16_t* WUKV = (bf16_t*)(ws + WS_WUKV); bf16_t* WMO = (bf16_t*)(ws + WS_WMO);
    bf16_t* H = (bf16_t*)(ws + WS_H); bf16_t* SG = (bf16_t*)(ws + WS_SG); bf16_t* Z = (bf16_t*)(ws + WS_Z); bf16_t* Y = (bf16_t*)(ws + WS_Y);
    bf16_t* U = (bf16_t*)(ws + WS_U); bf16_t* P = (bf16_t*)(ws + WS_P); bf16_t* Q = (bf16_t*)(ws + WS_Q); bf16_t* CQ = (bf16_t*)(ws + WS_CQ);
    bf16_t* CKV = (bf16_t*)(ws + WS_CKV); bf16_t* KR = (bf16_t*)(ws + WS_KR); bf16_t* KN = (bf16_t*)(ws + WS_KN); bf16_t* V = (bf16_t*)(ws + WS_V);
    const int NTHR = F.G * NWAVES * 64;
#define FRESH() int gtid; do { int t_ = threadIdx.x; asm volatile("" : "+v"(t_)); F.tid = t_; F.lane = t_ & 63; gtid = blockIdx.x * (NWAVES * 64) + t_; (void)gtid; } while (0)

    if (IN(0)) { FRESH();
        LAS float* scr = (LAS float*)(F.lds + F.wave * 16384);
        constexpr int I_GEMV = 2 * 32 * 24;
        constexpr int I_WIN = 32 * 128, I_WG = 4 * 8 * 16, I_WOUT = 32 * 64, I_WMLA = 32 * 98, I_WUQ = 8 * 96, I_WUKV = 8 * 128, I_WMO = 32 * 64;
        constexpr int NITEMS = I_GEMV + I_WIN + I_WG + I_WOUT + I_WMLA + I_WUQ + I_WUKV + I_WMO;
        for (int it = F.gw; it < NITEMS; it += F.NGW) {
            int r = it;
            if (r < I_GEMV) { gemv_item(c, c_ctx, ada_w, ada_b, mod, r, F.lane); continue; } r -= I_GEMV;
            if (r < I_WIN) { tr_item(args.in[8], DM, 4096, WIN, nullptr, scr, r, F.lane); continue; } r -= I_WIN;
            if (r < I_WG) { const int g = r / 128; tr_item(args.in[9] + (size_t)g * 512 * 512, 512, 512, WG + (size_t)g * 512 * 512, nullptr, scr, r % 128, F.lane); continue; } r -= I_WG;
            if (r < I_WOUT) { tr_item(args.in[12], DM, DM, WOUT, nullptr, scr, r, F.lane); continue; } r -= I_WOUT;
            if (r < I_WMLA) { tr_item(args.in[13], DM, 3136, WMLA, nullptr, scr, r, F.lane, true); continue; } r -= I_WMLA;
            if (r < I_WUQ) { tr_item(args.in[16], 512, 3072, WUQ, args.in[14], scr, r, F.lane); continue; } r -= I_WUQ;
            if (r < I_WUKV) { tr_item(args.in[17], 512, 4096, WUKV, args.in[15], scr, r, F.lane); continue; } r -= I_WUKV;
            tr_item(args.in[18], DM, DM, WMO, nullptr, scr, r, F.lane);
        }
        for (int i = gtid; i < (NMLA - 3136) * DM / 8; i += NTHR) *(u32x4*)(WMLA + (size_t)3136 * DM + (size_t)i * 8) = (u32x4){0u, 0u, 0u, 0u};
        if (gtid < 1024) { const int pos = gtid >> 4, i = gtid & 15; const float fr = powf(10000.f, -(float)i / 16.f); const float ang = (float)pos * fr; float sn, cs; sincosf(ang, &sn, &cs); tab[gtid] = (f32x2){cs, sn}; }
    }
    SEAM(0);
    if (IN(1)) { FRESH();
        for (int row = F.gw; row < MT; row += F.NGW) {
            const bool lat = row < ML; const float* src = lat ? x + (size_t)row * DM : ctx + (size_t)(row - ML) * DM; const int r = lat ? row / SEQ : 8;
            f32x4 v[8]; load_row_f32(src, F.lane, v);
            const float rstd = __builtin_amdgcn_rsqf(sumsq8(v) * (1.f / DM) + EPS);
            modulate_store(v, rstd, pre_norm, mod + (size_t)r * 6144, H + (size_t)row * DM, F.lane);
        }
    }
    SEAM(1);
    if (IN(2)) {
        pg8::Gemm g{H, WIN, MT, 4096, DM, DM, DM, 0}; pg8::StaticOrder S; S.init(MT, 4096, F.G, (int)blockIdx.x);
        pg8::EpiPoolIn E{U, SG};
        pg8::gemm_phase<pg8::EpiPoolIn>(F.lds, g, S, E);
    }
    SEAM(2);
    if (IN(3)) { FRESH();
        for (int item = gtid; item < (MT / 16) * 256; item += NTHR) {
            const int cc = item & 255, row0 = (item >> 8) * 16;
            int base, L; if (row0 < ML) { base = row0 & ~(SEQ - 1); L = SEQ; } else { base = ML + ((row0 - ML) & ~(CTXL - 1)); L = CTXL; }
            const int t0 = row0 - base, gidx = cc >> 6, win = 2 << gidx, left = win >> 1, right = win - 1 - left;
            const bf16_t* Ub = U + (size_t)base * DM + cc * 8; bf16_t* Pb = P + (size_t)base * DM + cc * 8;
            float S8[8];
#pragma unroll
            for (int e = 0; e < 8; ++e) S8[e] = 0.f;
            const int ta = t0 - left < 0 ? 0 : t0 - left, tb = t0 + right > L - 1 ? L - 1 : t0 + right;
            for (int t = ta; t <= tb; ++t) { const u32x4 w = *(const u32x4*)(Ub + (size_t)t * DM);
                S8[0] += bf_lo(w.x); S8[1] += bf_hi(w.x); S8[2] += bf_lo(w.y); S8[3] += bf_hi(w.y); S8[4] += bf_lo(w.z); S8[5] += bf_hi(w.z); S8[6] += bf_lo(w.w); S8[7] += bf_hi(w.w); }
#pragma unroll 4
            for (int i = 0; i < 16; ++i) { const int t = t0 + i; const int lo_ = t - left < 0 ? 0 : t - left, hi_ = t + right + 1 > L ? L : t + right + 1;
                const float inv = 1.f / (float)(hi_ - lo_);
                const u32x4 w = *(const u32x4*)(Ub + (size_t)t * DM);
                u32x4 o; o.x = cvt_pk_bf16(S8[0] * inv - bf_lo(w.x), S8[1] * inv - bf_hi(w.x)); o.y = cvt_pk_bf16(S8[2] * inv - bf_lo(w.y), S8[3] * inv - bf_hi(w.y));
                o.z = cvt_pk_bf16(S8[4] * inv - bf_lo(w.z), S8[5] * inv - bf_hi(w.z)); o.w = cvt_pk_bf16(S8[6] * inv - bf_lo(w.w), S8[7] * inv - bf_hi(w.w));
                *(u32x4*)(Pb + (size_t)t * DM) = o;
                const int tn = t + 1 + right, to = t - left;
                if (tn < L) { const u32x4 a = *(const u32x4*)(Ub + (size_t)tn * DM);
                    S8[0] += bf_lo(a.x); S8[1] += bf_hi(a.x); S8[2] += bf_lo(a.y); S8[3] += bf_hi(a.y); S8[4] += bf_lo(a.z); S8[5] += bf_hi(a.z); S8[6] += bf_lo(a.w); S8[7] += bf_hi(a.w); }
                if (to >= 0) { const u32x4 a = *(const u32x4*)(Ub + (size_t)to * DM);
                    S8[0] -= bf_lo(a.x); S8[1] -= bf_hi(a.x); S8[2] -= bf_lo(a.y); S8[3] -= bf_hi(a.y); S8[4] -= bf_lo(a.z); S8[5] -= bf_hi(a.z); S8[6] -= bf_lo(a.w); S8[7] -= bf_hi(a.w); }
            }
        }
    }
    SEAM(3);
    if (IN(4)) {
        pg8::Gemm g{P, WG, MT, DM, 512, DM, 512, 2}; pg8::StaticOrder S; S.init(MT, DM, F.G, (int)blockIdx.x);
        pg8::EpiGrp E{SG, Z, args.in[10], args.in[11]};
        pg8::gemm_phase<pg8::EpiGrp>(F.lds, g, S, E);
    }
    SEAM(4);
    if (IN(5)) {
        pg8::Gemm g{Z, WOUT, MT, DM, DM, DM, DM, 0}; pg8::StaticOrder S; S.init(MT, DM, F.G, (int)blockIdx.x);
        pg8::EpiPlain E{Y, DM};
        pg8::gemm_phase<pg8::EpiPlain>(F.lds, g, S, E);
    }
    SEAM(5);
    if (IN(6)) { FRESH();
        for (int row = F.gw; row < MT; row += F.NGW) {
            const bool lat = row < ML; const float* src = lat ? x + (size_t)row * DM : ctx + (size_t)(row - ML) * DM; const int r = lat ? row / SEQ : 8;
            f32x4 v[8], y[8]; load_row_f32(src, F.lane, v);
            const bf16_t* yr = Y + (size_t)row * DM;
#pragma unroll
            for (int j = 0; j < 8; ++j) { const u32x2 w = *(const u32x2*)(yr + 4 * F.lane + 256 * j); y[j] = (f32x4){bf_lo(w.x), bf_hi(w.x), bf_lo(w.y), bf_hi(w.y)}; }
            const float rsy = __builtin_amdgcn_rsqf(sumsq8(y) * (1.f / DM) + EPS);
            const float* m0 = mod + (size_t)r * 6144;
#pragma unroll
            for (int j = 0; j < 8; ++j) { const int col = 4 * F.lane + 256 * j; const f32x4 gt = *(const f32x4*)(m0 + 2 * DM + col), pn = *(const f32x4*)(post_norm + col);
                v[j] = v[j] + gt * (y[j] * rsy * pn);
                if (lat) *(f32x4*)(args.out + (size_t)row * DM + col) = v[j]; }
            const float rstd = __builtin_amdgcn_rsqf(sumsq8(v) * (1.f / DM) + EPS);
            modulate_store(v, rstd, pre_norm + DM, mod + (size_t)(9 + r) * 6144, H + (size_t)row * DM, F.lane);
        }
    }
    SEAM(6);
    if (IN(7)) {
        pg8::Gemm g{H, WMLA, MT, NMLA, DM, DM, DM, 0}; pg8::StaticOrder S; S.init(MT, NMLA, F.G, (int)blockIdx.x);
        pg8::EpiMlaIn E{CQ, CKV, KR, SG, ssq, tab};
        pg8::gemm_phase<pg8::EpiMlaIn>(F.lds, g, S, E);
    }
    SEAM(7);
    if (IN(8)) {
        { pg8::Gemm g{CQ, WUQ, ML, 3072, 512, 512, 512, 0}; pg8::StaticOrder S; S.init(ML, 3072, F.G, (int)blockIdx.x);
          pg8::EpiQ E{Q, ssq, tab};
          pg8::gemm_phase<pg8::EpiQ>(F.lds, g, S, E); }
        { pg8::Gemm g{CKV, WUKV, MT, 4096, 512, 512, 512, 0}; pg8::StaticOrder S; S.init(MT, 4096, F.G, (int)blockIdx.x);
          pg8::EpiKV E{KN, V, ssq + MT};
          pg8::gemm_phase<pg8::EpiKV>(F.lds, g, S, E); }
    }
    SEAM(8);
    if (IN(9)) {
        const int bx = blockIdx.x, vcu = (F.G % 8 == 0) ? (bx % 8) * (F.G / 8) + bx / 8 : bx;
        for (int un = vcu; un < NB * 16 * (SEQ / 256); un += F.G) {
            const int qb = un & 7, h = (un >> 3) & 15, b = un >> 7;
            att::attn_unit(Q, KN, KR, V, SG, Z, b, h, b * SEQ + qb * 256, (char*)lds);
        }
    }
    SEAM(9);
    if (IN(10)) {
        pg8::Gemm g{Z, WMO, ML, DM, DM, DM, DM, 0}; pg8::StaticOrder S; S.init(ML, DM, F.G, (int)blockIdx.x);
        pg8::EpiPlain E{Y, DM};
        pg8::gemm_phase<pg8::EpiPlain>(F.lds, g, S, E);
    }
    SEAM(10);
    if (IN(11)) { FRESH();
        for (int row = F.gw; row < ML; row += F.NGW) {
            const int r = row / SEQ;
            f32x4 v[8], y[8]; load_row_f32(args.out + (size_t)row * DM, F.lane, v);
            const bf16_t* yr = Y + (size_t)row * DM;
#pragma unroll
            for (int j = 0; j < 8; ++j) { const u32x2 w = *(const u32x2*)(yr + 4 * F.lane + 256 * j); y[j] = (f32x4){bf_lo(w.x), bf_hi(w.x), bf_lo(w.y), bf_hi(w.y)}; }
            const float rsy = __builtin_amdgcn_rsqf(sumsq8(y) * (1.f / DM) + EPS);
            const float* m1 = mod + (size_t)(9 + r) * 6144;
#pragma unroll
            for (int j = 0; j < 8; ++j) { const int col = 4 * F.lane + 256 * j; const f32x4 gt = *(const f32x4*)(m1 + 2 * DM + col), pn = *(const f32x4*)(post_norm + DM + col);
                *(f32x4*)(args.out + (size_t)row * DM + col) = v[j] + gt * (y[j] * rsy * pn); }
        }
    }
#undef IN
#undef SEAM
}

extern "C" void kernel_launch(void* const* d_in, const int* in_sizes, int n_in, void* d_out, int out_size, void* d_ws, size_t ws_size, hipStream_t stream) {
    static int grid = 0;
    if (grid == 0) {
        if (n_in != 19 || out_size != ML * DM || ws_size < WS_END) { fprintf(stderr, "kernel_launch: unexpected shapes (n_in %d out %d ws %zu)\n", n_in, out_size, ws_size); grid = -1; return; }
        int dev = 0, cus = 0, per_cu = 0;
        hipGetDevice(&dev); hipDeviceGetAttribute(&cus, hipDeviceAttributeMultiprocessorCount, dev);
        if (hipFuncSetAttribute((const void*)mk_fwd, hipFuncAttributeMaxDynamicSharedMemorySize, LDS_BYTES) != hipSuccess) { fprintf(stderr, "kernel_launch: hipFuncSetAttribute failed\n"); grid = -1; return; }
        hipOccupancyMaxActiveBlocksPerMultiprocessor(&per_cu, (const void*)mk_fwd, NWAVES * 64, LDS_BYTES);
        (void)hipGetLastError();
        if (per_cu < 1) per_cu = 1;
        grid = cus * 1;
        (void)per_cu;
    }
    if (grid < 0) return;
    hipMemsetAsync((char*)d_ws, 0, CTL_ZERO_BYTES, stream);
    Args a{};
    for (int i = 0; i < 19; ++i) a.in[i] = (const float*)d_in[i];
    a.out = (float*)d_out; a.ws = (unsigned char*)d_ws;
#if MK_N_LAUNCHES == 1
    a.ph_lo = 0; a.ph_hi = N_PHASES;
    void* kargs[] = {&a};
    hipError_t e = hipLaunchCooperativeKernel((const void*)mk_fwd, dim3(grid), dim3(NWAVES * 64), kargs, LDS_BYTES, stream);
    if (e != hipSuccess) fprintf(stderr, "cooperative launch failed: %s (grid %d)\n", hipGetErrorString(e), grid);
#else
    for (int p = 0; p < N_PHASES; ++p) { a.ph_lo = p; a.ph_hi = p + 1; hipLaunchKernelGGL(mk_fwd, dim3(grid), dim3(NWAVES * 64), LDS_BYTES, stream, a); }
#endif
}
```

```cpp
#include <hip/hip_runtime.h>
#include <hip/hip_cooperative_groups.h>
#include <hip/hip_bf16.h>
#include <cstdio>
#include <cstdint>
namespace cg = cooperative_groups;

#ifndef MK_N_LAUNCHES
#define MK_N_LAUNCHES 1
#endif

#define LAS __attribute__((address_space(3)))
typedef unsigned short bf16_t;
typedef short bf16x8 __attribute__((ext_vector_type(8)));
typedef short s16x4 __attribute__((ext_vector_type(4)));
typedef float f32x4 __attribute__((ext_vector_type(4)));
typedef float f32x2 __attribute__((ext_vector_type(2)));
typedef float f32x16 __attribute__((ext_vector_type(16)));
typedef unsigned u32x4 __attribute__((ext_vector_type(4)));
typedef unsigned u32x2 __attribute__((ext_vector_type(2)));

constexpr int DM = 2048, NB = 8, SEQ = 2048, CTXL = 256;
constexpr int ML = NB * SEQ, MC = NB * CTXL, MT = ML + MC;
constexpr int NMLA = 3328;
constexpr float EPS = 1e-6f;
constexpr float QSCALE = 0.07216878364870322f * 1.4426950408889634f;

constexpr size_t MiB = 1u << 20;
constexpr size_t WS_MOD = 0;
constexpr size_t WS_SSQ = 512 * 1024;
constexpr size_t WS_BAR = 768 * 1024;
constexpr size_t CTL_ZERO_BYTES = 1 * MiB;
constexpr size_t WS_TAB = 1 * MiB;
constexpr size_t WS_WIN = 2 * MiB, WS_WG = 18 * MiB, WS_WOUT = 20 * MiB, WS_WMLA = 28 * MiB, WS_WUQ = 41 * MiB, WS_WUKV = 44 * MiB, WS_WMO = 48 * MiB;
constexpr size_t WS_H = 64 * MiB, WS_SG = 136 * MiB, WS_Z = 208 * MiB, WS_Y = 280 * MiB, WS_U = 352 * MiB, WS_P = 424 * MiB;
constexpr size_t WS_Q = 352 * MiB, WS_CQ = 448 * MiB, WS_CKV = 466 * MiB, WS_KR = 484 * MiB, WS_KN = WS_H, WS_V = WS_Y;
constexpr size_t WS_END = 496 * MiB;

__device__ __forceinline__ unsigned cvt_pk_bf16(float lo, float hi) { unsigned r; asm volatile("v_cvt_pk_bf16_f32 %0, %1, %2" : "=v"(r) : "v"(lo), "v"(hi)); return r; }
__device__ __forceinline__ float bf_lo(unsigned w) { return __uint_as_float(w << 16); }
__device__ __forceinline__ float bf_hi(unsigned w) { return __uint_as_float(w & 0xffff0000u); }
__device__ __forceinline__ float silu_f(float v) { return v * __builtin_amdgcn_rcpf(1.f + __builtin_amdgcn_exp2f(-1.4426950408889634f * v)); }
__device__ __forceinline__ float wave_sum(float v) {
#pragma unroll
    for (int o = 1; o < 64; o <<= 1) v += __shfl_xor(v, o);
    return v;
}

namespace pg8 {
constexpr int BM = 256, BK = 64, HALF = 128, HTB = HALF * BK * 2, STAGE_BYTES = 8 * HTB, NXCD = 8, WGM = 8;
__host__ __device__ __forceinline__ int lds_byte(int r, int c) { const int st = (r >> 4) * 2 + (c >> 5), rr = r & 15, cc = c & 31, ob = rr * 64 + cc * 2; return st * 1024 + (ob ^ (((ob >> 9) & 1) << 5)); }
__host__ __device__ __forceinline__ void stage_rc(int b, int& R, int& C) { const int st = b / 1024, sb = b % 1024, swz = sb ^ (((sb >> 9) & 1) << 5); R = (st >> 1) * 16 + swz / 64; C = (st & 1) * 32 + (swz % 64) / 2; }
__host__ __device__ __forceinline__ int perm32(int rho) { const int n = rho >> 4, i = rho & 15; return 8 * (i >> 2) + 4 * n + (i & 3); }

struct Unit { int pm, pn; };
struct Gemm { const bf16_t* A; const bf16_t* Bt; int M, N, K, lda, ldb, agrp; };

struct StaticOrder {
    int nM, nN, nwg, G, c;
    __host__ __device__ void init(int M, int N, int G_, int c_) { nM = M / BM; nN = N / BM; nwg = nM * nN; G = G_; c = c_; }
    __host__ __device__ bool next(int i, Unit& u) const {
        const long L = (long)i * G + c; if (L >= nwg) return false;
        int wgid = (int)L; { const int q = nwg / NXCD, r = nwg % NXCD, xcd = wgid % NXCD, off = wgid / NXCD; wgid = (xcd < r ? xcd * (q + 1) : r * (q + 1) + (xcd - r) * q) + off; }
        const int nig = WGM * nN, gid = wgid / nig, fm = gid * WGM, gsz = (nM - fm) < WGM ? (nM - fm) : WGM;
        u.pm = fm + ((wgid % nig) % gsz); u.pn = (wgid % nig) / gsz; return true;
    }
};

template <class Epi>
__device__ __forceinline__ void gemm_phase(LAS unsigned char* lds, const Gemm g, const StaticOrder& S, const Epi& E) {
    const int tid = threadIdx.x, wid = __builtin_amdgcn_readfirstlane(tid >> 6), lane = tid & 63, wr = wid >> 2, wc = wid & 3, fr = lane & 15, fq = lane >> 4;
    const int K = g.K, nt = K / BK;
    unsigned voffA[2], voffB[2];
#pragma unroll
    for (int i = 0; i < 2; ++i) { int R, C; stage_rc(tid * 16 + i * 8192, R, C); const int Rb = Epi::PERM ? ((R & ~31) + perm32(R & 31)) : R;
        voffA[i] = (unsigned)(R * g.lda + C) * 2u; voffB[i] = (unsigned)(Rb * g.ldb + C) * 2u; }
    const size_t kstep = (size_t)(BK * 2);
    const size_t hsA = (size_t)HALF * g.lda * 2, hsB = (size_t)HALF * g.ldb * 2;
    const size_t tsA = 2 * hsA, tsB = 2 * hsB;
    const unsigned ldsw = (unsigned)wid * 1024u;
    const int aoff = lds_byte(wr * 64 + fr, fq * 8), boff = lds_byte(wc * 32 + fr, fq * 8);
#define PG8_SA(b, h) (((b) * 2 + (h)) * HTB)
#define PG8_SB(b, h) ((4 + (b) * 2 + (h)) * HTB)
#define PG8_STAGE(bufoff, gbase, voff) do { _Pragma("unroll") for (int _i = 0; _i < 2; ++_i) \
        __builtin_amdgcn_global_load_lds((const unsigned*)((const char*)(gbase) + (voff)[_i]), (LAS unsigned*)(lds + (bufoff) + ldsw + _i * 8192), 16, 0, 0); } while (0)
#define PG8_LDA(dst, b, h) do { _Pragma("unroll") for (int m = 0; m < 4; ++m) _Pragma("unroll") for (int k = 0; k < 2; ++k) dst[m][k] = *(const LAS bf16x8*)(lds + PG8_SA(b, h) + aoff + m * 2048 + k * 1024); } while (0)
#define PG8_LDB(dst, b, h) do { _Pragma("unroll") for (int n = 0; n < 2; ++n) _Pragma("unroll") for (int k = 0; k < 2; ++k) dst[n][k] = *(const LAS bf16x8*)(lds + PG8_SB(b, h) + boff + n * 2048 + k * 1024); } while (0)
#define PG8_MMA(ai, bj, At, Bt) do { __builtin_amdgcn_s_setprio(1); _Pragma("unroll") for (int m = 0; m < 4; ++m) _Pragma("unroll") for (int n = 0; n < 2; ++n) _Pragma("unroll") for (int k = 0; k < 2; ++k) \
        acc[ai][bj][m][n] = __builtin_amdgcn_mfma_f32_16x16x32_bf16(Bt[n][k], At[m][k], acc[ai][bj][m][n], 0, 0, 0); __builtin_amdgcn_s_setprio(0); } while (0)
#define PG8_WAIT_V(n) asm volatile("s_waitcnt vmcnt(" #n ")" ::: "memory")
#define PG8_WAIT_L(n) asm volatile("s_waitcnt lgkmcnt(" #n ")" ::: "memory")
#define PG8_BAR __builtin_amdgcn_s_barrier()
#define PG8_SCHED __builtin_amdgcn_sched_barrier(0)
#define PG8_AOFF(u) ((g.agrp > 0) ? (size_t)((u).pn / g.agrp) * (size_t)K * 2 : (size_t)0)
    Unit cur, nxt; int ui = 0;
    if (!S.next(0, cur)) return;
    f32x4 acc[2][2][4][2];
#pragma unroll
    for (int a = 0; a < 2; ++a)
#pragma unroll
        for (int b = 0; b < 2; ++b)
#pragma unroll
            for (int m = 0; m < 4; ++m)
#pragma unroll
                for (int n = 0; n < 2; ++n) acc[a][b][m][n] = (f32x4){0.f, 0.f, 0.f, 0.f};
    bf16x8 At[4][2], B0[2][2], B1[2][2];
    const char* cA = (const char*)g.A + (size_t)cur.pm * tsA + PG8_AOFF(cur); const char* cB = (const char*)g.Bt + (size_t)cur.pn * tsB;
    PG8_STAGE(PG8_SB(0, 0), cB, voffB); PG8_STAGE(PG8_SB(0, 1), cB + hsB, voffB); PG8_STAGE(PG8_SA(0, 0), cA, voffA); PG8_STAGE(PG8_SA(0, 1), cA + hsA, voffA);
    if (wr == 1) PG8_BAR;
    PG8_WAIT_V(2); PG8_BAR;
    PG8_STAGE(PG8_SB(1, 0), cB + kstep, voffB); PG8_STAGE(PG8_SA(1, 0), cA + kstep, voffA); PG8_STAGE(PG8_SB(1, 1), cB + hsB + kstep, voffB);
    PG8_WAIT_V(6); PG8_BAR;
    for (;;) {
        const bool has_next = S.next(ui + 1, nxt);
        const char* nA = has_next ? (const char*)g.A + (size_t)nxt.pm * tsA + PG8_AOFF(nxt) : cA; const char* nB = has_next ? (const char*)g.Bt + (size_t)nxt.pn * tsB : cB;
        for (int t = 0; t < nt; t += 2) {
            const bool last = (t == nt - 2);
            const char* a1 = cA + (size_t)(t + 1) * kstep;
            const char* a2 = last ? nA : cA + (size_t)(t + 2) * kstep; const char* b2 = last ? nB : cB + (size_t)(t + 2) * kstep;
            const char* a3 = a2 + kstep; const char* b3 = b2 + kstep;
            PG8_LDB(B0, 0, 0); PG8_LDB(B1, 0, 1); PG8_SCHED; PG8_LDA(At, 0, 0); PG8_STAGE(PG8_SA(1, 1), a1 + hsA, voffA);
            PG8_WAIT_V(8); PG8_WAIT_L(0); PG8_BAR; PG8_MMA(0, 0, At, B0); PG8_MMA(0, 1, At, B1); PG8_BAR; PG8_SCHED;
            PG8_LDA(At, 0, 1); PG8_STAGE(PG8_SB(0, 0), b2, voffB); PG8_STAGE(PG8_SB(0, 1), b2 + hsB, voffB); PG8_STAGE(PG8_SA(0, 0), a2, voffA);
            PG8_WAIT_V(8); PG8_WAIT_L(0); PG8_BAR; PG8_MMA(1, 0, At, B0); PG8_MMA(1, 1, At, B1); PG8_BAR; PG8_SCHED;
            PG8_LDB(B0, 1, 0); PG8_LDB(B1, 1, 1); PG8_SCHED; PG8_LDA(At, 1, 0); PG8_STAGE(PG8_SA(0, 1), a2 + hsA, voffA);
            PG8_WAIT_V(8); PG8_WAIT_L(0); PG8_BAR; PG8_MMA(0, 0, At, B0); PG8_MMA(0, 1, At, B1); PG8_BAR; PG8_SCHED;
            PG8_LDA(At, 1, 1); PG8_STAGE(PG8_SB(1, 0), b3, voffB); PG8_STAGE(PG8_SB(1, 1), b3 + hsB, voffB); PG8_STAGE(PG8_SA(1, 0), a3, voffA);
            PG8_WAIT_V(8); PG8_WAIT_L(0); PG8_BAR; PG8_MMA(1, 0, At, B0); PG8_MMA(1, 1, At, B1); PG8_BAR; PG8_SCHED;
        }
        if (wr == 0) PG8_BAR;
        E(acc, cur, wr, wc, fr, fq);
        if (!has_next) break;
#pragma unroll
        for (int a = 0; a < 2; ++a)
#pragma unroll
            for (int b = 0; b < 2; ++b)
#pragma unroll
                for (int m = 0; m < 4; ++m)
#pragma unroll
                    for (int n = 0; n < 2; ++n) acc[a][b][m][n] = (f32x4){0.f, 0.f, 0.f, 0.f};
        cur = nxt; cA = nA; cB = nB; ++ui;
        if (wr == 1) PG8_BAR;
    }
    PG8_WAIT_V(0);
    PG8_BAR;
#undef PG8_SA
#undef PG8_SB
#undef PG8_STAGE
#undef PG8_LDA
#undef PG8_LDB
#undef PG8_MMA
#undef PG8_WAIT_V
#undef PG8_WAIT_L
#undef PG8_BAR
#undef PG8_SCHED
#undef PG8_AOFF
}

__device__ __forceinline__ u32x4 pack8(f32x4 v0, f32x4 v1) { u32x4 w; w.x = cvt_pk_bf16(v0[0], v0[1]); w.y = cvt_pk_bf16(v0[2], v0[3]); w.z = cvt_pk_bf16(v1[0], v1[1]); w.w = cvt_pk_bf16(v1[2], v1[3]); return w; }
__device__ __forceinline__ f32x4 silu4(f32x4 v) { return (f32x4){silu_f(v[0]), silu_f(v[1]), silu_f(v[2]), silu_f(v[3])}; }

struct EpiPlain {
    static constexpr bool PERM = true;
    bf16_t* O; int ldc;
    __device__ __forceinline__ void operator()(const f32x4 (&acc)[2][2][4][2], const Unit& u, int wr, int wc, int fr, int fq) const {
        const int row0 = u.pm * BM + wr * 64 + fr, col0 = u.pn * BM + wc * 32 + 8 * fq;
#pragma unroll
        for (int ai = 0; ai < 2; ++ai)
#pragma unroll
            for (int m = 0; m < 4; ++m) { bf16_t* rowp = O + (size_t)(row0 + ai * HALF + m * 16) * ldc + col0;
#pragma unroll
                for (int bj = 0; bj < 2; ++bj) *(u32x4*)(rowp + bj * HALF) = pack8(acc[ai][bj][m][0], acc[ai][bj][m][1]); }
    }
};
struct EpiPoolIn {
    static constexpr bool PERM = true;
    bf16_t* U; bf16_t* SG;
    __device__ __forceinline__ void operator()(const f32x4 (&acc)[2][2][4][2], const Unit& u, int wr, int wc, int fr, int fq) const {
        const int t = u.pn >> 3; bf16_t* base = t ? SG : U;
        const int row0 = u.pm * BM + wr * 64 + fr, col0 = (u.pn & 7) * BM + wc * 32 + 8 * fq;
#pragma unroll
        for (int ai = 0; ai < 2; ++ai)
#pragma unroll
            for (int m = 0; m < 4; ++m) { bf16_t* rowp = base + (size_t)(row0 + ai * HALF + m * 16) * DM + col0;
#pragma unroll
                for (int bj = 0; bj < 2; ++bj) { f32x4 v0 = acc[ai][bj][m][0], v1 = acc[ai][bj][m][1];
                    if (t) { v0 = silu4(v0); v1 = silu4(v1); }
                    *(u32x4*)(rowp + bj * HALF) = pack8(v0, v1); } }
    }
};
struct EpiGrp {
    static constexpr bool PERM = true;
    const bf16_t* SG; bf16_t* Z; const float* bias; const float* scale;
    __device__ __forceinline__ void operator()(const f32x4 (&acc)[2][2][4][2], const Unit& u, int wr, int wc, int fr, int fq) const {
        const int row0 = u.pm * BM + wr * 64 + fr, col0 = u.pn * BM + wc * 32 + 8 * fq;
        f32x4 bv[2][2], sv[2][2];
#pragma unroll
        for (int bj = 0; bj < 2; ++bj)
#pragma unroll
            for (int n = 0; n < 2; ++n) { bv[bj][n] = *(const f32x4*)(bias + col0 + bj * HALF + 4 * n); sv[bj][n] = *(const f32x4*)(scale + col0 + bj * HALF + 4 * n); }
#pragma unroll
        for (int ai = 0; ai < 2; ++ai)
#pragma unroll
            for (int m = 0; m < 4; ++m) { const size_t off = (size_t)(row0 + ai * HALF + m * 16) * DM + col0;
#pragma unroll
                for (int bj = 0; bj < 2; ++bj) { const u32x4 gw = *(const u32x4*)(SG + off + bj * HALF);
                    f32x4 v0 = (acc[ai][bj][m][0] + bv[bj][0]) * sv[bj][0], v1 = (acc[ai][bj][m][1] + bv[bj][1]) * sv[bj][1];
                    v0 = v0 * (f32x4){bf_lo(gw.x), bf_hi(gw.x), bf_lo(gw.y), bf_hi(gw.y)}; v1 = v1 * (f32x4){bf_lo(gw.z), bf_hi(gw.z), bf_lo(gw.w), bf_hi(gw.w)};
                    *(u32x4*)(Z + off + bj * HALF) = pack8(v0, v1); } }
    }
};
struct EpiMlaIn {
    static constexpr bool PERM = true;
    bf16_t *CQ, *CKV, *KR, *SG; float* ssq; const f32x2* tab;
    __device__ __forceinline__ void operator()(const f32x4 (&acc)[2][2][4][2], const Unit& u, int wr, int wc, int fr, int fq) const {
        const int pn = u.pn, row0 = u.pm * BM + wr * 64 + fr;
        if (pn < 4) {
            bf16_t* base = pn < 2 ? CQ : CKV; float* ss = ssq + (pn < 2 ? 0 : MT);
            const int col0 = (pn & 1) * BM + wc * 32 + 8 * fq;
#pragma unroll
            for (int ai = 0; ai < 2; ++ai)
#pragma unroll
                for (int m = 0; m < 4; ++m) { const int row = row0 + ai * HALF + m * 16; bf16_t* rowp = base + (size_t)row * 512 + col0; float s = 0.f;
#pragma unroll
                    for (int bj = 0; bj < 2; ++bj) { const f32x4 v0 = acc[ai][bj][m][0], v1 = acc[ai][bj][m][1];
                        s += (v0[0] * v0[0] + v0[1] * v0[1]) + (v0[2] * v0[2] + v0[3] * v0[3]) + (v1[0] * v1[0] + v1[1] * v1[1]) + (v1[2] * v1[2] + v1[3] * v1[3]);
                        *(u32x4*)(rowp + bj * HALF) = pack8(v0, v1); }
                    s += __shfl_xor(s, 16); s += __shfl_xor(s, 32);
                    if (fq == 0) atomicAdd(ss + row, s); }
        } else if (pn < 12) {
            if (u.pm < ML / BM) {
                const int col0 = (pn - 4) * BM + wc * 32 + 8 * fq;
#pragma unroll
                for (int ai = 0; ai < 2; ++ai)
#pragma unroll
                    for (int m = 0; m < 4; ++m) { bf16_t* rowp = SG + (size_t)(row0 + ai * HALF + m * 16) * DM + col0;
#pragma unroll
                        for (int bj = 0; bj < 2; ++bj) *(u32x4*)(rowp + bj * HALF) = pack8(silu4(acc[ai][bj][m][0]), silu4(acc[ai][bj][m][1])); }
            }
        } else {
            if (wc < 2) {
                const bool lat = u.pm < ML / BM;
#pragma unroll
                for (int ai = 0; ai < 2; ++ai)
#pragma unroll
                    for (int m = 0; m < 4; ++m) { const int row = row0 + ai * HALF + m * 16;
                        f32x4 v0 = acc[ai][0][m][0], v1 = acc[ai][0][m][1];
                        if (lat) {
                            const int t = row & (SEQ - 1), pos = wc == 0 ? (t >> 6) : (t & 63);
                            const f32x2* tp = tab + pos * 16 + 8 * (fq & 1);
                            f32x4 p0, p1;
#pragma unroll
                            for (int j = 0; j < 4; ++j) { p0[j] = __shfl_xor(v0[j], 32); p1[j] = __shfl_xor(v1[j], 32); }
                            const bool first = fq < 2;
#pragma unroll
                            for (int j = 0; j < 4; ++j) { const f32x2 c0 = tp[j], c1 = tp[4 + j];
                                v0[j] = first ? (v0[j] * c0.x - p0[j] * c0.y) : (p0[j] * c0.y + v0[j] * c0.x);
                                v1[j] = first ? (v1[j] * c1.x - p1[j] * c1.y) : (p1[j] * c1.y + v1[j] * c1.x); }
                        }
                        *(u32x4*)(KR + (size_t)row * 64 + wc * 32 + 8 * fq) = pack8(v0, v1); }
            }
        }
    }
};
struct EpiQ {
    static constexpr bool PERM = false;
    bf16_t* Q; const float* ssq; const f32x2* tab;
    __device__ __forceinline__ void operator()(const f32x4 (&acc)[2][2][4][2], const Unit& u, int wr, int wc, int fr, int fq) const {
        const int row0 = u.pm * BM + wr * 64 + fr;
#pragma unroll
        for (int ai = 0; ai < 2; ++ai)
#pragma unroll
            for (int m = 0; m < 4; ++m) { const int row = row0 + ai * HALF + m * 16; const float rs = __builtin_amdgcn_rsqf(ssq[row] * (1.f / 512.f) + EPS) * QSCALE; const int t = row & (SEQ - 1);
#pragma unroll
                for (int bj = 0; bj < 2; ++bj) { const int gcol = u.pn * 8 + bj * 4 + wc, hg = gcol % 6;
                    f32x4 x1 = acc[ai][bj][m][0] * rs, x2 = acc[ai][bj][m][1] * rs;
                    if (hg >= 4) { const int pos = hg == 4 ? (t >> 6) : (t & 63); const f32x2* tp = tab + pos * 16 + 4 * fq;
#pragma unroll
                        for (int j = 0; j < 4; ++j) { const f32x2 cs = tp[j]; const float a = x1[j], b = x2[j]; x1[j] = a * cs.x - b * cs.y; x2[j] = a * cs.y + b * cs.x; } }
                    bf16_t* p = Q + (size_t)row * 3072 + gcol * 32 + 4 * fq;
                    u32x2 w0, w1; w0.x = cvt_pk_bf16(x1[0], x1[1]); w0.y = cvt_pk_bf16(x1[2], x1[3]); w1.x = cvt_pk_bf16(x2[0], x2[1]); w1.y = cvt_pk_bf16(x2[2], x2[3]);
                    *(u32x2*)p = w0; *(u32x2*)(p + 16) = w1; } }
    }
};
struct EpiKV {
    static constexpr bool PERM = true;
    bf16_t* KN; bf16_t* V; const float* ssq;
    __device__ __forceinline__ void operator()(const f32x4 (&acc)[2][2][4][2], const Unit& u, int wr, int wc, int fr, int fq) const {
        const int row0 = u.pm * BM + wr * 64 + fr, col0 = u.pn * 128 + wc * 32 + 8 * fq;
#pragma unroll
        for (int ai = 0; ai < 2; ++ai)
#pragma unroll
            for (int m = 0; m < 4; ++m) { const int row = row0 + ai * HALF + m * 16; const float rs = __builtin_amdgcn_rsqf(ssq[row] * (1.f / 512.f) + EPS);
                *(u32x4*)(KN + (size_t)row * DM + col0) = pack8(acc[ai][0][m][0] * rs, acc[ai][0][m][1] * rs);
                *(u32x4*)(V + (size_t)row * DM + col0) = pack8(acc[ai][1][m][0] * rs, acc[ai][1][m][1] * rs); }
    }
};
}

namespace att {
constexpr int NW = 8, QBLK = 32, KVBLK = 64, NT = (CTXL + SEQ) / KVBLK;
constexpr int SHM_V = KVBLK * 128 * 2, SHM_K = KVBLK * 192 * 2;
#ifndef ATT_NQREG
#define ATT_NQREG 12
#endif
constexpr int NQREG = ATT_NQREG, SHM_QR = (12 - NQREG) * 8192, SHM_ATTN = 3 * SHM_V + 3 * SHM_K + NW * 64 * 4 + SHM_QR + NW * 4096;
constexpr float THRL = 8.f * 1.4426950408889634f;
#define KSWZ(row, colB) ((row) * 384 + ((colB) ^ (((row) & 7) << 4)))
#define SBAR() __builtin_amdgcn_sched_barrier(0)
__device__ __forceinline__ int crow(int r, int hi) { return (r & 3) + 8 * (r >> 2) + 4 * hi; }
__device__ __forceinline__ void partialSM(f32x16& p0, f32x16& p1, float& m_reg, float& mn, float& alpha) {
  float pmax = p0[0];
#pragma unroll
  for (int r = 1; r < 16; ++r) pmax = fmaxf(pmax, p0[r]);
#pragma unroll
  for (int r = 0; r < 16; ++r) pmax = fmaxf(pmax, p1[r]);
  { auto rr = __builtin_amdgcn_permlane32_swap(__float_as_uint(pmax), __float_as_uint(pmax), false, false);
    pmax = fmaxf(__uint_as_float(rr[0]), __uint_as_float(rr[1])); }
  if (__builtin_expect(__all(pmax - m_reg <= THRL), 1)) { mn = m_reg; alpha = 1.f; }
  else { mn = fmaxf(m_reg, pmax); alpha = __builtin_amdgcn_exp2f(m_reg - mn); m_reg = mn; }
#pragma unroll
  for (int r = 0; r < 16; ++r) p0[r] = p0[r] - mn;
#pragma unroll
  for (int r = 0; r < 16; ++r) p1[r] = p1[r] - mn;
#pragma unroll
  for (int r = 0; r < 16; ++r) p0[r] = __builtin_amdgcn_exp2f(p0[r]);
}
__device__ __forceinline__ void finishSM(f32x16& p0, f32x16& p1, float alpha, float& l_reg, bf16x8& pa0, bf16x8& pa1, bf16x8& pa2, bf16x8& pa3) {
#pragma unroll
  for (int r = 0; r < 16; ++r) p1[r] = __builtin_amdgcn_exp2f(p1[r]);
  float ps = 0;
#pragma unroll
  for (int r = 0; r < 16; ++r) ps += p0[r];
#pragma unroll
  for (int r = 0; r < 16; ++r) ps += p1[r];
  { auto rr = __builtin_amdgcn_permlane32_swap(__float_as_uint(ps), __float_as_uint(ps), false, false);
    ps = __uint_as_float(rr[0]) + __uint_as_float(rr[1]); }
  l_reg = l_reg * alpha + ps;
#define PK4(P, BASE, OUT) do { unsigned a0 = cvt_pk_bf16(P[BASE + 0], P[BASE + 1]), a1 = cvt_pk_bf16(P[BASE + 2], P[BASE + 3]);   \
    unsigned b0 = cvt_pk_bf16(P[BASE + 4], P[BASE + 5]), b1 = cvt_pk_bf16(P[BASE + 6], P[BASE + 7]);                              \
    auto r0 = __builtin_amdgcn_permlane32_swap(a0, b0, false, false); auto r1 = __builtin_amdgcn_permlane32_swap(a1, b1, false, false); \
    u32x4 w = {r0[0], r1[0], r0[1], r1[1]}; OUT = *reinterpret_cast<bf16x8*>(&w); } while (0)
  PK4(p0, 0, pa0); PK4(p0, 8, pa1); PK4(p1, 0, pa2); PK4(p1, 8, pa3);
#undef PK4
}
__device__ __forceinline__ void qkt(f32x16& p0, f32x16& p1, const char* Ks, const bf16x8* qr, const char* Qr, int kbase) {
  p0 = f32x16{}; p1 = f32x16{};
  const char* kb = Ks + kbase;
  bf16x8 k0[3], k1[3];
#define KLD(d) do { k0[(d) % 3] = *reinterpret_cast<const bf16x8*>(kb + (d) * 512); k1[(d) % 3] = *reinterpret_cast<const bf16x8*>(kb + 12288 + (d) * 512); } while (0)
  KLD(0); KLD(1);
#pragma unroll
  for (int d0 = 0; d0 < 12; ++d0) {
    if (d0 + 2 < 12) KLD(d0 + 2);
    const bf16x8 qf = d0 < NQREG ? qr[d0 < NQREG ? d0 : 0] : *reinterpret_cast<const bf16x8*>(Qr + (d0 - NQREG) * 8192);
    p0 = __builtin_amdgcn_mfma_f32_32x32x16_bf16(k0[d0 % 3], qf, p0, 0, 0, 0);
    p1 = __builtin_amdgcn_mfma_f32_32x32x16_bf16(k1[d0 % 3], qf, p1, 0, 0, 0);
    SBAR(); }
#undef KLD
}
__device__ __forceinline__ int v_st(int k, int c) { const int kk = (k & ~0xC) | ((k & 4) << 1) | ((k & 8) >> 1); return ((kk >> 3) * 4 + (c >> 5)) * 512 + ((kk & 7) * 32 + (c & 31)) * 2; }
__device__ __forceinline__ int v_rd_base(int lane) { return ((lane & 3) << 3) | (((lane >> 2) & 3) << 6) | (((lane >> 4) & 1) << 5) | (((lane >> 5) & 1) << 8); }
constexpr int v_rd_off(int d0, int ks, int half) { return d0 * 512 + ks * 4096 + half * 2048; }
template <int OFF> __device__ __forceinline__ s16x4 tr_read(int vb) {
  s16x4 r; asm volatile("ds_read_b64_tr_b16 %0, %1 offset:%2" : "=&v"(r) : "v"(vb), "i"(OFF) : "memory"); return r;
}
struct VFrag { s16x4 l0, h0, l1, h1, l2, h2, l3, h3; };
template <int D0> __device__ __forceinline__ void v_read8(VFrag& f, int vb) {
  f.l0 = tr_read<v_rd_off(D0, 0, 0)>(vb); f.h0 = tr_read<v_rd_off(D0, 0, 1)>(vb); f.l1 = tr_read<v_rd_off(D0, 1, 0)>(vb); f.h1 = tr_read<v_rd_off(D0, 1, 1)>(vb);
  f.l2 = tr_read<v_rd_off(D0, 2, 0)>(vb); f.h2 = tr_read<v_rd_off(D0, 2, 1)>(vb); f.l3 = tr_read<v_rd_off(D0, 3, 0)>(vb); f.h3 = tr_read<v_rd_off(D0, 3, 1)>(vb);
}
__device__ __forceinline__ void pv_mma(f32x16& od, const VFrag& f, bf16x8 pa0, bf16x8 pa1, bf16x8 pa2, bf16x8 pa3) {
#define PK(L, H) (bf16x8){L[0], L[1], L[2], L[3], H[0], H[1], H[2], H[3]}
  od = __builtin_amdgcn_mfma_f32_32x32x16_bf16(pa0, PK(f.l0, f.h0), od, 0, 0, 0);
  od = __builtin_amdgcn_mfma_f32_32x32x16_bf16(pa1, PK(f.l1, f.h1), od, 0, 0, 0);
  od = __builtin_amdgcn_mfma_f32_32x32x16_bf16(pa2, PK(f.l2, f.h2), od, 0, 0, 0);
  od = __builtin_amdgcn_mfma_f32_32x32x16_bf16(pa3, PK(f.l3, f.h3), od, 0, 0, 0);
#undef PK
}
__device__ __forceinline__ void pv_d0(f32x16* o, int vb, bf16x8 pa0, bf16x8 pa1, bf16x8 pa2, bf16x8 pa3) {
  VFrag fa, fb;
  v_read8<0>(fa, vb); v_read8<1>(fb, vb);
  asm volatile("s_waitcnt lgkmcnt(8)" ::: "memory"); SBAR(); pv_mma(o[0], fa, pa0, pa1, pa2, pa3); SBAR();
  v_read8<2>(fa, vb);
  asm volatile("s_waitcnt lgkmcnt(8)" ::: "memory"); SBAR(); pv_mma(o[1], fb, pa0, pa1, pa2, pa3); SBAR();
  v_read8<3>(fb, vb);
  asm volatile("s_waitcnt lgkmcnt(8)" ::: "memory"); SBAR(); pv_mma(o[2], fa, pa0, pa1, pa2, pa3); SBAR();
  asm volatile("s_waitcnt lgkmcnt(0)" ::: "memory"); SBAR(); pv_mma(o[3], fb, pa0, pa1, pa2, pa3); SBAR();
}
constexpr int SLOT_K = SHM_K, SLOT_V = SHM_V, RING_BYTES = 3 * (SLOT_K + SLOT_V);
constexpr int NUNITS = NB * 16 * (SEQ / 256);
__device__ __forceinline__ void attn_phase(const bf16_t* __restrict__ Q, const bf16_t* __restrict__ KN, const bf16_t* __restrict__ KR, const bf16_t* __restrict__ V,
                                           const bf16_t* __restrict__ SG, bf16_t* __restrict__ Z, int vcu, int G, char* lds, LAS unsigned char* ldsl) {
  const int tid = threadIdx.x, wid = __builtin_amdgcn_readfirstlane(tid >> 6), lane = tid & 63, r32 = lane & 31, hi = lane >> 5;
  char* K_lds = lds; char* V_lds = lds + 3 * SLOT_K;
  float* wsf = (float*)(lds + RING_BYTES) + wid * 64; float* li_l = wsf; float* al_l = wsf + 32;
  char* Qr = lds + RING_BYTES + NW * 64 * 4 + tid * 16;
  const int vb0 = (int)(uintptr_t)V_lds + v_rd_base(lane);
  const int kbase = ((r32 >> 4) * 384 + (r32 & 15)) * 16 + hi * 256;
  int kofs[3], vofs[2]; bool krope[3];
#pragma unroll
  for (int i = 0; i < 3; ++i) { const int p = 3 * wid + i, row = (p / 6) * 16 + (lane & 15), chunk = 4 * (p % 6) + (lane >> 4);
    krope[i] = chunk >= 16; kofs[i] = krope[i] ? row * 128 + (chunk - 16) * 16 : row * 4096 + chunk * 16; }
#pragma unroll
  for (int i = 0; i < 2; ++i) { const int B = (2 * wid + i) * 1024 + lane * 16, sub = B >> 9, within = (B & 511) >> 1, kk = (sub >> 2) * 8 + (within >> 5);
    const int k = (kk & ~0xC) | ((kk & 4) << 1) | ((kk & 8) >> 1), c = (sub & 3) * 32 + (within & 31); vofs[i] = k * 4096 + c * 2; }
#define KROW(j, b_) ((j) < 4 ? ML + (b_) * CTXL + (j) * KVBLK : (b_) * SEQ + ((j) - 4) * KVBLK)
#define DMA_TILE(j, b_, h_, slot) do { const int rb_ = KROW(j, b_); \
    const char* kn_ = (const char*)KN + (size_t)rb_ * 4096 + (h_) * 256; const char* kr_ = (const char*)KR + (size_t)rb_ * 128; const char* v_ = (const char*)V + (size_t)rb_ * 4096 + (h_) * 256; \
    _Pragma("unroll") for (int i_ = 0; i_ < 3; ++i_) __builtin_amdgcn_global_load_lds((const unsigned*)((krope[i_] ? kr_ : kn_) + kofs[i_]), (LAS unsigned*)(ldsl + (slot) * SLOT_K + (3 * wid + i_) * 1024), 16, 0, 0); \
    _Pragma("unroll") for (int i_ = 0; i_ < 2; ++i_) __builtin_amdgcn_global_load_lds((const unsigned*)(v_ + vofs[i_]), (LAS unsigned*)(ldsl + 3 * SLOT_K + (slot) * SLOT_V + (2 * wid + i_) * 1024), 16, 0, 0); } while (0)
#define TILE_SYNC() do { asm volatile("s_waitcnt vmcnt(0)" ::: "memory"); __syncthreads(); } while (0)
#define RESC(a) do { if (__any((a) < 1.f)) { if (hi == 0) al_l[r32] = (a); asm volatile("s_waitcnt lgkmcnt(0)" ::: "memory"); \
    _Pragma("unroll") for (int d = 0; d < 4; ++d) _Pragma("unroll") for (int r = 0; r < 16; ++r) o[d][r] *= al_l[crow(r, hi)]; } } while (0)
  const int half = wid >> 2;
  const int nun_wg = vcu < NUNITS ? (NUNITS - 1 - vcu) / G + 1 : 0, T = nun_wg * NT;
#define ABAR() do { asm volatile("s_waitcnt lgkmcnt(0)" ::: "memory"); __builtin_amdgcn_s_barrier(); asm volatile("" ::: "memory"); } while (0)
#define VWAIT() asm volatile("s_waitcnt vmcnt(0)" ::: "memory")
#define DMA_T(t_) do { const int ui_ = (t_) / NT, j_ = (t_) - ui_ * NT, un_ = vcu + ui_ * G; DMA_TILE(j_, (un_ >> 7), ((un_ >> 3) & 15), ((t_) % 3)); } while (0)
#define LOADQ(un_) do { const int qb_ = (un_) & 7, h_ = ((un_) >> 3) & 15, b_ = (un_) >> 7; const bf16_t* Qw = Q + (size_t)(b_ * SEQ + qb_ * 256 + wid * QBLK + r32) * 3072 + h_ * 192 + hi * 8; \
    _Pragma("unroll") for (int d0 = 0; d0 < NQREG; ++d0) qr[d0] = *reinterpret_cast<const bf16x8*>(Qw + d0 * 16); \
    _Pragma("unroll") for (int d0 = NQREG; d0 < 12; ++d0) *reinterpret_cast<bf16x8*>(Qr + (d0 - NQREG) * 8192) = *reinterpret_cast<const bf16x8*>(Qw + d0 * 16); } while (0)
#define EPILOGUE(un_) do { const int qb_ = (un_) & 7, h_ = ((un_) >> 3) & 15, b_ = (un_) >> 7; \
    if (hi == 0) li_l[r32] = l_reg; asm volatile("s_waitcnt lgkmcnt(0)" ::: "memory"); \
    const size_t ob = (size_t)(b_ * SEQ + qb_ * 256 + wid * QBLK + (lane >> 3)) * DM + h_ * 128 + (lane & 7) * 8; \
    _Pragma("unroll") for (int hf = 0; hf < 2; ++hf) { \
      _Pragma("unroll") for (int r = 0; r < 16; ++r) { const float rl = __builtin_amdgcn_rcpf(li_l[crow(r, hi)]); \
        _Pragma("unroll") for (int dd = 0; dd < 2; ++dd) epi[crow(r, hi) * 64 + dd * 32 + r32] = (bf16_t)(cvt_pk_bf16(o[hf * 2 + dd][r] * rl, 0.f) & 0xffffu); } \
      asm volatile("s_waitcnt lgkmcnt(0)" ::: "memory"); \
      _Pragma("unroll") for (int i4 = 0; i4 < 4; ++i4) { const u32x4 ov = *(const u32x4*)(epi + (i4 * 8 + (lane >> 3)) * 64 + (lane & 7) * 8); \
        const size_t gi = ob + (size_t)(i4 * 8) * DM + hf * 64; const u32x4 gv = *(const u32x4*)(SG + gi); u32x4 zv; \
        zv.x = cvt_pk_bf16(bf_lo(ov.x) * bf_lo(gv.x), bf_hi(ov.x) * bf_hi(gv.x)); zv.y = cvt_pk_bf16(bf_lo(ov.y) * bf_lo(gv.y), bf_hi(ov.y) * bf_hi(gv.y)); \
        zv.z = cvt_pk_bf16(bf_lo(ov.z) * bf_lo(gv.z), bf_hi(ov.z) * bf_hi(gv.z)); zv.w = cvt_pk_bf16(bf_lo(ov.w) * bf_lo(gv.w), bf_hi(ov.w) * bf_hi(gv.w)); \
        *(u32x4*)(Z + gi) = zv; } \
      asm volatile("s_waitcnt lgkmcnt(0)" ::: "memory"); } } while (0)
  bf16_t* epi = (bf16_t*)(lds + RING_BYTES + NW * 64 * 4 + SHM_QR + wid * 4096);
  if (T > 0) {
    float m_reg = -1e30f, l_reg = 0, mn, al; f32x16 o[4] = {}; bf16x8 qr[NQREG]; f32x16 p0, p1; bf16x8 pa0, pa1, pa2, pa3;
    DMA_T(0); DMA_T(1);
    LOADQ(vcu);
    VWAIT(); __syncthreads();
    if (half == 1) ABAR();
    int slot = 0, pslot = 2, t = 0;
#define SEG_S() do { if (half == 1 && t + 2 < T) DMA_T(t + 2); \
      partialSM(p0, p1, m_reg, mn, al); RESC(al); finishSM(p0, p1, al, l_reg, pa0, pa1, pa2, pa3); \
      if (half == 0) VWAIT(); SBAR(); ABAR(); pslot = slot; slot = slot == 2 ? 0 : slot + 1; ++t; } while (0)
    for (int ui = 0; ui < nun_wg; ++ui) {
      SBAR();
      if (half == 0 && t >= 1 && t + 1 < T) DMA_T(t + 1);
      if (ui > 0) {
        pv_d0(o, vb0 + pslot * SLOT_V, pa0, pa1, pa2, pa3);
        EPILOGUE(vcu + (ui - 1) * G);
        m_reg = -1e30f; l_reg = 0;
#pragma unroll
        for (int d = 0; d < 4; ++d) o[d] = f32x16{};
        LOADQ(vcu + ui * G);
      }
      qkt(p0, p1, K_lds + slot * SLOT_K, qr, Qr, kbase);
      if (half == 1) VWAIT();
      SBAR(); ABAR();
      SEG_S();
      for (int j = 1; j < NT; ++j) {
        SBAR();
        if (half == 0 && t + 1 < T) DMA_T(t + 1);
        qkt(p0, p1, K_lds + slot * SLOT_K, qr, Qr, kbase); SBAR();
        pv_d0(o, vb0 + pslot * SLOT_V, pa0, pa1, pa2, pa3);
        if (half == 1) VWAIT();
        SBAR(); ABAR();
        SEG_S();
      }
    }
#undef SEG_S
    pv_d0(o, vb0 + pslot * SLOT_V, pa0, pa1, pa2, pa3);
    EPILOGUE(vcu + (nun_wg - 1) * G);
    if (half == 0) ABAR();
  }
  asm volatile("s_waitcnt vmcnt(0)" ::: "memory"); __syncthreads();
#undef ABAR
#undef VWAIT
#undef DMA_T
#undef LOADQ
#undef EPILOGUE
#undef KROW
#undef DMA_TILE
#undef TILE_SYNC
#undef RESC
}
}


#define XB_TMO      128
#define XB_XCNT(j)  (256  + 64 * (j))
#define XB_XSUB(j)  (1280 + 64 * (j))
#define XB_XGEN(j)  (2304 + 64 * (j))
#define XB_TOP      3328
#define XB_TOPGEN   3392
#define XCD_BAR_WORDS 3456
#define XB_SPIN_CAP (1u << 22)
__device__ __forceinline__ unsigned xb_ld(unsigned* p)              { return __hip_atomic_load(p, __ATOMIC_RELAXED, __HIP_MEMORY_SCOPE_AGENT); }
__device__ __forceinline__ unsigned xb_add(unsigned* p, unsigned v) { return __hip_atomic_fetch_add(p, v, __ATOMIC_RELAXED, __HIP_MEMORY_SCOPE_AGENT); }
__device__ __forceinline__ unsigned xb_xcc_id() { return (unsigned)__builtin_amdgcn_s_getreg((3 << 11) | 20) & 0xFu; }
#define XB_SPIN(cond, bar) do { unsigned _sp = 0; while (cond) { __builtin_amdgcn_s_sleep(1); \
    if ((++_sp & 255u) == 0u) { if (xb_ld(&(bar)[XB_TMO])) break; if (_sp > XB_SPIN_CAP) { atomicAdd(&(bar)[XB_TMO], 1u); break; } } } } while (0)
struct XcdBarrier { unsigned* bar; unsigned x; volatile LAS unsigned* st; };
__device__ __forceinline__ XcdBarrier xcd_barrier_post(unsigned* bar, volatile LAS unsigned* st) {
    XcdBarrier b; b.bar = bar; b.x = xb_xcc_id(); b.st = st;
    if (threadIdx.x == 0) (void)xb_add(&bar[XB_XCNT(b.x)], 1u);
    return b;
}
__device__ __forceinline__ void xcd_barrier_complete(unsigned* bar, unsigned x, unsigned& nloc, unsigned& nx) {
    const unsigned G = gridDim.x;
    unsigned sum, cnt, mine, sp = 0u;
    for (;;) {
        sum = 0u; cnt = 0u; mine = 0u;
#pragma unroll
        for (unsigned j = 0; j < 16; ++j) { const unsigned c = xb_ld(&bar[XB_XCNT(j)]); sum += c; cnt += (c > 0u) ? 1u : 0u; mine = (j == x) ? c : mine; }
        if (sum == G) break;
        __builtin_amdgcn_s_sleep(1);
        if ((++sp & 255u) == 0u) { if (xb_ld(&bar[XB_TMO])) break; if (sp > XB_SPIN_CAP) { atomicAdd(&bar[XB_TMO], 1u); break; } }
    }
    nloc = mine > 0u ? mine : 1u; nx = cnt > 0u ? cnt : 1u;
}
__device__ __forceinline__ void xcd_barrier(const XcdBarrier& b) {
    asm volatile("s_waitcnt vmcnt(0)" ::: "memory");
    __syncthreads();
    if (threadIdx.x == 0) {
        unsigned* bar = b.bar;
        __builtin_amdgcn_s_waitcnt(0);
        unsigned nloc = b.st[0], nx = b.st[1];
        if (nloc == 0u) { xcd_barrier_complete(bar, b.x, nloc, nx); b.st[0] = nloc; b.st[1] = nx; }
        const unsigned old = xb_add(&bar[XB_XSUB(b.x)], 1u);
        const unsigned gen = old / nloc;
        if (old + 1u == (gen + 1u) * nloc) {
            __builtin_amdgcn_fence(__ATOMIC_RELEASE, "agent");
            asm volatile("s_waitcnt vmcnt(0)" ::: "memory");
            const unsigned og = xb_add(&bar[XB_TOP], 1u);
            const unsigned tg = og / nx;
            if (og + 1u == (tg + 1u) * nx) xb_add(&bar[XB_TOPGEN], 1u);
            else XB_SPIN(xb_ld(&bar[XB_TOPGEN]) == tg, bar);
            __builtin_amdgcn_fence(__ATOMIC_ACQUIRE, "agent");
            xb_add(&bar[XB_XGEN(b.x)], 1u);
            asm volatile("s_waitcnt vmcnt(0)" ::: "memory");
        } else {
            XB_SPIN(xb_ld(&bar[XB_XGEN(b.x)]) == gen, bar);
            __builtin_amdgcn_fence(__ATOMIC_ACQUIRE, "agent");
            asm volatile("s_waitcnt vmcnt(0)" ::: "memory");
        }
    }
    __syncthreads();
}
constexpr int NWAVES = 8;
constexpr int LDS_BYTES = 163840;
constexpr int N_PHASES = 12;
constexpr int MISC_OFF = 163840 - 256; static_assert(att::SHM_ATTN <= MISC_OFF, "LDS map");

struct Args { const float* in[19]; float* out; unsigned char* ws; int ph_lo, ph_hi; };

struct Frame {
    LAS unsigned char* lds;
    int tid, lane, wave, gw, NGW, G;
    unsigned char* ws;
};

__device__ __forceinline__ void tr_item(const float* W, int K, int N, bf16_t* WT, const float* gk, LAS float* scr, int item, int lane, bool mla_reorder = false) {
    const int nblk = N / 32, kb = item / nblk, nb = item % nblk, k0 = 64 * kb, n0 = 32 * nb;
    const int d0 = mla_reorder ? (nb < 32 ? n0 : (nb < 34 ? n0 + 2048 : n0 - 64)) : n0;
    f32x4 wv[8];
#pragma unroll
    for (int i = 0; i < 8; ++i) wv[i] = *(const f32x4*)(W + (size_t)(k0 + 8 * i + (lane >> 3)) * N + n0 + (lane & 7) * 4);
#pragma unroll
    for (int i = 0; i < 8; ++i) { const int kk = 8 * i + (lane >> 3); f32x4 v = wv[i]; if (gk) v = v * gk[k0 + kk];
        LAS float* d = scr + kk * 33 + (lane & 7) * 4; d[0] = v[0]; d[1] = v[1]; d[2] = v[2]; d[3] = v[3]; }
    asm volatile("s_waitcnt lgkmcnt(0)" ::: "memory");
    const int c = lane & 7;
#pragma unroll
    for (int j = 0; j < 4; ++j) { const int n = (lane >> 3) + 8 * j; const LAS float* s = scr + (8 * c) * 33 + n;
        u32x4 o; o.x = cvt_pk_bf16(s[0 * 33], s[1 * 33]); o.y = cvt_pk_bf16(s[2 * 33], s[3 * 33]); o.z = cvt_pk_bf16(s[4 * 33], s[5 * 33]); o.w = cvt_pk_bf16(s[6 * 33], s[7 * 33]);
        *(u32x4*)(WT + (size_t)(d0 + n) * K + k0 + 8 * c) = o; }
    asm volatile("s_waitcnt lgkmcnt(0)" ::: "memory");
}

__device__ __forceinline__ void gemv_item(const float* c, const float* c_ctx, const float* ada_w, const float* ada_b, float* mod, int it, int lane) {
    const int l = it / 768, rem = it % 768, kc = rem / 24, cgp = rem % 24, k0 = kc * 64;
    float s[9];
#pragma unroll
    for (int r = 0; r < 8; ++r) s[r] = silu_f(c[r * DM + k0 + lane]);
    s[8] = silu_f(c_ctx[k0 + lane]);
    const float* W = ada_w + (size_t)l * DM * 6144 + (size_t)k0 * 6144 + cgp * 256 + lane * 4;
    f32x4 acc[9];
#pragma unroll
    for (int r = 0; r < 9; ++r) acc[r] = (f32x4){0.f, 0.f, 0.f, 0.f};
#pragma unroll 16
    for (int kk = 0; kk < 64; ++kk) { const f32x4 w = *(const f32x4*)(W + (size_t)kk * 6144);
#pragma unroll
        for (int r = 0; r < 9; ++r) { const float sk = __uint_as_float(__builtin_amdgcn_readlane(__float_as_uint(s[r]), kk)); acc[r] += w * sk; } }
    const int col = cgp * 256 + lane * 4;
    f32x4 bv = (f32x4){0.f, 0.f, 0.f, 0.f};
    if (kc == 0) bv = *(const f32x4*)(ada_b + l * 6144 + col);
#pragma unroll
    for (int r = 0; r < 9; ++r) { float* m = mod + (size_t)(l * 9 + r) * 6144 + col;
#pragma unroll
        for (int j = 0; j < 4; ++j) atomicAdd(m + j, acc[r][j] + bv[j]); }
}

__device__ __forceinline__ void load_row_f32(const float* p, int lane, f32x4 (&v)[8]) {
#pragma unroll
    for (int j = 0; j < 8; ++j) v[j] = *(const f32x4*)(p + 4 * lane + 256 * j);
}
__device__ __forceinline__ float sumsq8(const f32x4 (&v)[8]) {
    float s = 0.f;
#pragma unroll
    for (int j = 0; j < 8; ++j) s += (v[j][0] * v[j][0] + v[j][1] * v[j][1]) + (v[j][2] * v[j][2] + v[j][3] * v[j][3]);
    return wave_sum(s);
}
__device__ __forceinline__ void modulate_store(const f32x4 (&v)[8], float rstd, const float* pn, const float* modr, bf16_t* orow, int lane) {
#pragma unroll
    for (int j = 0; j < 8; ++j) { const int col = 4 * lane + 256 * j;
        const f32x4 g = *(const f32x4*)(pn + col), sh = *(const f32x4*)(modr + col), sc = *(const f32x4*)(modr + DM + col);
        const f32x4 hh = v[j] * rstd * g * (sc + 1.f) + sh;
        u32x2 w; w.x = cvt_pk_bf16(hh[0], hh[1]); w.y = cvt_pk_bf16(hh[2], hh[3]);
        *(u32x2*)(orow + col) = w; }
}


template <int WIN> __device__ __forceinline__ void pool_chunk(const bf16_t* Ub, bf16_t* Pb, int t0, int L) {
    constexpr int LEFT = WIN / 2, RIGHT = WIN - 1 - LEFT, NR = 8 + WIN - 1;
    u32x4 rw[NR];
#pragma unroll
    for (int k = 0; k < NR; ++k) { const int t = t0 - LEFT + k; rw[k] = (t >= 0 && t < L) ? *(const u32x4*)(Ub + (size_t)t * DM) : (u32x4){0u, 0u, 0u, 0u}; }
    float S8[8];
#pragma unroll
    for (int e = 0; e < 8; ++e) S8[e] = 0.f;
#define ACC8(q_, sgn) do { const u32x4 a_ = (q_); S8[0] += sgn bf_lo(a_.x); S8[1] += sgn bf_hi(a_.x); S8[2] += sgn bf_lo(a_.y); S8[3] += sgn bf_hi(a_.y); \
                          S8[4] += sgn bf_lo(a_.z); S8[5] += sgn bf_hi(a_.z); S8[6] += sgn bf_lo(a_.w); S8[7] += sgn bf_hi(a_.w); } while (0)
#pragma unroll
    for (int k = 0; k < WIN; ++k) ACC8(rw[k], +);
#pragma unroll
    for (int i = 0; i < 8; ++i) { const int t = t0 + i; const int lo_ = t - LEFT < 0 ? 0 : t - LEFT, hi_ = t + RIGHT + 1 > L ? L : t + RIGHT + 1;
        const float inv = 1.f / (float)(hi_ - lo_); const u32x4 w = rw[i + LEFT];
        u32x4 o; o.x = cvt_pk_bf16(S8[0] * inv - bf_lo(w.x), S8[1] * inv - bf_hi(w.x)); o.y = cvt_pk_bf16(S8[2] * inv - bf_lo(w.y), S8[3] * inv - bf_hi(w.y));
        o.z = cvt_pk_bf16(S8[4] * inv - bf_lo(w.z), S8[5] * inv - bf_hi(w.z)); o.w = cvt_pk_bf16(S8[6] * inv - bf_lo(w.w), S8[7] * inv - bf_hi(w.w));
        *(u32x4*)(Pb + (size_t)t * DM) = o;
        if (i < 7) { ACC8(rw[i + WIN], +); ACC8(rw[i], -); } }
#undef ACC8
}

__global__ void __launch_bounds__(NWAVES * 64, 2) mk_fwd(Args args) {
    extern __shared__ __attribute__((aligned(16))) unsigned char lds[];
    cg::grid_group grid = cg::this_grid();
    Frame F;
    F.lds = (LAS unsigned char*)lds;
    F.tid = threadIdx.x; F.lane = F.tid & 63; F.wave = __builtin_amdgcn_readfirstlane(F.tid >> 6);
    F.G = gridDim.x; F.gw = blockIdx.x * NWAVES + F.wave; F.NGW = F.G * NWAVES; F.ws = args.ws;
    unsigned char* ws = args.ws;
    const int lo = args.ph_lo, hi = args.ph_hi;
#ifndef PHASE_MASK
#define PHASE_MASK 0xFFF
#endif
#define IN(k) (((PHASE_MASK >> (k)) & 1) && lo <= (k) && (k) < hi)
#ifndef DBL_MASK
#define DBL_MASK 0
#endif

#define SEAM(k) do { if (IN(k) && IN((k) + 1)) { if ((k) == 0) grid.sync(); else xcd_barrier(bar); } } while (0)
    volatile LAS unsigned* MISC = (volatile LAS unsigned*)(F.lds + MISC_OFF);
    if (F.tid < 16) MISC[F.tid] = 0u;
    __syncthreads();
    XcdBarrier bar; bar.bar = (unsigned*)(args.ws + WS_BAR); bar.x = 0; bar.st = MISC;
    if (hi - lo > 1) bar = xcd_barrier_post((unsigned*)(args.ws + WS_BAR), MISC);
    const float* x = args.in[0]; const float* c = args.in[1]; const float* ctx = args.in[2]; const float* c_ctx = args.in[3];
    const float* ada_w = args.in[4]; const float* ada_b = args.in[5]; const float* pre_norm = args.in[6]; const float* post_norm = args.in[7];
    float* mod = (float*)(ws + WS_MOD); float* ssq = (float*)(ws + WS_SSQ); f32x2* tab = (f32x2*)(ws + WS_TAB);
    bf16_t* WIN = (bf16_t*)(ws + WS_WIN); bf16_t* WG = (bf16_t*)(ws + WS_WG); bf16_t* WOUT = (bf16_t*)(ws + WS_WOUT); bf16_t* WMLA = (bf16_t*)(ws + WS_WMLA);
    bf16_t* WUQ = (bf16_t*)(ws + WS_WUQ); bf16_t* WUKV = (bf16_t*)(ws + WS_WUKV); bf16_t* WMO = (bf16_t*)(ws + WS_WMO);
    bf16_t* H = (bf16_t*)(ws + WS_H); bf16_t* SG = (bf16_t*)(ws + WS_SG); bf16_t* Z = (bf16_t*)(ws + WS_Z); bf16_t* Y = (bf16_t*)(ws + WS_Y);
    bf16_t* U = (bf16_t*)(ws + WS_U); bf16_t* P = (bf16_t*)(ws + WS_P); bf16_t* Q = (bf16_t*)(ws + WS_Q); bf16_t* CQ = (bf16_t*)(ws + WS_CQ);
    bf16_t* CKV = (bf16_t*)(ws + WS_CKV); bf16_t* KR = (bf16_t*)(ws + WS_KR); bf16_t* KN = (bf16_t*)(ws + WS_KN); bf16_t* V = (bf16_t*)(ws + WS_V);
    const int NTHR = F.G * NWAVES * 64;
#define FRESH() int gtid; do { int t_ = threadIdx.x; asm volatile("" : "+v"(t_)); F.tid = t_; F.lane = t_ & 63; gtid = blockIdx.x * (NWAVES * 64) + t_; (void)gtid; } while (0)

    if (IN(0)) { FRESH();
        LAS float* scr = (LAS float*)(F.lds + F.wave * 16384);
        constexpr int I_GEMV = 2 * 32 * 24;
        constexpr int I_WIN = 32 * 128, I_WG = 4 * 8 * 16, I_WOUT = 32 * 64, I_WMLA = 32 * 98, I_WUQ = 8 * 96, I_WUKV = 8 * 128, I_WMO = 32 * 64;
        constexpr int NITEMS = I_GEMV + I_WIN + I_WG + I_WOUT + I_WMLA + I_WUQ + I_WUKV + I_WMO;
        for (int it = F.gw; it < NITEMS; it += F.NGW) {
            int r = it;
            if (r < I_GEMV) { gemv_item(c, c_ctx, ada_w, ada_b, mod, r, F.lane); continue; } r -= I_GEMV;
            if (r < I_WIN) { tr_item(args.in[8], DM, 4096, WIN, nullptr, scr, r, F.lane); continue; } r -= I_WIN;
            if (r < I_WG) { const int g = r / 128; tr_item(args.in[9] + (size_t)g * 512 * 512, 512, 512, WG + (size_t)g * 512 * 512, nullptr, scr, r % 128, F.lane); continue; } r -= I_WG;
            if (r < I_WOUT) { tr_item(args.in[12], DM, DM, WOUT, nullptr, scr, r, F.lane); continue; } r -= I_WOUT;
            if (r < I_WMLA) { tr_item(args.in[13], DM, 3136, WMLA, nullptr, scr, r, F.lane, true); continue; } r -= I_WMLA;
            if (r < I_WUQ) { tr_item(args.in[16], 512, 3072, WUQ, args.in[14], scr, r, F.lane); continue; } r -= I_WUQ;
            if (r < I_WUKV) { tr_item(args.in[17], 512, 4096, WUKV, args.in[15], scr, r, F.lane); continue; } r -= I_WUKV;
            tr_item(args.in[18], DM, DM, WMO, nullptr, scr, r, F.lane);
        }
        for (int i = gtid; i < (NMLA - 3136) * DM / 8; i += NTHR) *(u32x4*)(WMLA + (size_t)3136 * DM + (size_t)i * 8) = (u32x4){0u, 0u, 0u, 0u};
        if (gtid < 1024) { const int pos = gtid >> 4, i = gtid & 15; const float fr = powf(10000.f, -(float)i / 16.f); const float ang = (float)pos * fr; float sn, cs; sincosf(ang, &sn, &cs); tab[gtid] = (f32x2){cs, sn}; }
    }
    SEAM(0);
    if (IN(1)) { FRESH();
        for (int row0 = F.gw * 3; row0 < MT; row0 += F.NGW * 3) {
            f32x4 v[3][8];
#pragma unroll
            for (int q = 0; q < 3; ++q) { const int row = row0 + q; const float* src = row < ML ? x + (size_t)row * DM : ctx + (size_t)(row - ML) * DM; load_row_f32(src, F.lane, v[q]); }
#pragma unroll
            for (int q = 0; q < 3; ++q) { const int row = row0 + q; const int r = row < ML ? row / SEQ : 8;
                const float rstd = __builtin_amdgcn_rsqf(sumsq8(v[q]) * (1.f / DM) + EPS);
                modulate_store(v[q], rstd, pre_norm, mod + (size_t)r * 6144, H + (size_t)row * DM, F.lane); }
        }
    }
    SEAM(1);
    if (IN(2)) {
        pg8::Gemm g{H, WIN, MT, 4096, DM, DM, DM, 0}; pg8::StaticOrder S; S.init(MT, 4096, F.G, (int)blockIdx.x);
        pg8::EpiPoolIn E{U, SG};
        pg8::gemm_phase<pg8::EpiPoolIn>(F.lds, g, S, E);
    }
    SEAM(2);
    if (IN(3)) { FRESH();
        for (int item = gtid; item < (MT / 8) * 256; item += NTHR) {
            const int cc = item & 255, row0 = (item >> 8) * 8;
            int base, L; if (row0 < ML) { base = row0 & ~(SEQ - 1); L = SEQ; } else { base = ML + ((row0 - ML) & ~(CTXL - 1)); L = CTXL; }
            const int t0 = row0 - base, gidx = cc >> 6;
            const bf16_t* Ub = U + (size_t)base * DM + cc * 8; bf16_t* Pb = P + (size_t)base * DM + cc * 8;
            switch (gidx) {
                case 0: pool_chunk<2>(Ub, Pb, t0, L); break;
                case 1: pool_chunk<4>(Ub, Pb, t0, L); break;
                case 2: pool_chunk<8>(Ub, Pb, t0, L); break;
                default: pool_chunk<16>(Ub, Pb, t0, L); break;
            }
        }
    }
    SEAM(3);
    if (IN(4)) {
        pg8::Gemm g{P, WG, MT, DM, 512, DM, 512, 2}; pg8::StaticOrder S; S.init(MT, DM, F.G, (int)blockIdx.x);
        pg8::EpiGrp E{SG, Z, args.in[10], args.in[11]};
        pg8::gemm_phase<pg8::EpiGrp>(F.lds, g, S, E);
    }
    SEAM(4);
    if (IN(5)) {
        pg8::Gemm g{Z, WOUT, MT, DM, DM, DM, DM, 0}; pg8::StaticOrder S; S.init(MT, DM, F.G, (int)blockIdx.x);
        pg8::EpiPlain E{Y, DM};
        pg8::gemm_phase<pg8::EpiPlain>(F.lds, g, S, E);
    }
    SEAM(5);
    if (IN(6)) { FRESH();
        for (int row0 = F.gw * 3; row0 < MT; row0 += F.NGW * 3) {
            f32x4 v[3][8]; u32x2 yw[3][8];
#pragma unroll
            for (int q = 0; q < 3; ++q) { const int row = row0 + q; const float* src = row < ML ? x + (size_t)row * DM : ctx + (size_t)(row - ML) * DM; load_row_f32(src, F.lane, v[q]);
                const bf16_t* yr = Y + (size_t)row * DM;
#pragma unroll
                for (int j = 0; j < 8; ++j) yw[q][j] = *(const u32x2*)(yr + 4 * F.lane + 256 * j); }
#pragma unroll
            for (int q = 0; q < 3; ++q) { const int row = row0 + q; const bool lat = row < ML; const int r = lat ? row / SEQ : 8;
                float sy = 0.f;
#pragma unroll
                for (int j = 0; j < 8; ++j) { const float a = bf_lo(yw[q][j].x), b = bf_hi(yw[q][j].x), c2 = bf_lo(yw[q][j].y), d = bf_hi(yw[q][j].y); sy += (a * a + b * b) + (c2 * c2 + d * d); }
                const float rsy = __builtin_amdgcn_rsqf(wave_sum(sy) * (1.f / DM) + EPS);
                const float* m0 = mod + (size_t)r * 6144;
#pragma unroll
                for (int j = 0; j < 8; ++j) { const int col = 4 * F.lane + 256 * j; const f32x4 gt = *(const f32x4*)(m0 + 2 * DM + col), pn = *(const f32x4*)(post_norm + col);
                    const f32x4 y4 = (f32x4){bf_lo(yw[q][j].x), bf_hi(yw[q][j].x), bf_lo(yw[q][j].y), bf_hi(yw[q][j].y)};
                    v[q][j] = v[q][j] + gt * (y4 * rsy * pn);
                    if (lat) *(f32x4*)(args.out + (size_t)row * DM + col) = v[q][j]; }
                const float rstd = __builtin_amdgcn_rsqf(sumsq8(v[q]) * (1.f / DM) + EPS);
                modulate_store(v[q], rstd, pre_norm + DM, mod + (size_t)(9 + r) * 6144, H + (size_t)row * DM, F.lane); }
        }
    }
    SEAM(6);
    if (IN(7)) {
        pg8::Gemm g{H, WMLA, MT, NMLA, DM, DM, DM, 0}; pg8::StaticOrder S; S.init(MT, NMLA, F.G, (int)blockIdx.x);
        pg8::EpiMlaIn E{CQ, CKV, KR, SG, ssq, tab};
        pg8::gemm_phase<pg8::EpiMlaIn>(F.lds, g, S, E);
    }
    SEAM(7);
    if (IN(8)) {
        { pg8::Gemm g{CQ, WUQ, ML, 3072, 512, 512, 512, 0}; pg8::StaticOrder S; S.init(ML, 3072, F.G, (int)blockIdx.x);
          pg8::EpiQ E{Q, ssq, tab};
          pg8::gemm_phase<pg8::EpiQ>(F.lds, g, S, E); }
        { pg8::Gemm g{CKV, WUKV, MT, 4096, 512, 512, 512, 0}; pg8::StaticOrder S; S.init(MT, 4096, F.G, (int)blockIdx.x);
          pg8::EpiKV E{KN, V, ssq + MT};
          pg8::gemm_phase<pg8::EpiKV>(F.lds, g, S, E); }
    }
    SEAM(8);
    if (IN(9)) {
        const int bx = blockIdx.x, vcu = (F.G % 8 == 0) ? (bx % 8) * (F.G / 8) + bx / 8 : bx;
        att::attn_phase(Q, KN, KR, V, SG, Z, vcu, F.G, (char*)lds, F.lds);
    }
    SEAM(9);
    if (IN(10)) {
        pg8::Gemm g{Z, WMO, ML, DM, DM, DM, DM, 0}; pg8::StaticOrder S; S.init(ML, DM, F.G, (int)blockIdx.x);
        pg8::EpiPlain E{Y, DM};
        pg8::gemm_phase<pg8::EpiPlain>(F.lds, g, S, E);
    }
    SEAM(10);
    if (IN(11)) { FRESH();
        for (int row0 = F.gw * 2; row0 < ML; row0 += F.NGW * 2) {
            f32x4 v[2][8]; u32x2 yw[2][8];
#pragma unroll
            for (int q = 0; q < 2; ++q) { const int row = row0 + q; load_row_f32(args.out + (size_t)row * DM, F.lane, v[q]);
                const bf16_t* yr = Y + (size_t)row * DM;
#pragma unroll
                for (int j = 0; j < 8; ++j) yw[q][j] = *(const u32x2*)(yr + 4 * F.lane + 256 * j); }
#pragma unroll
            for (int q = 0; q < 2; ++q) { const int row = row0 + q; const int r = row / SEQ;
                float sy = 0.f;
#pragma unroll
                for (int j = 0; j < 8; ++j) { const float a = bf_lo(yw[q][j].x), b = bf_hi(yw[q][j].x), c2 = bf_lo(yw[q][j].y), d = bf_hi(yw[q][j].y); sy += (a * a + b * b) + (c2 * c2 + d * d); }
                const float rsy = __builtin_amdgcn_rsqf(wave_sum(sy) * (1.f / DM) + EPS);
                const float* m1 = mod + (size_t)(9 + r) * 6144;
#pragma unroll
                for (int j = 0; j < 8; ++j) { const int col = 4 * F.lane + 256 * j; const f32x4 gt = *(const f32x4*)(m1 + 2 * DM + col), pn = *(const f32x4*)(post_norm + DM + col);
                    const f32x4 y4 = (f32x4){bf_lo(yw[q][j].x), bf_hi(yw[q][j].x), bf_lo(yw[q][j].y), bf_hi(yw[q][j].y)};
                    *(f32x4*)(args.out + (size_t)row * DM + col) = v[q][j] + gt * (y4 * rsy * pn); }
            }
        }
    }
#undef IN
#undef SEAM
}

extern "C" void kernel_launch(void* const* d_in, const int* in_sizes, int n_in, void* d_out, int out_size, void* d_ws, size_t ws_size, hipStream_t stream) {
    static int grid = 0;
    if (grid == 0) {
        if (n_in != 19 || out_size != ML * DM || ws_size < WS_END) { fprintf(stderr, "kernel_launch: unexpected shapes (n_in %d out %d ws %zu)\n", n_in, out_size, ws_size); grid = -1; return; }
        int dev = 0, cus = 0, per_cu = 0;
        hipGetDevice(&dev); hipDeviceGetAttribute(&cus, hipDeviceAttributeMultiprocessorCount, dev);
        if (hipFuncSetAttribute((const void*)mk_fwd, hipFuncAttributeMaxDynamicSharedMemorySize, LDS_BYTES) != hipSuccess) { fprintf(stderr, "kernel_launch: hipFuncSetAttribute failed\n"); grid = -1; return; }
        hipOccupancyMaxActiveBlocksPerMultiprocessor(&per_cu, (const void*)mk_fwd, NWAVES * 64, LDS_BYTES);
        (void)hipGetLastError();
        if (per_cu < 1) per_cu = 1;
        grid = cus * 1;
        (void)per_cu;
    }
    if (grid < 0) return;
    hipMemsetAsync((char*)d_ws, 0, CTL_ZERO_BYTES, stream);
    Args a{};
    for (int i = 0; i < 19; ++i) a.in[i] = (const float*)d_in[i];
    a.out = (float*)d_out; a.ws = (unsigned char*)d_ws;
#if MK_N_LAUNCHES == 1
    a.ph_lo = 0; a.ph_hi = N_PHASES;
    void* kargs[] = {&a};
    hipError_t e = hipLaunchCooperativeKernel((const void*)mk_fwd, dim3(grid), dim3(NWAVES * 64), kargs, LDS_BYTES, stream);
    if (e != hipSuccess) fprintf(stderr, "cooperative launch failed: %s (grid %d)\n", hipGetErrorString(e), grid);
#else
    for (int p = 0; p < N_PHASES; ++p) for (int rep = 0; rep < (((DBL_MASK >> p) & 1) ? 2 : 1); ++rep) { a.ph_lo = p; a.ph_hi = p + 1; hipLaunchKernelGGL(mk_fwd, dim3(grid), dim3(NWAVES * 64), LDS_BYTES, stream, a); }
#endif
}
```

```cpp
#include <hip/hip_runtime.h>
#include <hip/hip_cooperative_groups.h>
#include <hip/hip_bf16.h>
#include <cstdio>
#include <cstdint>
namespace cg = cooperative_groups;

#ifndef MK_N_LAUNCHES
#define MK_N_LAUNCHES 1
#endif

#define LAS __attribute__((address_space(3)))
typedef unsigned short bf16_t;
typedef short bf16x8 __attribute__((ext_vector_type(8)));
typedef short s16x4 __attribute__((ext_vector_type(4)));
typedef float f32x4 __attribute__((ext_vector_type(4)));
typedef float f32x2 __attribute__((ext_vector_type(2)));
typedef float f32x16 __attribute__((ext_vector_type(16)));
typedef unsigned u32x4 __attribute__((ext_vector_type(4)));
typedef unsigned u32x2 __attribute__((ext_vector_type(2)));

constexpr int DM = 2048, NB = 8, SEQ = 2048, CTXL = 256;
constexpr int ML = NB * SEQ, MC = NB * CTXL, MT = ML + MC;
constexpr int NMLA = 3328;
constexpr float EPS = 1e-6f;
constexpr float QSCALE = 0.07216878364870322f * 1.4426950408889634f;

constexpr size_t MiB = 1u << 20;
constexpr size_t WS_MOD = 0;
constexpr size_t WS_SSQ = 512 * 1024;
constexpr size_t WS_BAR = 768 * 1024;
constexpr size_t CTL_ZERO_BYTES = 1 * MiB;
constexpr size_t WS_TAB = 1 * MiB;
constexpr size_t WS_WIN = 2 * MiB, WS_WG = 18 * MiB, WS_WOUT = 20 * MiB, WS_WMLA = 28 * MiB, WS_WUQ = 41 * MiB, WS_WUKV = 44 * MiB, WS_WMO = 48 * MiB;
constexpr size_t WS_H = 64 * MiB, WS_SG = 136 * MiB, WS_Z = 208 * MiB, WS_Y = 280 * MiB, WS_U = 352 * MiB, WS_P = 424 * MiB;
constexpr size_t WS_Q = 352 * MiB, WS_CQ = 448 * MiB, WS_CKV = 466 * MiB, WS_KR = 484 * MiB, WS_KN = WS_H, WS_V = WS_Y;
constexpr size_t WS_END = 496 * MiB;

__device__ __forceinline__ unsigned cvt_pk_bf16(float lo, float hi) { unsigned r; asm volatile("v_cvt_pk_bf16_f32 %0, %1, %2" : "=v"(r) : "v"(lo), "v"(hi)); return r; }
__device__ __forceinline__ float bf_lo(unsigned w) { return __uint_as_float(w << 16); }
__device__ __forceinline__ float bf_hi(unsigned w) { return __uint_as_float(w & 0xffff0000u); }
__device__ __forceinline__ float silu_f(float v) { return v * __builtin_amdgcn_rcpf(1.f + __builtin_amdgcn_exp2f(-1.4426950408889634f * v)); }
__device__ __forceinline__ float wave_sum(float v) {
#pragma unroll
    for (int o = 1; o < 64; o <<= 1) v += __shfl_xor(v, o);
    return v;
}

namespace pg8 {
constexpr int BM = 256, BK = 64, HALF = 128, HTB = HALF * BK * 2, STAGE_BYTES = 8 * HTB, NXCD = 8, WGM = 8;
__host__ __device__ __forceinline__ int lds_byte(int r, int c) { const int st = (r >> 4) * 2 + (c >> 5), rr = r & 15, cc = c & 31, ob = rr * 64 + cc * 2; return st * 1024 + (ob ^ (((ob >> 9) & 1) << 5)); }
__host__ __device__ __forceinline__ void stage_rc(int b, int& R, int& C) { const int st = b / 1024, sb = b % 1024, swz = sb ^ (((sb >> 9) & 1) << 5); R = (st >> 1) * 16 + swz / 64; C = (st & 1) * 32 + (swz % 64) / 2; }
__host__ __device__ __forceinline__ int perm32(int rho) { const int n = rho >> 4, i = rho & 15; return 8 * (i >> 2) + 4 * n + (i & 3); }

struct Unit { int pm, pn; };
struct Gemm { const bf16_t* A; const bf16_t* Bt; int M, N, K, lda, ldb, agrp; };

struct StaticOrder {
    int nM, nN, nwg, G, c;
    __host__ __device__ void init(int M, int N, int G_, int c_) { nM = M / BM; nN = N / BM; nwg = nM * nN; G = G_; c = c_; }
    __host__ __device__ bool next(int i, Unit& u) const {
        const long L = (long)i * G + c; if (L >= nwg) return false;
        int wgid = (int)L; { const int q = nwg / NXCD, r = nwg % NXCD, xcd = wgid % NXCD, off = wgid / NXCD; wgid = (xcd < r ? xcd * (q + 1) : r * (q + 1) + (xcd - r) * q) + off; }
        const int nig = WGM * nN, gid = wgid / nig, fm = gid * WGM, gsz = (nM - fm) < WGM ? (nM - fm) : WGM;
        u.pm = fm + ((wgid % nig) % gsz); u.pn = (wgid % nig) / gsz; return true;
    }
};

template <class Epi>
__device__ __forceinline__ void gemm_phase(LAS unsigned char* lds, const Gemm g, const StaticOrder& S, const Epi& E) {
    const int tid = threadIdx.x, wid = __builtin_amdgcn_readfirstlane(tid >> 6), lane = tid & 63, wr = wid >> 2, wc = wid & 3, fr = lane & 15, fq = lane >> 4;
    const int K = g.K, nt = K / BK;
    unsigned voffA[2], voffB[2];
#pragma unroll
    for (int i = 0; i < 2; ++i) { int R, C; stage_rc(tid * 16 + i * 8192, R, C); const int Rb = Epi::PERM ? ((R & ~31) + perm32(R & 31)) : R;
        voffA[i] = (unsigned)(R * g.lda + C) * 2u; voffB[i] = (unsigned)(Rb * g.ldb + C) * 2u; }
    const size_t kstep = (size_t)(BK * 2);
    const size_t hsA = (size_t)HALF * g.lda * 2, hsB = (size_t)HALF * g.ldb * 2;
    const size_t tsA = 2 * hsA, tsB = 2 * hsB;
    const unsigned ldsw = (unsigned)wid * 1024u;
    const int aoff = lds_byte(wr * 64 + fr, fq * 8), boff = lds_byte(wc * 32 + fr, fq * 8);
#define PG8_SA(b, h) (((b) * 2 + (h)) * HTB)
#define PG8_SB(b, h) ((4 + (b) * 2 + (h)) * HTB)
#define PG8_STAGE(bufoff, gbase, voff) do { _Pragma("unroll") for (int _i = 0; _i < 2; ++_i) \
        __builtin_amdgcn_global_load_lds((const unsigned*)((const char*)(gbase) + (voff)[_i]), (LAS unsigned*)(lds + (bufoff) + ldsw + _i * 8192), 16, 0, 0); } while (0)
#define PG8_LDA(dst, b, h) do { _Pragma("unroll") for (int m = 0; m < 4; ++m) _Pragma("unroll") for (int k = 0; k < 2; ++k) dst[m][k] = *(const LAS bf16x8*)(lds + PG8_SA(b, h) + aoff + m * 2048 + k * 1024); } while (0)
#define PG8_LDB(dst, b, h) do { _Pragma("unroll") for (int n = 0; n < 2; ++n) _Pragma("unroll") for (int k = 0; k < 2; ++k) dst[n][k] = *(const LAS bf16x8*)(lds + PG8_SB(b, h) + boff + n * 2048 + k * 1024); } while (0)
#define PG8_MMA(ai, bj, At, Bt) do { __builtin_amdgcn_s_setprio(1); _Pragma("unroll") for (int m = 0; m < 4; ++m) _Pragma("unroll") for (int n = 0; n < 2; ++n) _Pragma("unroll") for (int k = 0; k < 2; ++k) \
        acc[ai][bj][m][n] = __builtin_amdgcn_mfma_f32_16x16x32_bf16(Bt[n][k], At[m][k], acc[ai][bj][m][n], 0, 0, 0); __builtin_amdgcn_s_setprio(0); } while (0)
#define PG8_WAIT_V(n) asm volatile("s_waitcnt vmcnt(" #n ")" ::: "memory")
#define PG8_WAIT_L(n) asm volatile("s_waitcnt lgkmcnt(" #n ")" ::: "memory")
#define PG8_BAR __builtin_amdgcn_s_barrier()
#define PG8_SCHED __builtin_amdgcn_sched_barrier(0)
#define PG8_AOFF(u) ((g.agrp > 0) ? (size_t)((u).pn / g.agrp) * (size_t)K * 2 : (size_t)0)
    Unit cur, nxt; int ui = 0;
    if (!S.next(0, cur)) return;
    f32x4 acc[2][2][4][2];
#pragma unroll
    for (int a = 0; a < 2; ++a)
#pragma unroll
        for (int b = 0; b < 2; ++b)
#pragma unroll
            for (int m = 0; m < 4; ++m)
#pragma unroll
                for (int n = 0; n < 2; ++n) acc[a][b][m][n] = (f32x4){0.f, 0.f, 0.f, 0.f};
    bf16x8 At[4][2], B0[2][2], B1[2][2];
    const char* cA = (const char*)g.A + (size_t)cur.pm * tsA + PG8_AOFF(cur); const char* cB = (const char*)g.Bt + (size_t)cur.pn * tsB;
    PG8_STAGE(PG8_SB(0, 0), cB, voffB); PG8_STAGE(PG8_SB(0, 1), cB + hsB, voffB); PG8_STAGE(PG8_SA(0, 0), cA, voffA); PG8_STAGE(PG8_SA(0, 1), cA + hsA, voffA);
    if (wr == 1) PG8_BAR;
    PG8_WAIT_V(2); PG8_BAR;
    PG8_STAGE(PG8_SB(1, 0), cB + kstep, voffB); PG8_STAGE(PG8_SA(1, 0), cA + kstep, voffA); PG8_STAGE(PG8_SB(1, 1), cB + hsB + kstep, voffB);
    PG8_WAIT_V(6); PG8_BAR;
    for (;;) {
        const bool has_next = S.next(ui + 1, nxt);
        const char* nA = has_next ? (const char*)g.A + (size_t)nxt.pm * tsA + PG8_AOFF(nxt) : cA; const char* nB = has_next ? (const char*)g.Bt + (size_t)nxt.pn * tsB : cB;
        for (int t = 0; t < nt; t += 2) {
            const bool last = (t == nt - 2);
            const char* a1 = cA + (size_t)(t + 1) * kstep;
            const char* a2 = last ? nA : cA + (size_t)(t + 2) * kstep; const char* b2 = last ? nB : cB + (size_t)(t + 2) * kstep;
            const char* a3 = a2 + kstep; const char* b3 = b2 + kstep;
            PG8_LDB(B0, 0, 0); PG8_LDB(B1, 0, 1); PG8_SCHED; PG8_LDA(At, 0, 0); PG8_STAGE(PG8_SA(1, 1), a1 + hsA, voffA);
            PG8_WAIT_V(8); PG8_WAIT_L(0); PG8_BAR; PG8_MMA(0, 0, At, B0); PG8_MMA(0, 1, At, B1); PG8_BAR; PG8_SCHED;
            PG8_LDA(At, 0, 1); PG8_STAGE(PG8_SB(0, 0), b2, voffB); PG8_STAGE(PG8_SB(0, 1), b2 + hsB, voffB); PG8_STAGE(PG8_SA(0, 0), a2, voffA);
            PG8_WAIT_V(8); PG8_WAIT_L(0); PG8_BAR; PG8_MMA(1, 0, At, B0); PG8_MMA(1, 1, At, B1); PG8_BAR; PG8_SCHED;
            PG8_LDB(B0, 1, 0); PG8_LDB(B1, 1, 1); PG8_SCHED; PG8_LDA(At, 1, 0); PG8_STAGE(PG8_SA(0, 1), a2 + hsA, voffA);
            PG8_WAIT_V(8); PG8_WAIT_L(0); PG8_BAR; PG8_MMA(0, 0, At, B0); PG8_MMA(0, 1, At, B1); PG8_BAR; PG8_SCHED;
            PG8_LDA(At, 1, 1); PG8_STAGE(PG8_SB(1, 0), b3, voffB); PG8_STAGE(PG8_SB(1, 1), b3 + hsB, voffB); PG8_STAGE(PG8_SA(1, 0), a3, voffA);
            PG8_WAIT_V(8); PG8_WAIT_L(0); PG8_BAR; PG8_MMA(1, 0, At, B0); PG8_MMA(1, 1, At, B1); PG8_BAR; PG8_SCHED;
        }
        if (wr == 0) PG8_BAR;
        E(acc, cur, wr, wc, fr, fq);
        if (!has_next) break;
#pragma unroll
        for (int a = 0; a < 2; ++a)
#pragma unroll
            for (int b = 0; b < 2; ++b)
#pragma unroll
                for (int m = 0; m < 4; ++m)
#pragma unroll
                    for (int n = 0; n < 2; ++n) acc[a][b][m][n] = (f32x4){0.f, 0.f, 0.f, 0.f};
        cur = nxt; cA = nA; cB = nB; ++ui;
        if (wr == 1) PG8_BAR;
    }
    PG8_WAIT_V(0);
    PG8_BAR;
#undef PG8_SA
#undef PG8_SB
#undef PG8_STAGE
#undef PG8_LDA
#undef PG8_LDB
#undef PG8_MMA
#undef PG8_WAIT_V
#undef PG8_WAIT_L
#undef PG8_BAR
#undef PG8_SCHED
#undef PG8_AOFF
}

__device__ __forceinline__ u32x4 pack8(f32x4 v0, f32x4 v1) { u32x4 w; w.x = cvt_pk_bf16(v0[0], v0[1]); w.y = cvt_pk_bf16(v0[2], v0[3]); w.z = cvt_pk_bf16(v1[0], v1[1]); w.w = cvt_pk_bf16(v1[2], v1[3]); return w; }
__device__ __forceinline__ f32x4 silu4(f32x4 v) { return (f32x4){silu_f(v[0]), silu_f(v[1]), silu_f(v[2]), silu_f(v[3])}; }

struct EpiPlain {
    static constexpr bool PERM = true;
    bf16_t* O; int ldc;
    __device__ __forceinline__ void operator()(const f32x4 (&acc)[2][2][4][2], const Unit& u, int wr, int wc, int fr, int fq) const {
        const int row0 = u.pm * BM + wr * 64 + fr, col0 = u.pn * BM + wc * 32 + 8 * fq;
#pragma unroll
        for (int ai = 0; ai < 2; ++ai)
#pragma unroll
            for (int m = 0; m < 4; ++m) { bf16_t* rowp = O + (size_t)(row0 + ai * HALF + m * 16) * ldc + col0;
#pragma unroll
                for (int bj = 0; bj < 2; ++bj) *(u32x4*)(rowp + bj * HALF) = pack8(acc[ai][bj][m][0], acc[ai][bj][m][1]); }
    }
};
struct EpiPoolIn {
    static constexpr bool PERM = true;
    bf16_t* U; bf16_t* SG;
    __device__ __forceinline__ void operator()(const f32x4 (&acc)[2][2][4][2], const Unit& u, int wr, int wc, int fr, int fq) const {
        const int t = u.pn >> 3; bf16_t* base = t ? SG : U;
        const int row0 = u.pm * BM + wr * 64 + fr, col0 = (u.pn & 7) * BM + wc * 32 + 8 * fq;
#pragma unroll
        for (int ai = 0; ai < 2; ++ai)
#pragma unroll
            for (int m = 0; m < 4; ++m) { bf16_t* rowp = base + (size_t)(row0 + ai * HALF + m * 16) * DM + col0;
#pragma unroll
                for (int bj = 0; bj < 2; ++bj) { f32x4 v0 = acc[ai][bj][m][0], v1 = acc[ai][bj][m][1];
                    if (t) { v0 = silu4(v0); v1 = silu4(v1); }
                    *(u32x4*)(rowp + bj * HALF) = pack8(v0, v1); } }
    }
};
struct EpiGrp {
    static constexpr bool PERM = true;
    const bf16_t* SG; bf16_t* Z; const float* bias; const float* scale;
    __device__ __forceinline__ void operator()(const f32x4 (&acc)[2][2][4][2], const Unit& u, int wr, int wc, int fr, int fq) const {
        const int row0 = u.pm * BM + wr * 64 + fr, col0 = u.pn * BM + wc * 32 + 8 * fq;
        f32x4 bv[2][2], sv[2][2];
#pragma unroll
        for (int bj = 0; bj < 2; ++bj)
#pragma unroll
            for (int n = 0; n < 2; ++n) { bv[bj][n] = *(const f32x4*)(bias + col0 + bj * HALF + 4 * n); sv[bj][n] = *(const f32x4*)(scale + col0 + bj * HALF + 4 * n); }
#pragma unroll
        for (int ai = 0; ai < 2; ++ai)
#pragma unroll
            for (int m = 0; m < 4; ++m) { const size_t off = (size_t)(row0 + ai * HALF + m * 16) * DM + col0;
#pragma unroll
                for (int bj = 0; bj < 2; ++bj) { const u32x4 gw = *(const u32x4*)(SG + off + bj * HALF);
                    f32x4 v0 = (acc[ai][bj][m][0] + bv[bj][0]) * sv[bj][0], v1 = (acc[ai][bj][m][1] + bv[bj][1]) * sv[bj][1];
                    v0 = v0 * (f32x4){bf_lo(gw.x), bf_hi(gw.x), bf_lo(gw.y), bf_hi(gw.y)}; v1 = v1 * (f32x4){bf_lo(gw.z), bf_hi(gw.z), bf_lo(gw.w), bf_hi(gw.w)};
                    *(u32x4*)(Z + off + bj * HALF) = pack8(v0, v1); } }
    }
};
struct EpiMlaIn {
    static constexpr bool PERM = true;
    bf16_t *CQ, *CKV, *KR, *SG; float* ssq; const f32x2* tab;
    __device__ __forceinline__ void operator()(const f32x4 (&acc)[2][2][4][2], const Unit& u, int wr, int wc, int fr, int fq) const {
        const int pn = u.pn, row0 = u.pm * BM + wr * 64 + fr;
        if (pn < 4) {
            bf16_t* base = pn < 2 ? CQ : CKV; float* ss = ssq + (pn < 2 ? 0 : MT);
            const int col0 = (pn & 1) * BM + wc * 32 + 8 * fq;
#pragma unroll
            for (int ai = 0; ai < 2; ++ai)
#pragma unroll
                for (int m = 0; m < 4; ++m) { const int row = row0 + ai * HALF + m * 16; bf16_t* rowp = base + (size_t)row * 512 + col0; float s = 0.f;
#pragma unroll
                    for (int bj = 0; bj < 2; ++bj) { const f32x4 v0 = acc[ai][bj][m][0], v1 = acc[ai][bj][m][1];
                        s += (v0[0] * v0[0] + v0[1] * v0[1]) + (v0[2] * v0[2] + v0[3] * v0[3]) + (v1[0] * v1[0] + v1[1] * v1[1]) + (v1[2] * v1[2] + v1[3] * v1[3]);
                        *(u32x4*)(rowp + bj * HALF) = pack8(v0, v1); }
                    s += __shfl_xor(s, 16); s += __shfl_xor(s, 32);
                    if (fq == 0) atomicAdd(ss + row, s); }
        } else if (pn < 12) {
            if (u.pm < ML / BM) {
                const int col0 = (pn - 4) * BM + wc * 32 + 8 * fq;
#pragma unroll
                for (int ai = 0; ai < 2; ++ai)
#pragma unroll
                    for (int m = 0; m < 4; ++m) { bf16_t* rowp = SG + (size_t)(row0 + ai * HALF + m * 16) * DM + col0;
#pragma unroll
                        for (int bj = 0; bj < 2; ++bj) *(u32x4*)(rowp + bj * HALF) = pack8(silu4(acc[ai][bj][m][0]), silu4(acc[ai][bj][m][1])); }
            }
        } else {
            if (wc < 2) {
                const bool lat = u.pm < ML / BM;
#pragma unroll
                for (int ai = 0; ai < 2; ++ai)
#pragma unroll
                    for (int m = 0; m < 4; ++m) { const int row = row0 + ai * HALF + m * 16;
                        f32x4 v0 = acc[ai][0][m][0], v1 = acc[ai][0][m][1];
                        if (lat) {
                            const int t = row & (SEQ - 1), pos = wc == 0 ? (t >> 6) : (t & 63);
                            const f32x2* tp = tab + pos * 16 + 8 * (fq & 1);
                            f32x4 p0, p1;
#pragma unroll
                            for (int j = 0; j < 4; ++j) { p0[j] = __shfl_xor(v0[j], 32); p1[j] = __shfl_xor(v1[j], 32); }
                            const bool first = fq < 2;
#pragma unroll
                            for (int j = 0; j < 4; ++j) { const f32x2 c0 = tp[j], c1 = tp[4 + j];
                                v0[j] = first ? (v0[j] * c0.x - p0[j] * c0.y) : (p0[j] * c0.y + v0[j] * c0.x);
                                v1[j] = first ? (v1[j] * c1.x - p1[j] * c1.y) : (p1[j] * c1.y + v1[j] * c1.x); }
                        }
                        *(u32x4*)(KR + (size_t)row * 64 + wc * 32 + 8 * fq) = pack8(v0, v1); }
            }
        }
    }
};
struct EpiQ {
    static constexpr bool PERM = true;
    bf16_t* Q; const float* ssq; const f32x2* tab;
    __device__ __forceinline__ void operator()(const f32x4 (&acc)[2][2][4][2], const Unit& u, int wr, int wc, int fr, int fq) const {
        const int row0 = u.pm * BM + wr * 64 + fr; const bool first = fq < 2;
#pragma unroll
        for (int ai = 0; ai < 2; ++ai)
#pragma unroll
            for (int m = 0; m < 4; ++m) { const int row = row0 + ai * HALF + m * 16; const float rs = __builtin_amdgcn_rsqf(ssq[row] * (1.f / 512.f) + EPS) * QSCALE; const int t = row & (SEQ - 1);
#pragma unroll
                for (int bj = 0; bj < 2; ++bj) { const int gcol = u.pn * 8 + bj * 4 + wc, hg = gcol % 6;
                    f32x4 v0 = acc[ai][bj][m][0] * rs, v1 = acc[ai][bj][m][1] * rs;
                    if (hg >= 4) { const int pos = hg == 4 ? (t >> 6) : (t & 63); const f32x2* tp = tab + pos * 16 + 8 * (fq & 1);
                        f32x4 p0, p1;
#pragma unroll
                        for (int j = 0; j < 4; ++j) { p0[j] = __shfl_xor(v0[j], 32); p1[j] = __shfl_xor(v1[j], 32); }
#pragma unroll
                        for (int j = 0; j < 4; ++j) { const f32x2 c0 = tp[j], c1 = tp[4 + j];
                            v0[j] = first ? (v0[j] * c0.x - p0[j] * c0.y) : (p0[j] * c0.y + v0[j] * c0.x);
                            v1[j] = first ? (v1[j] * c1.x - p1[j] * c1.y) : (p1[j] * c1.y + v1[j] * c1.x); } }
                    *(u32x4*)(Q + (size_t)row * 3072 + gcol * 32 + 8 * fq) = pack8(v0, v1); } }
    }
};
struct EpiKV {
    static constexpr bool PERM = true;
    bf16_t* KN; bf16_t* V; const float* ssq;
    __device__ __forceinline__ void operator()(const f32x4 (&acc)[2][2][4][2], const Unit& u, int wr, int wc, int fr, int fq) const {
        const int row0 = u.pm * BM + wr * 64 + fr, col0 = u.pn * 128 + wc * 32 + 8 * fq;
#pragma unroll
        for (int ai = 0; ai < 2; ++ai)
#pragma unroll
            for (int m = 0; m < 4; ++m) { const int row = row0 + ai * HALF + m * 16; const float rs = __builtin_amdgcn_rsqf(ssq[row] * (1.f / 512.f) + EPS);
                *(u32x4*)(KN + (size_t)row * DM + col0) = pack8(acc[ai][0][m][0] * rs, acc[ai][0][m][1] * rs);
                *(u32x4*)(V + (size_t)row * DM + col0) = pack8(acc[ai][1][m][0] * rs, acc[ai][1][m][1] * rs); }
    }
};
}

namespace att {
constexpr int NW = 8, QBLK = 32, KVBLK = 64, NT = (CTXL + SEQ) / KVBLK;
constexpr int SHM_V = KVBLK * 128 * 2, SHM_K = KVBLK * 192 * 2;
#ifndef ATT_NQREG
#define ATT_NQREG 12
#endif
constexpr int NQREG = ATT_NQREG, SHM_QR = (12 - NQREG) * 8192, SHM_ATTN = 3 * SHM_V + 3 * SHM_K + NW * 64 * 4 + SHM_QR + NW * 4096;
constexpr float THRL = 8.f * 1.4426950408889634f;
#define KSWZ(row, colB) ((row) * 384 + ((colB) ^ (((row) & 7) << 4)))
#define SBAR() __builtin_amdgcn_sched_barrier(0)
__device__ __forceinline__ int crow(int r, int hi) { return (r & 3) + 8 * (r >> 2) + 4 * hi; }
__device__ __forceinline__ void partialSM(f32x16& p0, f32x16& p1, float& m_reg, float& mn, float& alpha) {
  float pmax = p0[0];
#pragma unroll
  for (int r = 1; r < 16; ++r) pmax = fmaxf(pmax, p0[r]);
#pragma unroll
  for (int r = 0; r < 16; ++r) pmax = fmaxf(pmax, p1[r]);
  { auto rr = __builtin_amdgcn_permlane32_swap(__float_as_uint(pmax), __float_as_uint(pmax), false, false);
    pmax = fmaxf(__uint_as_float(rr[0]), __uint_as_float(rr[1])); }
  if (__builtin_expect(__all(pmax - m_reg <= THRL), 1)) { mn = m_reg; alpha = 1.f; }
  else { mn = fmaxf(m_reg, pmax); alpha = __builtin_amdgcn_exp2f(m_reg - mn); m_reg = mn; }
#pragma unroll
  for (int r = 0; r < 16; ++r) p0[r] = p0[r] - mn;
#pragma unroll
  for (int r = 0; r < 16; ++r) p1[r] = p1[r] - mn;
#pragma unroll
  for (int r = 0; r < 16; ++r) p0[r] = __builtin_amdgcn_exp2f(p0[r]);
}
__device__ __forceinline__ void finishSM(f32x16& p0, f32x16& p1, float alpha, float& l_reg, bf16x8& pa0, bf16x8& pa1, bf16x8& pa2, bf16x8& pa3) {
#pragma unroll
  for (int r = 0; r < 16; ++r) p1[r] = __builtin_amdgcn_exp2f(p1[r]);
  float ps = 0;
#pragma unroll
  for (int r = 0; r < 16; ++r) ps += p0[r];
#pragma unroll
  for (int r = 0; r < 16; ++r) ps += p1[r];
  { auto rr = __builtin_amdgcn_permlane32_swap(__float_as_uint(ps), __float_as_uint(ps), false, false);
    ps = __uint_as_float(rr[0]) + __uint_as_float(rr[1]); }
  l_reg = l_reg * alpha + ps;
#define PK4(P, BASE, OUT) do { unsigned a0 = cvt_pk_bf16(P[BASE + 0], P[BASE + 1]), a1 = cvt_pk_bf16(P[BASE + 2], P[BASE + 3]);   \
    unsigned b0 = cvt_pk_bf16(P[BASE + 4], P[BASE + 5]), b1 = cvt_pk_bf16(P[BASE + 6], P[BASE + 7]);                              \
    auto r0 = __builtin_amdgcn_permlane32_swap(a0, b0, false, false); auto r1 = __builtin_amdgcn_permlane32_swap(a1, b1, false, false); \
    u32x4 w = {r0[0], r1[0], r0[1], r1[1]}; OUT = *reinterpret_cast<bf16x8*>(&w); } while (0)
  PK4(p0, 0, pa0); PK4(p0, 8, pa1); PK4(p1, 0, pa2); PK4(p1, 8, pa3);
#undef PK4
}
__device__ __forceinline__ void qkt(f32x16& p0, f32x16& p1, const char* Ks, const bf16x8* qr, const char* Qr, int kbase) {
  p0 = f32x16{}; p1 = f32x16{};
  const char* kb = Ks + kbase;
  bf16x8 k0[4], k1[4];
#define KLD(d) do { k0[(d) % 4] = *reinterpret_cast<const bf16x8*>(kb + (d) * 512); k1[(d) % 4] = *reinterpret_cast<const bf16x8*>(kb + 12288 + (d) * 512); } while (0)
  KLD(0); KLD(1); KLD(2);
  __builtin_amdgcn_s_setprio(1);
#pragma unroll
  for (int d0 = 0; d0 < 12; ++d0) {
    if (d0 + 3 < 12) KLD(d0 + 3);
    const bf16x8 qf = d0 < NQREG ? qr[d0 < NQREG ? d0 : 0] : *reinterpret_cast<const bf16x8*>(Qr + (d0 - NQREG) * 8192);
    p0 = __builtin_amdgcn_mfma_f32_32x32x16_bf16(k0[d0 % 4], qf, p0, 0, 0, 0);
    p1 = __builtin_amdgcn_mfma_f32_32x32x16_bf16(k1[d0 % 4], qf, p1, 0, 0, 0);
    SBAR(); }
  __builtin_amdgcn_s_setprio(0);
#undef KLD
}
__device__ __forceinline__ int v_st(int k, int c) { const int kk = (k & ~0xC) | ((k & 4) << 1) | ((k & 8) >> 1); return ((kk >> 3) * 4 + (c >> 5)) * 512 + ((kk & 7) * 32 + (c & 31)) * 2; }
__device__ __forceinline__ int v_rd_base(int lane) { return ((lane & 3) << 3) | (((lane >> 2) & 3) << 6) | (((lane >> 4) & 1) << 5) | (((lane >> 5) & 1) << 8); }
constexpr int v_rd_off(int d0, int ks, int half) { return d0 * 512 + ks * 4096 + half * 2048; }
template <int OFF> __device__ __forceinline__ s16x4 tr_read(int vb) {
  s16x4 r; asm volatile("ds_read_b64_tr_b16 %0, %1 offset:%2" : "=&v"(r) : "v"(vb), "i"(OFF) : "memory"); return r;
}
struct VFrag { s16x4 l0, h0, l1, h1, l2, h2, l3, h3; };
template <int D0> __device__ __forceinline__ void v_read8(VFrag& f, int vb) {
  f.l0 = tr_read<v_rd_off(D0, 0, 0)>(vb); f.h0 = tr_read<v_rd_off(D0, 0, 1)>(vb); f.l1 = tr_read<v_rd_off(D0, 1, 0)>(vb); f.h1 = tr_read<v_rd_off(D0, 1, 1)>(vb);
  f.l2 = tr_read<v_rd_off(D0, 2, 0)>(vb); f.h2 = tr_read<v_rd_off(D0, 2, 1)>(vb); f.l3 = tr_read<v_rd_off(D0, 3, 0)>(vb); f.h3 = tr_read<v_rd_off(D0, 3, 1)>(vb);
}
__device__ __forceinline__ void pv_mma(f32x16& od, const VFrag& f, bf16x8 pa0, bf16x8 pa1, bf16x8 pa2, bf16x8 pa3) {
#define PK(L, H) (bf16x8){L[0], L[1], L[2], L[3], H[0], H[1], H[2], H[3]}
  od = __builtin_amdgcn_mfma_f32_32x32x16_bf16(pa0, PK(f.l0, f.h0), od, 0, 0, 0);
  od = __builtin_amdgcn_mfma_f32_32x32x16_bf16(pa1, PK(f.l1, f.h1), od, 0, 0, 0);
  od = __builtin_amdgcn_mfma_f32_32x32x16_bf16(pa2, PK(f.l2, f.h2), od, 0, 0, 0);
  od = __builtin_amdgcn_mfma_f32_32x32x16_bf16(pa3, PK(f.l3, f.h3), od, 0, 0, 0);
#undef PK
}
__device__ __forceinline__ void pv_d0(f32x16* o, int vb, bf16x8 pa0, bf16x8 pa1, bf16x8 pa2, bf16x8 pa3) {
  VFrag fa, fb;
  v_read8<0>(fa, vb); v_read8<1>(fb, vb);
  asm volatile("s_waitcnt lgkmcnt(8)" ::: "memory"); SBAR(); pv_mma(o[0], fa, pa0, pa1, pa2, pa3); SBAR();
  v_read8<2>(fa, vb);
  asm volatile("s_waitcnt lgkmcnt(8)" ::: "memory"); SBAR(); pv_mma(o[1], fb, pa0, pa1, pa2, pa3); SBAR();
  v_read8<3>(fb, vb);
  asm volatile("s_waitcnt lgkmcnt(8)" ::: "memory"); SBAR(); pv_mma(o[2], fa, pa0, pa1, pa2, pa3); SBAR();
  asm volatile("s_waitcnt lgkmcnt(0)" ::: "memory"); SBAR(); pv_mma(o[3], fb, pa0, pa1, pa2, pa3); SBAR();
}
constexpr int SLOT_K = SHM_K, SLOT_V = SHM_V, RING_BYTES = 3 * (SLOT_K + SLOT_V);
constexpr int NUNITS = NB * 16 * (SEQ / 256);
__device__ __forceinline__ void attn_phase(const bf16_t* __restrict__ Q, const bf16_t* __restrict__ KN, const bf16_t* __restrict__ KR, const bf16_t* __restrict__ V,
                                           const bf16_t* __restrict__ SG, bf16_t* __restrict__ Z, int vcu, int G, char* lds, LAS unsigned char* ldsl) {
  const int tid = threadIdx.x, wid = __builtin_amdgcn_readfirstlane(tid >> 6), lane = tid & 63, r32 = lane & 31, hi = lane >> 5;
  char* K_lds = lds; char* V_lds = lds + 3 * SLOT_K;
  float* wsf = (float*)(lds + RING_BYTES) + wid * 64; float* li_l = wsf; float* al_l = wsf + 32;
  char* Qr = lds + RING_BYTES + NW * 64 * 4 + tid * 16;
  const int vb0 = (int)(uintptr_t)V_lds + v_rd_base(lane);
  const int kbase = ((r32 >> 4) * 384 + (r32 & 15)) * 16 + hi * 256;
  int kofs[6], vofs[4]; bool krope[6];
  const int wq = wid & 3;
#pragma unroll
  for (int i = 0; i < 6; ++i) { const int p = 6 * wq + i, row = (p / 6) * 16 + (lane & 15), chunk = 4 * (p % 6) + (lane >> 4);
    krope[i] = chunk >= 16; kofs[i] = krope[i] ? row * 128 + (chunk - 16) * 16 : row * 4096 + chunk * 16; }
#pragma unroll
  for (int i = 0; i < 4; ++i) { const int B = (4 * wq + i) * 1024 + lane * 16, sub = B >> 9, within = (B & 511) >> 1, kk = (sub >> 2) * 8 + (within >> 5);
    const int k = (kk & ~0xC) | ((kk & 4) << 1) | ((kk & 8) >> 1), c = (sub & 3) * 32 + (within & 31); vofs[i] = k * 4096 + c * 2; }
#define KROW(j, b_) ((j) < 4 ? ML + (b_) * CTXL + (j) * KVBLK : (b_) * SEQ + ((j) - 4) * KVBLK)
#define DMA_K(j, b_, h_, slot) do { const int rb_ = KROW(j, b_); \
    const char* kn_ = (const char*)KN + (size_t)rb_ * 4096 + (h_) * 256; const char* kr_ = (const char*)KR + (size_t)rb_ * 128; \
    _Pragma("unroll") for (int i_ = 0; i_ < 6; ++i_) __builtin_amdgcn_global_load_lds((const unsigned*)((krope[i_] ? kr_ : kn_) + kofs[i_]), (LAS unsigned*)(ldsl + (slot) * SLOT_K + (6 * wq + i_) * 1024), 16, 0, 0); } while (0)
#define DMA_V(j, b_, h_, slot) do { const int rb_ = KROW(j, b_); const char* v_ = (const char*)V + (size_t)rb_ * 4096 + (h_) * 256; \
    _Pragma("unroll") for (int i_ = 0; i_ < 4; ++i_) __builtin_amdgcn_global_load_lds((const unsigned*)(v_ + vofs[i_]), (LAS unsigned*)(ldsl + 3 * SLOT_K + (slot) * SLOT_V + (4 * wq + i_) * 1024), 16, 0, 0); } while (0)
#define TILE_SYNC() do { asm volatile("s_waitcnt vmcnt(0)" ::: "memory"); __syncthreads(); } while (0)
#define RESC(a) do { if (__any((a) < 1.f)) { if (hi == 0) al_l[r32] = (a); asm volatile("s_waitcnt lgkmcnt(0)" ::: "memory"); \
    _Pragma("unroll") for (int d = 0; d < 4; ++d) _Pragma("unroll") for (int r = 0; r < 16; ++r) o[d][r] *= al_l[crow(r, hi)]; } } while (0)
  const int half = wid >> 2;
  const int nun_wg = vcu < NUNITS ? (NUNITS - 1 - vcu) / G + 1 : 0, T = nun_wg * NT;
#define ABAR() do { asm volatile("s_waitcnt lgkmcnt(0)" ::: "memory"); __builtin_amdgcn_s_barrier(); asm volatile("" ::: "memory"); } while (0)
#define VWAIT() asm volatile("s_waitcnt vmcnt(0)" ::: "memory")
#define DMA_TK(t_) do { const int ui_ = (t_) / NT, j_ = (t_) - ui_ * NT, un_ = vcu + ui_ * G; DMA_K(j_, (un_ >> 7), ((un_ >> 3) & 15), ((t_) % 3)); } while (0)
#define DMA_TV(t_) do { const int ui_ = (t_) / NT, j_ = (t_) - ui_ * NT, un_ = vcu + ui_ * G; DMA_V(j_, (un_ >> 7), ((un_ >> 3) & 15), ((t_) % 3)); } while (0)
#define LOADQ(un_) do { const int qb_ = (un_) & 7, h_ = ((un_) >> 3) & 15, b_ = (un_) >> 7; const bf16_t* Qw = Q + (size_t)(b_ * SEQ + qb_ * 256 + wid * QBLK + r32) * 3072 + h_ * 192 + hi * 8; \
    _Pragma("unroll") for (int d0 = 0; d0 < NQREG; ++d0) qr[d0] = *reinterpret_cast<const bf16x8*>(Qw + d0 * 16); \
    _Pragma("unroll") for (int d0 = NQREG; d0 < 12; ++d0) *reinterpret_cast<bf16x8*>(Qr + (d0 - NQREG) * 8192) = *reinterpret_cast<const bf16x8*>(Qw + d0 * 16); } while (0)
#define EPILOGUE(un_) do { const int qb_ = (un_) & 7, h_ = ((un_) >> 3) & 15, b_ = (un_) >> 7; \
    if (hi == 0) li_l[r32] = l_reg; asm volatile("s_waitcnt lgkmcnt(0)" ::: "memory"); \
    const size_t ob = (size_t)(b_ * SEQ + qb_ * 256 + wid * QBLK + (lane >> 3)) * DM + h_ * 128 + (lane & 7) * 8; \
    _Pragma("unroll") for (int hf = 0; hf < 2; ++hf) { \
      _Pragma("unroll") for (int r = 0; r < 16; ++r) { const float rl = __builtin_amdgcn_rcpf(li_l[crow(r, hi)]); \
        _Pragma("unroll") for (int dd = 0; dd < 2; ++dd) epi[crow(r, hi) * 64 + dd * 32 + r32] = (bf16_t)(cvt_pk_bf16(o[hf * 2 + dd][r] * rl, 0.f) & 0xffffu); } \
      asm volatile("s_waitcnt lgkmcnt(0)" ::: "memory"); \
      _Pragma("unroll") for (int i4 = 0; i4 < 4; ++i4) { const u32x4 ov = *(const u32x4*)(epi + (i4 * 8 + (lane >> 3)) * 64 + (lane & 7) * 8); \
        const size_t gi = ob + (size_t)(i4 * 8) * DM + hf * 64; const u32x4 gv = *(const u32x4*)(SG + gi); u32x4 zv; \
        zv.x = cvt_pk_bf16(bf_lo(ov.x) * bf_lo(gv.x), bf_hi(ov.x) * bf_hi(gv.x)); zv.y = cvt_pk_bf16(bf_lo(ov.y) * bf_lo(gv.y), bf_hi(ov.y) * bf_hi(gv.y)); \
        zv.z = cvt_pk_bf16(bf_lo(ov.z) * bf_lo(gv.z), bf_hi(ov.z) * bf_hi(gv.z)); zv.w = cvt_pk_bf16(bf_lo(ov.w) * bf_lo(gv.w), bf_hi(ov.w) * bf_hi(gv.w)); \
        *(u32x4*)(Z + gi) = zv; } \
      asm volatile("s_waitcnt lgkmcnt(0)" ::: "memory"); } } while (0)
  bf16_t* epi = (bf16_t*)(lds + RING_BYTES + NW * 64 * 4 + SHM_QR + wid * 4096);
  if (T > 0) {
    float m_reg = -1e30f, l_reg = 0, mn, al; f32x16 o[4] = {}; bf16x8 qr[NQREG]; f32x16 p0, p1; bf16x8 pa0, pa1, pa2, pa3;
    if (half == 1) { DMA_TK(0); DMA_TK(1); } else { DMA_TV(0); DMA_TV(1); }
    LOADQ(vcu);
    VWAIT(); __syncthreads();
    if (half == 1) ABAR();
    int slot = 0, pslot = 2, t = 0;
#define SEG_S() do { const bool vis_ = (half == 0) && t >= 1 && t + 1 < T; \
      if (half == 1) { if (t + 2 < T) DMA_TK(t + 2); } else if (vis_) DMA_TV(t + 1); \
      partialSM(p0, p1, m_reg, mn, al); RESC(al); finishSM(p0, p1, al, l_reg, pa0, pa1, pa2, pa3); \
      if (half == 0) { if (vis_) asm volatile("s_waitcnt vmcnt(4)" ::: "memory"); else VWAIT(); } \
      SBAR(); ABAR(); pslot = slot; slot = slot == 2 ? 0 : slot + 1; ++t; } while (0)
    for (int ui = 0; ui < nun_wg; ++ui) {
      SBAR();
      if (ui > 0) {
        pv_d0(o, vb0 + pslot * SLOT_V, pa0, pa1, pa2, pa3);
        EPILOGUE(vcu + (ui - 1) * G);
        m_reg = -1e30f; l_reg = 0;
#pragma unroll
        for (int d = 0; d < 4; ++d) o[d] = f32x16{};
        LOADQ(vcu + ui * G);
      }
      qkt(p0, p1, K_lds + slot * SLOT_K, qr, Qr, kbase);
      if (half == 1) VWAIT();
      SBAR(); ABAR();
      SEG_S();
      for (int j = 1; j < NT; ++j) {
        SBAR();
        qkt(p0, p1, K_lds + slot * SLOT_K, qr, Qr, kbase); SBAR();
        pv_d0(o, vb0 + pslot * SLOT_V, pa0, pa1, pa2, pa3);
        if (half == 1) VWAIT();
        SBAR(); ABAR();
        SEG_S();
      }
    }
#undef SEG_S
    pv_d0(o, vb0 + pslot * SLOT_V, pa0, pa1, pa2, pa3);
    EPILOGUE(vcu + (nun_wg - 1) * G);
    if (half == 0) ABAR();
  }
  asm volatile("s_waitcnt vmcnt(0)" ::: "memory"); __syncthreads();
#undef ABAR
#undef VWAIT
#undef DMA_TK
#undef DMA_TV
#undef LOADQ
#undef EPILOGUE
#undef KROW
#undef DMA_K
#undef DMA_V
#undef TILE_SYNC
#undef RESC
}
}


#define XB_TMO      128
#define XB_XCNT(j)  (256  + 64 * (j))
#define XB_XSUB(j)  (1280 + 64 * (j))
#define XB_XGEN(j)  (2304 + 64 * (j))
#define XB_TOP      3328
#define XB_TOPGEN   3392
#define XCD_BAR_WORDS 3456
#define XB_SPIN_CAP (1u << 22)
__device__ __forceinline__ unsigned xb_ld(unsigned* p)              { return __hip_atomic_load(p, __ATOMIC_RELAXED, __HIP_MEMORY_SCOPE_AGENT); }
__device__ __forceinline__ unsigned xb_add(unsigned* p, unsigned v) { return __hip_atomic_fetch_add(p, v, __ATOMIC_RELAXED, __HIP_MEMORY_SCOPE_AGENT); }
__device__ __forceinline__ unsigned xb_xcc_id() { return (unsigned)__builtin_amdgcn_s_getreg((3 << 11) | 20) & 0xFu; }
#define XB_SPIN(cond, bar) do { unsigned _sp = 0; while (cond) { __builtin_amdgcn_s_sleep(1); \
    if ((++_sp & 255u) == 0u) { if (xb_ld(&(bar)[XB_TMO])) break; if (_sp > XB_SPIN_CAP) { atomicAdd(&(bar)[XB_TMO], 1u); break; } } } } while (0)
struct XcdBarrier { unsigned* bar; unsigned x; volatile LAS unsigned* st; };
__device__ __forceinline__ XcdBarrier xcd_barrier_post(unsigned* bar, volatile LAS unsigned* st) {
    XcdBarrier b; b.bar = bar; b.x = xb_xcc_id(); b.st = st;
    if (threadIdx.x == 0) (void)xb_add(&bar[XB_XCNT(b.x)], 1u);
    return b;
}
__device__ __forceinline__ void xcd_barrier_complete(unsigned* bar, unsigned x, unsigned& nloc, unsigned& nx) {
    const unsigned G = gridDim.x;
    unsigned sum, cnt, mine, sp = 0u;
    for (;;) {
        sum = 0u; cnt = 0u; mine = 0u;
#pragma unroll
        for (unsigned j = 0; j < 16; ++j) { const unsigned c = xb_ld(&bar[XB_XCNT(j)]); sum += c; cnt += (c > 0u) ? 1u : 0u; mine = (j == x) ? c : mine; }
        if (sum == G) break;
        __builtin_amdgcn_s_sleep(1);
        if ((++sp & 255u) == 0u) { if (xb_ld(&bar[XB_TMO])) break; if (sp > XB_SPIN_CAP) { atomicAdd(&bar[XB_TMO], 1u); break; } }
    }
    nloc = mine > 0u ? mine : 1u; nx = cnt > 0u ? cnt : 1u;
}
__device__ __forceinline__ void xcd_barrier(const XcdBarrier& b) {
    asm volatile("s_waitcnt vmcnt(0)" ::: "memory");
    __syncthreads();
    if (threadIdx.x == 0) {
        unsigned* bar = b.bar;
        __builtin_amdgcn_s_waitcnt(0);
        unsigned nloc = b.st[0], nx = b.st[1];
        if (nloc == 0u) { xcd_barrier_complete(bar, b.x, nloc, nx); b.st[0] = nloc; b.st[1] = nx; }
        const unsigned old = xb_add(&bar[XB_XSUB(b.x)], 1u);
        const unsigned gen = old / nloc;
        if (old + 1u == (gen + 1u) * nloc) {
            __builtin_amdgcn_fence(__ATOMIC_RELEASE, "agent");
            asm volatile("s_waitcnt vmcnt(0)" ::: "memory");
            const unsigned og = xb_add(&bar[XB_TOP], 1u);
            const unsigned tg = og / nx;
            if (og + 1u == (tg + 1u) * nx) xb_add(&bar[XB_TOPGEN], 1u);
            else XB_SPIN(xb_ld(&bar[XB_TOPGEN]) == tg, bar);
            __builtin_amdgcn_fence(__ATOMIC_ACQUIRE, "agent");
            xb_add(&bar[XB_XGEN(b.x)], 1u);
            asm volatile("s_waitcnt vmcnt(0)" ::: "memory");
        } else {
            XB_SPIN(xb_ld(&bar[XB_XGEN(b.x)]) == gen, bar);
            __builtin_amdgcn_fence(__ATOMIC_ACQUIRE, "agent");
            asm volatile("s_waitcnt vmcnt(0)" ::: "memory");
        }
    }
    __syncthreads();
}
constexpr int NWAVES = 8;
constexpr int LDS_BYTES = 163840;
constexpr int N_PHASES = 12;
constexpr int MISC_OFF = 163840 - 256; static_assert(att::SHM_ATTN <= MISC_OFF, "LDS map");


struct Frame {
    LAS unsigned char* lds;
    int tid, lane, wave, gw, NGW, G;
    unsigned char* ws;
};

struct Args { const float* in[19]; float* out; unsigned char* ws; int ph_lo, ph_hi; };
struct TrDesc { const float* W; bf16_t* WT; const float* gk; int K, N, item; bool reorder; };
__device__ __forceinline__ void tr_load(const TrDesc& d, int lane, f32x4 (&wv)[8]) {
    const int nblk = d.N / 32, kb = d.item / nblk, nb = d.item % nblk, k0 = 64 * kb, n0 = 32 * nb;
#pragma unroll
    for (int i = 0; i < 8; ++i) wv[i] = *(const f32x4*)(d.W + (size_t)(k0 + 8 * i + (lane >> 3)) * d.N + n0 + (lane & 7) * 4);
}
__device__ __forceinline__ void tr_finish(const TrDesc& d, int lane, const f32x4 (&wv)[8], LAS float* scr) {
    const int nblk = d.N / 32, kb = d.item / nblk, nb = d.item % nblk, k0 = 64 * kb, n0 = 32 * nb;
    const int d0 = d.reorder ? (nb < 32 ? n0 : (nb < 34 ? n0 + 2048 : n0 - 64)) : n0;
#pragma unroll
    for (int i = 0; i < 8; ++i) { const int kk = 8 * i + (lane >> 3); f32x4 v = wv[i]; if (d.gk) v = v * d.gk[k0 + kk];
        LAS float* p = scr + kk * 33 + (lane & 7) * 4; p[0] = v[0]; p[1] = v[1]; p[2] = v[2]; p[3] = v[3]; }
    asm volatile("s_waitcnt lgkmcnt(0)" ::: "memory");
    const int c = lane & 7;
#pragma unroll
    for (int j = 0; j < 4; ++j) { const int n = (lane >> 3) + 8 * j; const LAS float* sp = scr + (8 * c) * 33 + n;
        u32x4 o; o.x = cvt_pk_bf16(sp[0 * 33], sp[1 * 33]); o.y = cvt_pk_bf16(sp[2 * 33], sp[3 * 33]); o.z = cvt_pk_bf16(sp[4 * 33], sp[5 * 33]); o.w = cvt_pk_bf16(sp[6 * 33], sp[7 * 33]);
        *(u32x4*)(d.WT + (size_t)(d0 + n) * d.K + k0 + 8 * c) = o; }
    asm volatile("s_waitcnt lgkmcnt(0)" ::: "memory");
}
constexpr int I_WIN = 32 * 128, I_WG = 4 * 8 * 16, I_WOUT = 32 * 64, I_WMLA = 32 * 98, I_WUQ = 8 * 96, I_WUKV = 8 * 128, I_WMO = 32 * 64;
constexpr int I_LIST0 = I_WIN + I_WG + I_WOUT, I_LIST1 = I_WMLA + I_WUQ + I_WUKV, I_LIST2 = I_WMO;
__device__ __forceinline__ TrDesc tr_desc(const Args& a, int list, int r) {
    unsigned char* ws = a.ws; TrDesc d; d.gk = nullptr; d.reorder = false;
    if (list == 0) {
        if (r < I_WIN) { d.W = a.in[8]; d.WT = (bf16_t*)(ws + WS_WIN); d.K = DM; d.N = 4096; d.item = r; return d; } r -= I_WIN;
        if (r < I_WG) { const int g = r / 128; d.W = a.in[9] + (size_t)g * 512 * 512; d.WT = (bf16_t*)(ws + WS_WG) + (size_t)g * 512 * 512; d.K = 512; d.N = 512; d.item = r % 128; return d; } r -= I_WG;
        d.W = a.in[12]; d.WT = (bf16_t*)(ws + WS_WOUT); d.K = DM; d.N = DM; d.item = r; return d;
    }
    if (list == 1) {
    if (r < I_WMLA) { d.W = a.in[13]; d.WT = (bf16_t*)(ws + WS_WMLA); d.K = DM; d.N = 3136; d.item = r; d.reorder = true; return d; } r -= I_WMLA;
    if (r < I_WUQ) { d.W = a.in[16]; d.WT = (bf16_t*)(ws + WS_WUQ); d.K = 512; d.N = 3072; d.item = r; d.gk = a.in[14]; return d; } r -= I_WUQ;
    { d.W = a.in[17]; d.WT = (bf16_t*)(ws + WS_WUKV); d.K = 512; d.N = 4096; d.item = r; d.gk = a.in[15]; return d; } }
    d.W = a.in[18]; d.WT = (bf16_t*)(ws + WS_WMO); d.K = DM; d.N = DM; d.item = r; return d;
}
__device__ __forceinline__ void tr_run(const Args& a, int list, int first, int stride, int lane, LAS float* scr, int n_end = -1) {
    const int n = n_end >= 0 ? n_end : (list == 0 ? I_LIST0 : (list == 1 ? I_LIST1 : I_LIST2));
    int it = first; if (it >= n) return;
    TrDesc d = tr_desc(a, list, it); f32x4 wv[8]; tr_load(d, lane, wv);
    for (;;) {
        const int nit = it + stride; const bool more = nit < n;
        TrDesc dn = d; f32x4 wn[8];
        if (more) { dn = tr_desc(a, list, nit); tr_load(dn, lane, wn); }
        tr_finish(d, lane, wv, scr);
        if (!more) break;
#pragma unroll
        for (int i = 0; i < 8; ++i) wv[i] = wn[i];
        d = dn; it = nit;
    }
}

__device__ __forceinline__ void gemv_item(const float* c, const float* c_ctx, const float* ada_w, const float* ada_b, float* mod, int it, int lane) {
    const int l = it / 768, rem = it % 768, kc = rem / 24, cgp = rem % 24, k0 = kc * 64;
    float s[9];
#pragma unroll
    for (int r = 0; r < 8; ++r) s[r] = silu_f(c[r * DM + k0 + lane]);
    s[8] = silu_f(c_ctx[k0 + lane]);
    const float* W = ada_w + (size_t)l * DM * 6144 + (size_t)k0 * 6144 + cgp * 256 + lane * 4;
    f32x4 acc[9];
#pragma unroll
    for (int r = 0; r < 9; ++r) acc[r] = (f32x4){0.f, 0.f, 0.f, 0.f};
#pragma unroll 16
    for (int kk = 0; kk < 64; ++kk) { const f32x4 w = *(const f32x4*)(W + (size_t)kk * 6144);
#pragma unroll
        for (int r = 0; r < 9; ++r) { const float sk = __uint_as_float(__builtin_amdgcn_readlane(__float_as_uint(s[r]), kk)); acc[r] += w * sk; } }
    const int col = cgp * 256 + lane * 4;
    f32x4 bv = (f32x4){0.f, 0.f, 0.f, 0.f};
    if (kc == 0) bv = *(const f32x4*)(ada_b + l * 6144 + col);
#pragma unroll
    for (int r = 0; r < 9; ++r) { float* m = mod + (size_t)(l * 9 + r) * 6144 + col;
#pragma unroll
        for (int j = 0; j < 4; ++j) atomicAdd(m + j, acc[r][j] + bv[j]); }
}

__device__ __forceinline__ void load_row_f32(const float* p, int lane, f32x4 (&v)[8]) {
#pragma unroll
    for (int j = 0; j < 8; ++j) v[j] = *(const f32x4*)(p + 4 * lane + 256 * j);
}
__device__ __forceinline__ float sumsq8(const f32x4 (&v)[8]) {
    float s = 0.f;
#pragma unroll
    for (int j = 0; j < 8; ++j) s += (v[j][0] * v[j][0] + v[j][1] * v[j][1]) + (v[j][2] * v[j][2] + v[j][3] * v[j][3]);
    return wave_sum(s);
}
__device__ __forceinline__ void modulate_store(const f32x4 (&v)[8], float rstd, const float* pn, const float* modr, bf16_t* orow, int lane) {
#pragma unroll
    for (int j = 0; j < 8; ++j) { const int col = 4 * lane + 256 * j;
        const f32x4 g = *(const f32x4*)(pn + col), sh = *(const f32x4*)(modr + col), sc = *(const f32x4*)(modr + DM + col);
        const f32x4 hh = v[j] * rstd * g * (sc + 1.f) + sh;
        u32x2 w; w.x = cvt_pk_bf16(hh[0], hh[1]); w.y = cvt_pk_bf16(hh[2], hh[3]);
        *(u32x2*)(orow + col) = w; }
}


template <int WIN> __device__ __forceinline__ void pool_chunk(const bf16_t* Ub, bf16_t* Pb, int t0, int L) {
    constexpr int LEFT = WIN / 2, RIGHT = WIN - 1 - LEFT, NR = 8 + WIN - 1;
    u32x4 rw[NR];
#pragma unroll
    for (int k = 0; k < NR; ++k) { const int t = t0 - LEFT + k; rw[k] = (t >= 0 && t < L) ? *(const u32x4*)(Ub + (size_t)t * DM) : (u32x4){0u, 0u, 0u, 0u}; }
    float S8[8];
#pragma unroll
    for (int e = 0; e < 8; ++e) S8[e] = 0.f;
#define ACC8(q_, sgn) do { const u32x4 a_ = (q_); S8[0] += sgn bf_lo(a_.x); S8[1] += sgn bf_hi(a_.x); S8[2] += sgn bf_lo(a_.y); S8[3] += sgn bf_hi(a_.y); \
                          S8[4] += sgn bf_lo(a_.z); S8[5] += sgn bf_hi(a_.z); S8[6] += sgn bf_lo(a_.w); S8[7] += sgn bf_hi(a_.w); } while (0)
#pragma unroll
    for (int k = 0; k < WIN; ++k) ACC8(rw[k], +);
#pragma unroll
    for (int i = 0; i < 8; ++i) { const int t = t0 + i; const int lo_ = t - LEFT < 0 ? 0 : t - LEFT, hi_ = t + RIGHT + 1 > L ? L : t + RIGHT + 1;
        const float inv = 1.f / (float)(hi_ - lo_); const u32x4 w = rw[i + LEFT];
        u32x4 o; o.x = cvt_pk_bf16(S8[0] * inv - bf_lo(w.x), S8[1] * inv - bf_hi(w.x)); o.y = cvt_pk_bf16(S8[2] * inv - bf_lo(w.y), S8[3] * inv - bf_hi(w.y));
        o.z = cvt_pk_bf16(S8[4] * inv - bf_lo(w.z), S8[5] * inv - bf_hi(w.z)); o.w = cvt_pk_bf16(S8[6] * inv - bf_lo(w.w), S8[7] * inv - bf_hi(w.w));
        *(u32x4*)(Pb + (size_t)t * DM) = o;
        if (i < 7) { ACC8(rw[i + WIN], +); ACC8(rw[i], -); } }
#undef ACC8
}

__global__ void __launch_bounds__(NWAVES * 64, 2) mk_fwd(Args args) {
    extern __shared__ __attribute__((aligned(16))) unsigned char lds[];
    cg::grid_group grid = cg::this_grid();
    Frame F;
    F.lds = (LAS unsigned char*)lds;
    F.tid = threadIdx.x; F.lane = F.tid & 63; F.wave = __builtin_amdgcn_readfirstlane(F.tid >> 6);
    F.G = gridDim.x; F.gw = blockIdx.x * NWAVES + F.wave; F.NGW = F.G * NWAVES; F.ws = args.ws;
    unsigned char* ws = args.ws;
    const int lo = args.ph_lo, hi = args.ph_hi;
#ifndef PHASE_MASK
#define PHASE_MASK 0xFFF
#endif
#define IN(k) (((PHASE_MASK >> (k)) & 1) && lo <= (k) && (k) < hi)
#ifndef DBL_MASK
#define DBL_MASK 0
#endif

#define SEAM(k) do { if (IN(k) && IN((k) + 1)) xcd_barrier(bar); } while (0)
    if (args.ph_hi > 4096) grid.sync();
    volatile LAS unsigned* MISC = (volatile LAS unsigned*)(F.lds + MISC_OFF);
    if (F.tid < 16) MISC[F.tid] = 0u;
    __syncthreads();
    XcdBarrier bar; bar.bar = (unsigned*)(args.ws + WS_BAR); bar.x = 0; bar.st = MISC;
    if (hi - lo > 1) bar = xcd_barrier_post((unsigned*)(args.ws + WS_BAR), MISC);
    const float* x = args.in[0]; const float* c = args.in[1]; const float* ctx = args.in[2]; const float* c_ctx = args.in[3];
    const float* ada_w = args.in[4]; const float* ada_b = args.in[5]; const float* pre_norm = args.in[6]; const float* post_norm = args.in[7];
    float* mod = (float*)(ws + WS_MOD); float* ssq = (float*)(ws + WS_SSQ); f32x2* tab = (f32x2*)(ws + WS_TAB);
    bf16_t* WIN = (bf16_t*)(ws + WS_WIN); bf16_t* WG = (bf16_t*)(ws + WS_WG); bf16_t* WOUT = (bf16_t*)(ws + WS_WOUT); bf16_t* WMLA = (bf16_t*)(ws + WS_WMLA);
    bf16_t* WUQ = (bf16_t*)(ws + WS_WUQ); bf16_t* WUKV = (bf16_t*)(ws + WS_WUKV); bf16_t* WMO = (bf16_t*)(ws + WS_WMO);
    bf16_t* H = (bf16_t*)(ws + WS_H); bf16_t* SG = (bf16_t*)(ws + WS_SG); bf16_t* Z = (bf16_t*)(ws + WS_Z); bf16_t* Y = (bf16_t*)(ws + WS_Y);
    bf16_t* U = (bf16_t*)(ws + WS_U); bf16_t* P = (bf16_t*)(ws + WS_P); bf16_t* Q = (bf16_t*)(ws + WS_Q); bf16_t* CQ = (bf16_t*)(ws + WS_CQ);
    bf16_t* CKV = (bf16_t*)(ws + WS_CKV); bf16_t* KR = (bf16_t*)(ws + WS_KR); bf16_t* KN = (bf16_t*)(ws + WS_KN); bf16_t* V = (bf16_t*)(ws + WS_V);
    const int NTHR = F.G * NWAVES * 64;
#define FRESH() int gtid; do { int t_ = threadIdx.x; asm volatile("" : "+v"(t_)); F.tid = t_; F.lane = t_ & 63; gtid = blockIdx.x * (NWAVES * 64) + t_; (void)gtid; } while (0)

    if (IN(0)) { FRESH();
        LAS float* scr = (LAS float*)(F.lds + F.wave * 16384);
        constexpr int I_GEMV = 2 * 32 * 24;
        if (F.G == 256) {
            if (F.wave < 3) gemv_item(c, c_ctx, ada_w, ada_b, mod, (int)blockIdx.x * 3 + F.wave, F.lane);
            const int b0 = (int)blockIdx.x * 26 + (F.wave < 3 ? F.wave * 2 : 6 + (F.wave - 3) * 4);
            tr_run(args, 0, b0, 1, F.lane, scr, b0 + (F.wave < 3 ? 2 : 4));
        } else {
            for (int it = F.gw; it < I_GEMV; it += F.NGW) gemv_item(c, c_ctx, ada_w, ada_b, mod, it, F.lane);
            tr_run(args, 0, F.gw, F.NGW, F.lane, scr); tr_run(args, 1, F.gw, F.NGW, F.lane, scr); tr_run(args, 2, F.gw, F.NGW, F.lane, scr);
        }
        for (int i = gtid; i < (NMLA - 3136) * DM / 8; i += NTHR) *(u32x4*)(WMLA + (size_t)3136 * DM + (size_t)i * 8) = (u32x4){0u, 0u, 0u, 0u};
        if (gtid < 1024) { const int pos = gtid >> 4, i = gtid & 15; const float fr = powf(10000.f, -(float)i / 16.f); const float ang = (float)pos * fr; float sn, cs; sincosf(ang, &sn, &cs); tab[gtid] = (f32x2){cs, sn}; }
    }
    SEAM(0);
    if (IN(1)) { FRESH();
        for (int row0 = F.gw * 3; row0 < MT; row0 += F.NGW * 3) {
            f32x4 v[3][8];
#pragma unroll
            for (int q = 0; q < 3; ++q) { const int row = row0 + q; const float* src = row < ML ? x + (size_t)row * DM : ctx + (size_t)(row - ML) * DM; load_row_f32(src, F.lane, v[q]); }
#pragma unroll
            for (int q = 0; q < 3; ++q) { const int row = row0 + q; const int r = row < ML ? row / SEQ : 8;
                const float rstd = __builtin_amdgcn_rsqf(sumsq8(v[q]) * (1.f / DM) + EPS);
                modulate_store(v[q], rstd, pre_norm, mod + (size_t)r * 6144, H + (size_t)row * DM, F.lane); }
        }
    }
    SEAM(1);
    if (IN(2)) {
        pg8::Gemm g{H, WIN, MT, 4096, DM, DM, DM, 0}; pg8::StaticOrder S; S.init(MT, 4096, F.G, (int)blockIdx.x);
        pg8::EpiPoolIn E{U, SG};
        pg8::gemm_phase<pg8::EpiPoolIn>(F.lds, g, S, E);
        if (F.G == 256 && (int)blockIdx.x >= 128)
            tr_run(args, 1, ((int)blockIdx.x - 128) * NWAVES + F.wave, 128 * NWAVES, threadIdx.x & 63, (LAS float*)(F.lds + F.wave * 16384));
    }
    SEAM(2);
    if (IN(3)) { FRESH();
        for (int item = gtid; item < (MT / 8) * 256; item += NTHR) {
            const int cc = item & 255, row0 = (item >> 8) * 8;
            int base, L; if (row0 < ML) { base = row0 & ~(SEQ - 1); L = SEQ; } else { base = ML + ((row0 - ML) & ~(CTXL - 1)); L = CTXL; }
            const int t0 = row0 - base, gidx = cc >> 6;
            const bf16_t* Ub = U + (size_t)base * DM + cc * 8; bf16_t* Pb = P + (size_t)base * DM + cc * 8;
            switch (gidx) {
                case 0: pool_chunk<2>(Ub, Pb, t0, L); break;
                case 1: pool_chunk<4>(Ub, Pb, t0, L); break;
                case 2: pool_chunk<8>(Ub, Pb, t0, L); break;
                default: pool_chunk<16>(Ub, Pb, t0, L); break;
            }
        }
    }
    SEAM(3);
    if (IN(4)) {
        pg8::Gemm g{P, WG, MT, DM, 512, DM, 512, 2}; pg8::StaticOrder S; S.init(MT, DM, F.G, (int)blockIdx.x);
        pg8::EpiGrp E{SG, Z, args.in[10], args.in[11]};
        pg8::gemm_phase<pg8::EpiGrp>(F.lds, g, S, E);
    }
    SEAM(4);
    if (IN(5)) {
        pg8::Gemm g{Z, WOUT, MT, DM, DM, DM, DM, 0}; pg8::StaticOrder S; S.init(MT, DM, F.G, (int)blockIdx.x);
        pg8::EpiPlain E{Y, DM};
        pg8::gemm_phase<pg8::EpiPlain>(F.lds, g, S, E);
        if (F.G == 256 && (int)blockIdx.x >= 64) {
            const int lb = (int)blockIdx.x - 64;
            if (F.wave < 4) gemv_item(c, c_ctx, ada_w, ada_b, mod, 768 + lb * 4 + F.wave, threadIdx.x & 63);
            else tr_run(args, 2, lb * 4 + (F.wave - 4), 192 * 4, threadIdx.x & 63, (LAS float*)(F.lds + F.wave * 16384));
        }
    }
    SEAM(5);
    if (IN(6)) { FRESH();
        for (int row0 = F.gw * 3; row0 < MT; row0 += F.NGW * 3) {
            f32x4 v[3][8]; u32x2 yw[3][8];
#pragma unroll
            for (int q = 0; q < 3; ++q) { const int row = row0 + q; const float* src = row < ML ? x + (size_t)row * DM : ctx + (size_t)(row - ML) * DM; load_row_f32(src, F.lane, v[q]);
                const bf16_t* yr = Y + (size_t)row * DM;
#pragma unroll
                for (int j = 0; j < 8; ++j) yw[q][j] = *(const u32x2*)(yr + 4 * F.lane + 256 * j); }
#pragma unroll
            for (int q = 0; q < 3; ++q) { const int row = row0 + q; const bool lat = row < ML; const int r = lat ? row / SEQ : 8;
                float sy = 0.f;
#pragma unroll
                for (int j = 0; j < 8; ++j) { const float a = bf_lo(yw[q][j].x), b = bf_hi(yw[q][j].x), c2 = bf_lo(yw[q][j].y), d = bf_hi(yw[q][j].y); sy += (a * a + b * b) + (c2 * c2 + d * d); }
                const float rsy = __builtin_amdgcn_rsqf(wave_sum(sy) * (1.f / DM) + EPS);
                const float* m0 = mod + (size_t)r * 6144;
#pragma unroll
                for (int j = 0; j < 8; ++j) { const int col = 4 * F.lane + 256 * j; const f32x4 gt = *(const f32x4*)(m0 + 2 * DM + col), pn = *(const f32x4*)(post_norm + col);
                    const f32x4 y4 = (f32x4){bf_lo(yw[q][j].x), bf_hi(yw[q][j].x), bf_lo(yw[q][j].y), bf_hi(yw[q][j].y)};
                    v[q][j] = v[q][j] + gt * (y4 * rsy * pn);
                    if (lat) *(f32x4*)(args.out + (size_t)row * DM + col) = v[q][j]; }
                const float rstd = __builtin_amdgcn_rsqf(sumsq8(v[q]) * (1.f / DM) + EPS);
                modulate_store(v[q], rstd, pre_norm + DM, mod + (size_t)(9 + r) * 6144, H + (size_t)row * DM, F.lane); }
        }
    }
    SEAM(6);
    if (IN(7)) {
        pg8::Gemm g{H, WMLA, MT, NMLA, DM, DM, DM, 0}; pg8::StaticOrder S; S.init(MT, NMLA, F.G, (int)blockIdx.x);
        pg8::EpiMlaIn E{CQ, CKV, KR, SG, ssq, tab};
        pg8::gemm_phase<pg8::EpiMlaIn>(F.lds, g, S, E);
    }
    SEAM(7);
    if (IN(8)) {
        { pg8::Gemm g{CQ, WUQ, ML, 3072, 512, 512, 512, 0}; pg8::StaticOrder S; S.init(ML, 3072, F.G, (int)blockIdx.x);
          pg8::EpiQ E{Q, ssq, tab};
          pg8::gemm_phase<pg8::EpiQ>(F.lds, g, S, E); }
        { pg8::Gemm g{CKV, WUKV, MT, 4096, 512, 512, 512, 0}; pg8::StaticOrder S; S.init(MT, 4096, F.G, (int)blockIdx.x);
          pg8::EpiKV E{KN, V, ssq + MT};
          pg8::gemm_phase<pg8::EpiKV>(F.lds, g, S, E); }
    }
    SEAM(8);
    if (IN(9)) {
        const int bx = blockIdx.x, vcu = (F.G % 8 == 0) ? (bx % 8) * (F.G / 8) + bx / 8 : bx;
        att::attn_phase(Q, KN, KR, V, SG, Z, vcu, F.G, (char*)lds, F.lds);
    }
    SEAM(9);
    if (IN(10)) {
        pg8::Gemm g{Z, WMO, ML, DM, DM, DM, DM, 0}; pg8::StaticOrder S; S.init(ML, DM, F.G, (int)blockIdx.x);
        pg8::EpiPlain E{Y, DM};
        pg8::gemm_phase<pg8::EpiPlain>(F.lds, g, S, E);
    }
    SEAM(10);
    if (IN(11)) { FRESH();
        for (int row0 = F.gw * 2; row0 < ML; row0 += F.NGW * 2) {
            f32x4 v[2][8]; u32x2 yw[2][8];
#pragma unroll
            for (int q = 0; q < 2; ++q) { const int row = row0 + q; load_row_f32(args.out + (size_t)row * DM, F.lane, v[q]);
                const bf16_t* yr = Y + (size_t)row * DM;
#pragma unroll
                for (int j = 0; j < 8; ++j) yw[q][j] = *(const u32x2*)(yr + 4 * F.lane + 256 * j); }
#pragma unroll
            for (int q = 0; q < 2; ++q) { const int row = row0 + q; const int r = row / SEQ;
                float sy = 0.f;
#pragma unroll
                for (int j = 0; j < 8; ++j) { const float a = bf_lo(yw[q][j].x), b = bf_hi(yw[q][j].x), c2 = bf_lo(yw[q][j].y), d = bf_hi(yw[q][j].y); sy += (a * a + b * b) + (c2 * c2 + d * d); }
                const float rsy = __builtin_amdgcn_rsqf(wave_sum(sy) * (1.f / DM) + EPS);
                const float* m1 = mod + (size_t)(9 + r) * 6144;
#pragma unroll
                for (int j = 0; j < 8; ++j) { const int col = 4 * F.lane + 256 * j; const f32x4 gt = *(const f32x4*)(m1 + 2 * DM + col), pn = *(const f32x4*)(post_norm + DM + col);
                    const f32x4 y4 = (f32x4){bf_lo(yw[q][j].x), bf_hi(yw[q][j].x), bf_lo(yw[q][j].y), bf_hi(yw[q][j].y)};
                    *(f32x4*)(args.out + (size_t)row * DM + col) = v[q][j] + gt * (y4 * rsy * pn); }
            }
        }
    }
#undef IN
#undef SEAM
}

extern "C" void kernel_launch(void* const* d_in, const int* in_sizes, int n_in, void* d_out, int out_size, void* d_ws, size_t ws_size, hipStream_t stream) {
    static int grid = 0;
    if (grid == 0) {
        if (n_in != 19 || out_size != ML * DM || ws_size < WS_END) { fprintf(stderr, "kernel_launch: unexpected shapes (n_in %d out %d ws %zu)\n", n_in, out_size, ws_size); grid = -1; return; }
        int dev = 0, cus = 0, per_cu = 0;
        hipGetDevice(&dev); hipDeviceGetAttribute(&cus, hipDeviceAttributeMultiprocessorCount, dev);
        if (hipFuncSetAttribute((const void*)mk_fwd, hipFuncAttributeMaxDynamicSharedMemorySize, LDS_BYTES) != hipSuccess) { fprintf(stderr, "kernel_launch: hipFuncSetAttribute failed\n"); grid = -1; return; }
        hipOccupancyMaxActiveBlocksPerMultiprocessor(&per_cu, (const void*)mk_fwd, NWAVES * 64, LDS_BYTES);
        (void)hipGetLastError();
        if (per_cu < 1) per_cu = 1;
        grid = cus * 1;
        (void)per_cu;
    }
    if (grid < 0) return;
    hipMemsetAsync((char*)d_ws, 0, CTL_ZERO_BYTES, stream);
    Args a{};
    for (int i = 0; i < 19; ++i) a.in[i] = (const float*)d_in[i];
    a.out = (float*)d_out; a.ws = (unsigned char*)d_ws;
#if MK_N_LAUNCHES == 1
    a.ph_lo = 0; a.ph_hi = N_PHASES;
    void* kargs[] = {&a};
    hipError_t e = hipLaunchCooperativeKernel((const void*)mk_fwd, dim3(grid), dim3(NWAVES * 64), kargs, LDS_BYTES, stream);
    if (e != hipSuccess) fprintf(stderr, "cooperative launch failed: %s (grid %d)\n", hipGetErrorString(e), grid);
#else
    for (int p = 0; p < N_PHASES; ++p) for (int rep = 0; rep < (((DBL_MASK >> p) & 1) ? 2 : 1); ++rep) { a.ph_lo = p; a.ph_hi = p + 1; hipLaunchKernelGGL(mk_fwd, dim3(grid), dim3(NWAVES * 64), LDS_BYTES, stream, a); }
#endif
}
```

```cpp
#include <hip/hip_runtime.h>
#include <hip/hip_cooperative_groups.h>
#include <hip/hip_bf16.h>
#include <cstdio>
#include <cstdint>
namespace cg = cooperative_groups;

#ifndef MK_N_LAUNCHES
#define MK_N_LAUNCHES 1
#endif

#define LAS __attribute__((address_space(3)))
typedef unsigned short bf16_t;
typedef short bf16x8 __attribute__((ext_vector_type(8)));
typedef short s16x4 __attribute__((ext_vector_type(4)));
typedef float f32x4 __attribute__((ext_vector_type(4)));
typedef float f32x2 __attribute__((ext_vector_type(2)));
typedef float f32x16 __attribute__((ext_vector_type(16)));
typedef unsigned u32x4 __attribute__((ext_vector_type(4)));
typedef unsigned u32x2 __attribute__((ext_vector_type(2)));

constexpr int DM = 2048, NB = 8, SEQ = 2048, CTXL = 256;
constexpr int ML = NB * SEQ, MC = NB * CTXL, MT = ML + MC;
constexpr int NMLA = 3328;
constexpr float EPS = 1e-6f;
constexpr float QSCALE = 0.07216878364870322f * 1.4426950408889634f;

constexpr size_t MiB = 1u << 20;
constexpr size_t WS_MOD = 0;
constexpr size_t WS_SSQ = 512 * 1024;
constexpr size_t WS_BAR = 768 * 1024;
constexpr size_t CTL_ZERO_BYTES = 1 * MiB;
constexpr size_t WS_TAB = 1 * MiB;
constexpr size_t WS_WIN = 2 * MiB, WS_WG = 18 * MiB, WS_WOUT = 20 * MiB, WS_WMLA = 28 * MiB, WS_WUQ = 41 * MiB, WS_WUKV = 44 * MiB, WS_WMO = 48 * MiB;
constexpr size_t WS_H = 64 * MiB, WS_SG = 136 * MiB, WS_Z = 208 * MiB, WS_Y = 280 * MiB, WS_U = 352 * MiB, WS_P = 424 * MiB;
constexpr size_t WS_Q = 352 * MiB, WS_CQ = 448 * MiB, WS_CKV = 466 * MiB, WS_KR = 484 * MiB, WS_KN = WS_H, WS_V = WS_Y;
constexpr size_t WS_END = 496 * MiB;

__device__ __forceinline__ unsigned cvt_pk_bf16(float lo, float hi) { unsigned r; asm volatile("v_cvt_pk_bf16_f32 %0, %1, %2" : "=v"(r) : "v"(lo), "v"(hi)); return r; }
__device__ __forceinline__ float bf_lo(unsigned w) { return __uint_as_float(w << 16); }
__device__ __forceinline__ float bf_hi(unsigned w) { return __uint_as_float(w & 0xffff0000u); }
__device__ __forceinline__ float silu_f(float v) { return v * __builtin_amdgcn_rcpf(1.f + __builtin_amdgcn_exp2f(-1.4426950408889634f * v)); }
__device__ __forceinline__ float wave_sum(float v) {
#pragma unroll
    for (int o = 1; o < 64; o <<= 1) v += __shfl_xor(v, o);
    return v;
}

namespace pg8 {
constexpr int BM = 256, BK = 64, HALF = 128, HTB = HALF * BK * 2, STAGE_BYTES = 8 * HTB, NXCD = 8, WGM = 8;
__host__ __device__ __forceinline__ int lds_byte(int r, int c) { const int st = (r >> 4) * 2 + (c >> 5), rr = r & 15, cc = c & 31, ob = rr * 64 + cc * 2; return st * 1024 + (ob ^ (((ob >> 9) & 1) << 5)); }
__host__ __device__ __forceinline__ void stage_rc(int b, int& R, int& C) { const int st = b / 1024, sb = b % 1024, swz = sb ^ (((sb >> 9) & 1) << 5); R = (st >> 1) * 16 + swz / 64; C = (st & 1) * 32 + (swz % 64) / 2; }
__host__ __device__ __forceinline__ int perm32(int rho) { const int n = rho >> 4, i = rho & 15; return 8 * (i >> 2) + 4 * n + (i & 3); }

struct Unit { int pm, pn; };
struct Gemm { const bf16_t* A; const bf16_t* Bt; int M, N, K, lda, ldb, agrp; };

struct StaticOrder {
    int nM, nN, nwg, G, c;
    __host__ __device__ void init(int M, int N, int G_, int c_) { nM = M / BM; nN = N / BM; nwg = nM * nN; G = G_; c = c_; }
    __host__ __device__ bool next(int i, Unit& u) const {
        const long L = (long)i * G + c; if (L >= nwg) return false;
        int wgid = (int)L; { const int q = nwg / NXCD, r = nwg % NXCD, xcd = wgid % NXCD, off = wgid / NXCD; wgid = (xcd < r ? xcd * (q + 1) : r * (q + 1) + (xcd - r) * q) + off; }
        const int nig = WGM * nN, gid = wgid / nig, fm = gid * WGM, gsz = (nM - fm) < WGM ? (nM - fm) : WGM;
        u.pm = fm + ((wgid % nig) % gsz); u.pn = (wgid % nig) / gsz; return true;
    }
};

template <class Epi>
__device__ __forceinline__ void gemm_phase(LAS unsigned char* lds, const Gemm g, const StaticOrder& S, const Epi& E) {
    const int tid = threadIdx.x, wid = __builtin_amdgcn_readfirstlane(tid >> 6), lane = tid & 63, wr = wid >> 2, wc = wid & 3, fr = lane & 15, fq = lane >> 4;
    const int K = g.K, nt = K / BK;
    unsigned voffA[2], voffB[2];
#pragma unroll
    for (int i = 0; i < 2; ++i) { int R, C; stage_rc(tid * 16 + i * 8192, R, C); const int Rb = Epi::PERM ? ((R & ~31) + perm32(R & 31)) : R;
        voffA[i] = (unsigned)(R * g.lda + C) * 2u; voffB[i] = (unsigned)(Rb * g.ldb + C) * 2u; }
    const size_t kstep = (size_t)(BK * 2);
    const size_t hsA = (size_t)HALF * g.lda * 2, hsB = (size_t)HALF * g.ldb * 2;
    const size_t tsA = 2 * hsA, tsB = 2 * hsB;
    const unsigned ldsw = (unsigned)wid * 1024u;
    const int aoff = lds_byte(wr * 64 + fr, fq * 8), boff = lds_byte(wc * 32 + fr, fq * 8);
#define PG8_SA(b, h) (((b) * 2 + (h)) * HTB)
#define PG8_SB(b, h) ((4 + (b) * 2 + (h)) * HTB)
#define PG8_STAGE(bufoff, gbase, voff) do { _Pragma("unroll") for (int _i = 0; _i < 2; ++_i) \
        __builtin_amdgcn_global_load_lds((const unsigned*)((const char*)(gbase) + (voff)[_i]), (LAS unsigned*)(lds + (bufoff) + ldsw + _i * 8192), 16, 0, 0); } while (0)
#define PG8_LDA(dst, b, h) do { _Pragma("unroll") for (int m = 0; m < 4; ++m) _Pragma("unroll") for (int k = 0; k < 2; ++k) dst[m][k] = *(const LAS bf16x8*)(lds + PG8_SA(b, h) + aoff + m * 2048 + k * 1024); } while (0)
#define PG8_LDB(dst, b, h) do { _Pragma("unroll") for (int n = 0; n < 2; ++n) _Pragma("unroll") for (int k = 0; k < 2; ++k) dst[n][k] = *(const LAS bf16x8*)(lds + PG8_SB(b, h) + boff + n * 2048 + k * 1024); } while (0)
#define PG8_MMA(ai, bj, At, Bt) do { __builtin_amdgcn_s_setprio(1); _Pragma("unroll") for (int m = 0; m < 4; ++m) _Pragma("unroll") for (int n = 0; n < 2; ++n) _Pragma("unroll") for (int k = 0; k < 2; ++k) \
        acc[ai][bj][m][n] = __builtin_amdgcn_mfma_f32_16x16x32_bf16(Bt[n][k], At[m][k], acc[ai][bj][m][n], 0, 0, 0); __builtin_amdgcn_s_setprio(0); } while (0)
#define PG8_WAIT_V(n) asm volatile("s_waitcnt vmcnt(" #n ")" ::: "memory")
#define PG8_WAIT_L(n) asm volatile("s_waitcnt lgkmcnt(" #n ")" ::: "memory")
#define PG8_BAR __builtin_amdgcn_s_barrier()
#define PG8_SCHED __builtin_amdgcn_sched_barrier(0)
#define PG8_AOFF(u) ((g.agrp > 0) ? (size_t)((u).pn / g.agrp) * (size_t)K * 2 : (size_t)0)
    Unit cur, nxt; int ui = 0;
    if (!S.next(0, cur)) return;
    f32x4 acc[2][2][4][2];
#pragma unroll
    for (int a = 0; a < 2; ++a)
#pragma unroll
        for (int b = 0; b < 2; ++b)
#pragma unroll
            for (int m = 0; m < 4; ++m)
#pragma unroll
                for (int n = 0; n < 2; ++n) acc[a][b][m][n] = (f32x4){0.f, 0.f, 0.f, 0.f};
    bf16x8 At[4][2], B0[2][2], B1[2][2];
    const char* cA = (const char*)g.A + (size_t)cur.pm * tsA + PG8_AOFF(cur); const char* cB = (const char*)g.Bt + (size_t)cur.pn * tsB;
    PG8_STAGE(PG8_SB(0, 0), cB, voffB); PG8_STAGE(PG8_SB(0, 1), cB + hsB, voffB); PG8_STAGE(PG8_SA(0, 0), cA, voffA); PG8_STAGE(PG8_SA(0, 1), cA + hsA, voffA);
    if (wr == 1) PG8_BAR;
    PG8_WAIT_V(2); PG8_BAR;
    PG8_STAGE(PG8_SB(1, 0), cB + kstep, voffB); PG8_STAGE(PG8_SA(1, 0), cA + kstep, voffA); PG8_STAGE(PG8_SB(1, 1), cB + hsB + kstep, voffB);
    PG8_WAIT_V(6); PG8_BAR;
    for (;;) {
        const bool has_next = S.next(ui + 1, nxt);
        const char* nA = has_next ? (const char*)g.A + (size_t)nxt.pm * tsA + PG8_AOFF(nxt) : cA; const char* nB = has_next ? (const char*)g.Bt + (size_t)nxt.pn * tsB : cB;
        for (int t = 0; t < nt; t += 2) {
            const bool last = (t == nt - 2);
            const char* a1 = cA + (size_t)(t + 1) * kstep;
            const char* a2 = last ? nA : cA + (size_t)(t + 2) * kstep; const char* b2 = last ? nB : cB + (size_t)(t + 2) * kstep;
            const char* a3 = a2 + kstep; const char* b3 = b2 + kstep;
            PG8_LDB(B0, 0, 0); PG8_LDB(B1, 0, 1); PG8_SCHED; PG8_LDA(At, 0, 0); PG8_STAGE(PG8_SA(1, 1), a1 + hsA, voffA);
            PG8_WAIT_V(8); PG8_WAIT_L(0); PG8_BAR; PG8_MMA(0, 0, At, B0); PG8_MMA(0, 1, At, B1); PG8_BAR; PG8_SCHED;
            PG8_LDA(At, 0, 1); PG8_STAGE(PG8_SB(0, 0), b2, voffB); PG8_STAGE(PG8_SB(0, 1), b2 + hsB, voffB); PG8_STAGE(PG8_SA(0, 0), a2, voffA);
            PG8_WAIT_V(8); PG8_WAIT_L(0); PG8_BAR; PG8_MMA(1, 0, At, B0); PG8_MMA(1, 1, At, B1); PG8_BAR; PG8_SCHED;
            PG8_LDB(B0, 1, 0); PG8_LDB(B1, 1, 1); PG8_SCHED; PG8_LDA(At, 1, 0); PG8_STAGE(PG8_SA(0, 1), a2 + hsA, voffA);
            PG8_WAIT_V(8); PG8_WAIT_L(0); PG8_BAR; PG8_MMA(0, 0, At, B0); PG8_MMA(0, 1, At, B1); PG8_BAR; PG8_SCHED;
            PG8_LDA(At, 1, 1); PG8_STAGE(PG8_SB(1, 0), b3, voffB); PG8_STAGE(PG8_SB(1, 1), b3 + hsB, voffB); PG8_STAGE(PG8_SA(1, 0), a3, voffA);
            PG8_WAIT_V(8); PG8_WAIT_L(0); PG8_BAR; PG8_MMA(1, 0, At, B0); PG8_MMA(1, 1, At, B1); PG8_BAR; PG8_SCHED;
        }
        if (wr == 0) PG8_BAR;
        E(acc, cur, wr, wc, fr, fq);
        if (!has_next) break;
#pragma unroll
        for (int a = 0; a < 2; ++a)
#pragma unroll
            for (int b = 0; b < 2; ++b)
#pragma unroll
                for (int m = 0; m < 4; ++m)
#pragma unroll
                    for (int n = 0; n < 2; ++n) acc[a][b][m][n] = (f32x4){0.f, 0.f, 0.f, 0.f};
        cur = nxt; cA = nA; cB = nB; ++ui;
        if (wr == 1) PG8_BAR;
    }
    PG8_WAIT_V(0);
    PG8_BAR;
#undef PG8_SA
#undef PG8_SB
#undef PG8_STAGE
#undef PG8_LDA
#undef PG8_LDB
#undef PG8_MMA
#undef PG8_WAIT_V
#undef PG8_WAIT_L
#undef PG8_BAR
#undef PG8_SCHED
#undef PG8_AOFF
}

__device__ __forceinline__ u32x4 pack8(f32x4 v0, f32x4 v1) { u32x4 w; w.x = cvt_pk_bf16(v0[0], v0[1]); w.y = cvt_pk_bf16(v0[2], v0[3]); w.z = cvt_pk_bf16(v1[0], v1[1]); w.w = cvt_pk_bf16(v1[2], v1[3]); return w; }
__device__ __forceinline__ f32x4 silu4(f32x4 v) { return (f32x4){silu_f(v[0]), silu_f(v[1]), silu_f(v[2]), silu_f(v[3])}; }

struct EpiPlain {
    static constexpr bool PERM = true;
    bf16_t* O; int ldc;
    __device__ __forceinline__ void operator()(const f32x4 (&acc)[2][2][4][2], const Unit& u, int wr, int wc, int fr, int fq) const {
        const int row0 = u.pm * BM + wr * 64 + fr, col0 = u.pn * BM + wc * 32 + 8 * fq;
#pragma unroll
        for (int ai = 0; ai < 2; ++ai)
#pragma unroll
            for (int m = 0; m < 4; ++m) { bf16_t* rowp = O + (size_t)(row0 + ai * HALF + m * 16) * ldc + col0;
#pragma unroll
                for (int bj = 0; bj < 2; ++bj) *(u32x4*)(rowp + bj * HALF) = pack8(acc[ai][bj][m][0], acc[ai][bj][m][1]); }
    }
};
struct EpiPoolIn {
    static constexpr bool PERM = true;
    bf16_t* U; bf16_t* SG;
    __device__ __forceinline__ void operator()(const f32x4 (&acc)[2][2][4][2], const Unit& u, int wr, int wc, int fr, int fq) const {
        const int t = u.pn >> 3; bf16_t* base = t ? SG : U;
        const int row0 = u.pm * BM + wr * 64 + fr, col0 = (u.pn & 7) * BM + wc * 32 + 8 * fq;
#pragma unroll
        for (int ai = 0; ai < 2; ++ai)
#pragma unroll
            for (int m = 0; m < 4; ++m) { bf16_t* rowp = base + (size_t)(row0 + ai * HALF + m * 16) * DM + col0;
#pragma unroll
                for (int bj = 0; bj < 2; ++bj) { f32x4 v0 = acc[ai][bj][m][0], v1 = acc[ai][bj][m][1];
                    if (t) { v0 = silu4(v0); v1 = silu4(v1); }
                    *(u32x4*)(rowp + bj * HALF) = pack8(v0, v1); } }
    }
};
struct EpiGrp {
    static constexpr bool PERM = true;
    const bf16_t* SG; bf16_t* Z; const float* bias; const float* scale;
    __device__ __forceinline__ void operator()(const f32x4 (&acc)[2][2][4][2], const Unit& u, int wr, int wc, int fr, int fq) const {
        const int row0 = u.pm * BM + wr * 64 + fr, col0 = u.pn * BM + wc * 32 + 8 * fq;
        f32x4 bv[2][2], sv[2][2];
#pragma unroll
        for (int bj = 0; bj < 2; ++bj)
#pragma unroll
            for (int n = 0; n < 2; ++n) { bv[bj][n] = *(const f32x4*)(bias + col0 + bj * HALF + 4 * n); sv[bj][n] = *(const f32x4*)(scale + col0 + bj * HALF + 4 * n); }
#pragma unroll
        for (int ai = 0; ai < 2; ++ai)
#pragma unroll
            for (int m = 0; m < 4; ++m) { const size_t off = (size_t)(row0 + ai * HALF + m * 16) * DM + col0;
#pragma unroll
                for (int bj = 0; bj < 2; ++bj) { const u32x4 gw = *(const u32x4*)(SG + off + bj * HALF);
                    f32x4 v0 = (acc[ai][bj][m][0] + bv[bj][0]) * sv[bj][0], v1 = (acc[ai][bj][m][1] + bv[bj][1]) * sv[bj][1];
                    v0 = v0 * (f32x4){bf_lo(gw.x), bf_hi(gw.x), bf_lo(gw.y), bf_hi(gw.y)}; v1 = v1 * (f32x4){bf_lo(gw.z), bf_hi(gw.z), bf_lo(gw.w), bf_hi(gw.w)};
                    *(u32x4*)(Z + off + bj * HALF) = pack8(v0, v1); } }
    }
};
struct EpiMlaIn {
    static constexpr bool PERM = true;
    bf16_t *CQ, *CKV, *KR, *SG; float* ssq; const f32x2* tab;
    __device__ __forceinline__ void operator()(const f32x4 (&acc)[2][2][4][2], const Unit& u, int wr, int wc, int fr, int fq) const {
        const int pn = u.pn, row0 = u.pm * BM + wr * 64 + fr;
        if (pn < 4) {
            bf16_t* base = pn < 2 ? CQ : CKV; float* ss = ssq + (pn < 2 ? 0 : MT);
            const int col0 = (pn & 1) * BM + wc * 32 + 8 * fq;
#pragma unroll
            for (int ai = 0; ai < 2; ++ai)
#pragma unroll
                for (int m = 0; m < 4; ++m) { const int row = row0 + ai * HALF + m * 16; bf16_t* rowp = base + (size_t)row * 512 + col0; float s = 0.f;
#pragma unroll
                    for (int bj = 0; bj < 2; ++bj) { const f32x4 v0 = acc[ai][bj][m][0], v1 = acc[ai][bj][m][1];
                        s += (v0[0] * v0[0] + v0[1] * v0[1]) + (v0[2] * v0[2] + v0[3] * v0[3]) + (v1[0] * v1[0] + v1[1] * v1[1]) + (v1[2] * v1[2] + v1[3] * v1[3]);
                        *(u32x4*)(rowp + bj * HALF) = pack8(v0, v1); }
                    s += __shfl_xor(s, 16); s += __shfl_xor(s, 32);
                    if (fq == 0) atomicAdd(ss + row, s); }
        } else if (pn < 12) {
            if (u.pm < ML / BM) {
                const int col0 = (pn - 4) * BM + wc * 32 + 8 * fq;
#pragma unroll
                for (int ai = 0; ai < 2; ++ai)
#pragma unroll
                    for (int m = 0; m < 4; ++m) { bf16_t* rowp = SG + (size_t)(row0 + ai * HALF + m * 16) * DM + col0;
#pragma unroll
                        for (int bj = 0; bj < 2; ++bj) *(u32x4*)(rowp + bj * HALF) = pack8(silu4(acc[ai][bj][m][0]), silu4(acc[ai][bj][m][1])); }
            }
        } else {
            if (wc < 2) {
                const bool lat = u.pm < ML / BM;
#pragma unroll
                for (int ai = 0; ai < 2; ++ai)
#pragma unroll
                    for (int m = 0; m < 4; ++m) { const int row = row0 + ai * HALF + m * 16;
                        f32x4 v0 = acc[ai][0][m][0], v1 = acc[ai][0][m][1];
                        if (lat) {
                            const int t = row & (SEQ - 1), pos = wc == 0 ? (t >> 6) : (t & 63);
                            const f32x2* tp = tab + pos * 16 + 8 * (fq & 1);
                            f32x4 p0, p1;
#pragma unroll
                            for (int j = 0; j < 4; ++j) { p0[j] = __shfl_xor(v0[j], 32); p1[j] = __shfl_xor(v1[j], 32); }
                            const bool first = fq < 2;
#pragma unroll
                            for (int j = 0; j < 4; ++j) { const f32x2 c0 = tp[j], c1 = tp[4 + j];
                                v0[j] = first ? (v0[j] * c0.x - p0[j] * c0.y) : (p0[j] * c0.y + v0[j] * c0.x);
                                v1[j] = first ? (v1[j] * c1.x - p1[j] * c1.y) : (p1[j] * c1.y + v1[j] * c1.x); }
                        }
                        *(u32x4*)(KR + (size_t)row * 64 + wc * 32 + 8 * fq) = pack8(v0, v1); }
            }
        }
    }
};
struct EpiQ {
    static constexpr bool PERM = true;
    bf16_t* Q; const float* ssq; const f32x2* tab;
    __device__ __forceinline__ void operator()(const f32x4 (&acc)[2][2][4][2], const Unit& u, int wr, int wc, int fr, int fq) const {
        const int row0 = u.pm * BM + wr * 64 + fr; const bool first = fq < 2;
#pragma unroll
        for (int ai = 0; ai < 2; ++ai)
#pragma unroll
            for (int m = 0; m < 4; ++m) { const int row = row0 + ai * HALF + m * 16; const float rs = __builtin_amdgcn_rsqf(ssq[row] * (1.f / 512.f) + EPS) * QSCALE; const int t = row & (SEQ - 1);
#pragma unroll
                for (int bj = 0; bj < 2; ++bj) { const int gcol = u.pn * 8 + bj * 4 + wc, hg = gcol % 6;
                    f32x4 v0 = acc[ai][bj][m][0] * rs, v1 = acc[ai][bj][m][1] * rs;
                    if (hg >= 4) { const int pos = hg == 4 ? (t >> 6) : (t & 63); const f32x2* tp = tab + pos * 16 + 8 * (fq & 1);
                        f32x4 p0, p1;
#pragma unroll
                        for (int j = 0; j < 4; ++j) { p0[j] = __shfl_xor(v0[j], 32); p1[j] = __shfl_xor(v1[j], 32); }
#pragma unroll
                        for (int j = 0; j < 4; ++j) { const f32x2 c0 = tp[j], c1 = tp[4 + j];
                            v0[j] = first ? (v0[j] * c0.x - p0[j] * c0.y) : (p0[j] * c0.y + v0[j] * c0.x);
                            v1[j] = first ? (v1[j] * c1.x - p1[j] * c1.y) : (p1[j] * c1.y + v1[j] * c1.x); } }
                    *(u32x4*)(Q + (size_t)row * 3072 + gcol * 32 + 8 * fq) = pack8(v0, v1); } }
    }
};
struct EpiKV {
    static constexpr bool PERM = true;
    bf16_t* KN; bf16_t* V; const float* ssq;
    __device__ __forceinline__ void operator()(const f32x4 (&acc)[2][2][4][2], const Unit& u, int wr, int wc, int fr, int fq) const {
        const int row0 = u.pm * BM + wr * 64 + fr, col0 = u.pn * 128 + wc * 32 + 8 * fq;
#pragma unroll
        for (int ai = 0; ai < 2; ++ai)
#pragma unroll
            for (int m = 0; m < 4; ++m) { const int row = row0 + ai * HALF + m * 16; const float rs = __builtin_amdgcn_rsqf(ssq[row] * (1.f / 512.f) + EPS);
                *(u32x4*)(KN + (size_t)row * DM + col0) = pack8(acc[ai][0][m][0] * rs, acc[ai][0][m][1] * rs);
                *(u32x4*)(V + (size_t)row * DM + col0) = pack8(acc[ai][1][m][0] * rs, acc[ai][1][m][1] * rs); }
    }
};
}

namespace att {
constexpr int NW = 8, QBLK = 32, KVBLK = 64, NT = (CTXL + SEQ) / KVBLK;
constexpr int SHM_V = KVBLK * 128 * 2, SHM_K = KVBLK * 192 * 2;
#ifndef ATT_NQREG
#define ATT_NQREG 12
#endif
constexpr int NQREG = ATT_NQREG, SHM_QR = (12 - NQREG) * 8192, SHM_ATTN = 3 * SHM_V + 3 * SHM_K + NW * 64 * 4 + SHM_QR + NW * 4096;
constexpr float THRL = 8.f * 1.4426950408889634f;
#define KSWZ(row, colB) ((row) * 384 + ((colB) ^ (((row) & 7) << 4)))
#define SBAR() __builtin_amdgcn_sched_barrier(0)
__device__ __forceinline__ int crow(int r, int hi) { return (r & 3) + 8 * (r >> 2) + 4 * hi; }
__device__ __forceinline__ void partialSM(f32x16& p0, f32x16& p1, float& m_reg, float& mn, float& alpha) {
  float pmax = p0[0];
#pragma unroll
  for (int r = 1; r < 16; ++r) pmax = fmaxf(pmax, p0[r]);
#pragma unroll
  for (int r = 0; r < 16; ++r) pmax = fmaxf(pmax, p1[r]);
  { auto rr = __builtin_amdgcn_permlane32_swap(__float_as_uint(pmax), __float_as_uint(pmax), false, false);
    pmax = fmaxf(__uint_as_float(rr[0]), __uint_as_float(rr[1])); }
  if (__builtin_expect(__all(pmax - m_reg <= THRL), 1)) { mn = m_reg; alpha = 1.f; }
  else { mn = fmaxf(m_reg, pmax); alpha = __builtin_amdgcn_exp2f(m_reg - mn); m_reg = mn; }
#pragma unroll
  for (int r = 0; r < 16; ++r) p0[r] = p0[r] - mn;
#pragma unroll
  for (int r = 0; r < 16; ++r) p1[r] = p1[r] - mn;
#pragma unroll
  for (int r = 0; r < 16; ++r) p0[r] = __builtin_amdgcn_exp2f(p0[r]);
}
__device__ __forceinline__ void finishSM(f32x16& p0, f32x16& p1, float alpha, float& l_reg, bf16x8& pa0, bf16x8& pa1, bf16x8& pa2, bf16x8& pa3) {
#pragma unroll
  for (int r = 0; r < 16; ++r) p1[r] = __builtin_amdgcn_exp2f(p1[r]);
  float ps = 0;
#pragma unroll
  for (int r = 0; r < 16; ++r) ps += p0[r];
#pragma unroll
  for (int r = 0; r < 16; ++r) ps += p1[r];
  { auto rr = __builtin_amdgcn_permlane32_swap(__float_as_uint(ps), __float_as_uint(ps), false, false);
    ps = __uint_as_float(rr[0]) + __uint_as_float(rr[1]); }
  l_reg = l_reg * alpha + ps;
#define PK4(P, BASE, OUT) do { unsigned a0 = cvt_pk_bf16(P[BASE + 0], P[BASE + 1]), a1 = cvt_pk_bf16(P[BASE + 2], P[BASE + 3]);   \
    unsigned b0 = cvt_pk_bf16(P[BASE + 4], P[BASE + 5]), b1 = cvt_pk_bf16(P[BASE + 6], P[BASE + 7]);                              \
    auto r0 = __builtin_amdgcn_permlane32_swap(a0, b0, false, false); auto r1 = __builtin_amdgcn_permlane32_swap(a1, b1, false, false); \
    u32x4 w = {r0[0], r1[0], r0[1], r1[1]}; OUT = *reinterpret_cast<bf16x8*>(&w); } while (0)
  PK4(p0, 0, pa0); PK4(p0, 8, pa1); PK4(p1, 0, pa2); PK4(p1, 8, pa3);
#undef PK4
}
__device__ __forceinline__ void qkt(f32x16& p0, f32x16& p1, const char* Ks, const bf16x8* qr, const char* Qr, int kbase) {
  p0 = f32x16{}; p1 = f32x16{};
  const char* kb = Ks + kbase;
  bf16x8 k0[4], k1[4];
#define KLD(d) do { k0[(d) % 4] = *reinterpret_cast<const bf16x8*>(kb + (d) * 512); k1[(d) % 4] = *reinterpret_cast<const bf16x8*>(kb + 12288 + (d) * 512); } while (0)
  KLD(0); KLD(1); KLD(2);
  __builtin_amdgcn_s_setprio(1);
#pragma unroll
  for (int d0 = 0; d0 < 12; ++d0) {
    if (d0 + 3 < 12) KLD(d0 + 3);
    const bf16x8 qf = d0 < NQREG ? qr[d0 < NQREG ? d0 : 0] : *reinterpret_cast<const bf16x8*>(Qr + (d0 - NQREG) * 8192);
    p0 = __builtin_amdgcn_mfma_f32_32x32x16_bf16(k0[d0 % 4], qf, p0, 0, 0, 0);
    p1 = __builtin_amdgcn_mfma_f32_32x32x16_bf16(k1[d0 % 4], qf, p1, 0, 0, 0);
    SBAR(); }
  __builtin_amdgcn_s_setprio(0);
#undef KLD
}
__device__ __forceinline__ int v_st(int k, int c) { const int kk = (k & ~0xC) | ((k & 4) << 1) | ((k & 8) >> 1); return ((kk >> 3) * 4 + (c >> 5)) * 512 + ((kk & 7) * 32 + (c & 31)) * 2; }
__device__ __forceinline__ int v_rd_base(int lane) { return ((lane & 3) << 3) | (((lane >> 2) & 3) << 6) | (((lane >> 4) & 1) << 5) | (((lane >> 5) & 1) << 8); }
constexpr int v_rd_off(int d0, int ks, int half) { return d0 * 512 + ks * 4096 + half * 2048; }
template <int OFF> __device__ __forceinline__ s16x4 tr_read(int vb) {
  s16x4 r; asm volatile("ds_read_b64_tr_b16 %0, %1 offset:%2" : "=&v"(r) : "v"(vb), "i"(OFF) : "memory"); return r;
}
struct VFrag { s16x4 l0, h0, l1, h1, l2, h2, l3, h3; };
template <int D0> __device__ __forceinline__ void v_read8(VFrag& f, int vb) {
  f.l0 = tr_read<v_rd_off(D0, 0, 0)>(vb); f.h0 = tr_read<v_rd_off(D0, 0, 1)>(vb); f.l1 = tr_read<v_rd_off(D0, 1, 0)>(vb); f.h1 = tr_read<v_rd_off(D0, 1, 1)>(vb);
  f.l2 = tr_read<v_rd_off(D0, 2, 0)>(vb); f.h2 = tr_read<v_rd_off(D0, 2, 1)>(vb); f.l3 = tr_read<v_rd_off(D0, 3, 0)>(vb); f.h3 = tr_read<v_rd_off(D0, 3, 1)>(vb);
}
__device__ __forceinline__ void pv_mma(f32x16& od, const VFrag& f, bf16x8 pa0, bf16x8 pa1, bf16x8 pa2, bf16x8 pa3) {
#define PK(L, H) (bf16x8){L[0], L[1], L[2], L[3], H[0], H[1], H[2], H[3]}
  od = __builtin_amdgcn_mfma_f32_32x32x16_bf16(pa0, PK(f.l0, f.h0), od, 0, 0, 0);
  od = __builtin_amdgcn_mfma_f32_32x32x16_bf16(pa1, PK(f.l1, f.h1), od, 0, 0, 0);
  od = __builtin_amdgcn_mfma_f32_32x32x16_bf16(pa2, PK(f.l2, f.h2), od, 0, 0, 0);
  od = __builtin_amdgcn_mfma_f32_32x32x16_bf16(pa3, PK(f.l3, f.h3), od, 0, 0, 0);
#undef PK
}
__device__ __forceinline__ void pv_d0(f32x16* o, int vb, bf16x8 pa0, bf16x8 pa1, bf16x8 pa2, bf16x8 pa3) {
  VFrag fa, fb;
  v_read8<0>(fa, vb); v_read8<1>(fb, vb);
  asm volatile("s_waitcnt lgkmcnt(8)" ::: "memory"); SBAR(); pv_mma(o[0], fa, pa0, pa1, pa2, pa3); SBAR();
  v_read8<2>(fa, vb);
  asm volatile("s_waitcnt lgkmcnt(8)" ::: "memory"); SBAR(); pv_mma(o[1], fb, pa0, pa1, pa2, pa3); SBAR();
  v_read8<3>(fb, vb);
  asm volatile("s_waitcnt lgkmcnt(8)" ::: "memory"); SBAR(); pv_mma(o[2], fa, pa0, pa1, pa2, pa3); SBAR();
  asm volatile("s_waitcnt lgkmcnt(0)" ::: "memory"); SBAR(); pv_mma(o[3], fb, pa0, pa1, pa2, pa3); SBAR();
}
constexpr int SLOT_K = SHM_K, SLOT_V = SHM_V, RING_BYTES = 3 * (SLOT_K + SLOT_V);
constexpr int NUNITS = NB * 16 * (SEQ / 256);
__device__ __forceinline__ void attn_phase(const bf16_t* __restrict__ Q, const bf16_t* __restrict__ KN, const bf16_t* __restrict__ KR, const bf16_t* __restrict__ V,
                                           const bf16_t* __restrict__ SG, bf16_t* __restrict__ Z, int vcu, int G, char* lds, LAS unsigned char* ldsl) {
  const int tid = threadIdx.x, wid = __builtin_amdgcn_readfirstlane(tid >> 6), lane = tid & 63, r32 = lane & 31, hi = lane >> 5;
  char* K_lds = lds; char* V_lds = lds + 3 * SLOT_K;
  float* wsf = (float*)(lds + RING_BYTES) + wid * 64; float* li_l = wsf; float* al_l = wsf + 32;
  char* Qr = lds + RING_BYTES + NW * 64 * 4 + tid * 16;
  const int vb0 = (int)(uintptr_t)V_lds + v_rd_base(lane);
  const int kbase = ((r32 >> 4) * 384 + (r32 & 15)) * 16 + hi * 256;
  int kofs[6], vofs[4]; bool krope[6];
  const int wq = wid & 3;
#pragma unroll
  for (int i = 0; i < 6; ++i) { const int p = 6 * wq + i, row = (p / 6) * 16 + (lane & 15), chunk = 4 * (p % 6) + (lane >> 4);
    krope[i] = chunk >= 16; kofs[i] = krope[i] ? row * 128 + (chunk - 16) * 16 : row * 4096 + chunk * 16; }
#pragma unroll
  for (int i = 0; i < 4; ++i) { const int B = (4 * wq + i) * 1024 + lane * 16, sub = B >> 9, within = (B & 511) >> 1, kk = (sub >> 2) * 8 + (within >> 5);
    const int k = (kk & ~0xC) | ((kk & 4) << 1) | ((kk & 8) >> 1), c = (sub & 3) * 32 + (within & 31); vofs[i] = k * 4096 + c * 2; }
#define KROW(j, b_) ((j) < 4 ? ML + (b_) * CTXL + (j) * KVBLK : (b_) * SEQ + ((j) - 4) * KVBLK)
#define DMA_K(j, b_, h_, slot) do { const int rb_ = KROW(j, b_); \
    const char* kn_ = (const char*)KN + (size_t)rb_ * 4096 + (h_) * 256; const char* kr_ = (const char*)KR + (size_t)rb_ * 128; \
    _Pragma("unroll") for (int i_ = 0; i_ < 6; ++i_) __builtin_amdgcn_global_load_lds((const unsigned*)((krope[i_] ? kr_ : kn_) + kofs[i_]), (LAS unsigned*)(ldsl + (slot) * SLOT_K + (6 * wq + i_) * 1024), 16, 0, 0); } while (0)
#define DMA_V(j, b_, h_, slot) do { const int rb_ = KROW(j, b_); const char* v_ = (const char*)V + (size_t)rb_ * 4096 + (h_) * 256; \
    _Pragma("unroll") for (int i_ = 0; i_ < 4; ++i_) __builtin_amdgcn_global_load_lds((const unsigned*)(v_ + vofs[i_]), (LAS unsigned*)(ldsl + 3 * SLOT_K + (slot) * SLOT_V + (4 * wq + i_) * 1024), 16, 0, 0); } while (0)
#define TILE_SYNC() do { asm volatile("s_waitcnt vmcnt(0)" ::: "memory"); __syncthreads(); } while (0)
#define RESC(a) do { if (__any((a) < 1.f)) { if (hi == 0) al_l[r32] = (a); asm volatile("s_waitcnt lgkmcnt(0)" ::: "memory"); \
    _Pragma("unroll") for (int d = 0; d < 4; ++d) _Pragma("unroll") for (int r = 0; r < 16; ++r) o[d][r] *= al_l[crow(r, hi)]; } } while (0)
  const int half = wid >> 2;
  const int nun_wg = vcu < NUNITS ? (NUNITS - 1 - vcu) / G + 1 : 0, T = nun_wg * NT;
#define ABAR() do { asm volatile("s_waitcnt lgkmcnt(0)" ::: "memory"); __builtin_amdgcn_s_barrier(); asm volatile("" ::: "memory"); } while (0)
#define VWAIT() asm volatile("s_waitcnt vmcnt(0)" ::: "memory")
#define DMA_TK(t_) do { const int ui_ = (t_) / NT, j_ = (t_) - ui_ * NT, un_ = vcu + ui_ * G; DMA_K(j_, (un_ >> 7), ((un_ >> 3) & 15), ((t_) % 3)); } while (0)
#define DMA_TV(t_) do { const int ui_ = (t_) / NT, j_ = (t_) - ui_ * NT, un_ = vcu + ui_ * G; DMA_V(j_, (un_ >> 7), ((un_ >> 3) & 15), ((t_) % 3)); } while (0)
#define LOADQ(un_) do { const int qb_ = (un_) & 7, h_ = ((un_) >> 3) & 15, b_ = (un_) >> 7; const bf16_t* Qw = Q + (size_t)(b_ * SEQ + qb_ * 256 + wid * QBLK + r32) * 3072 + h_ * 192 + hi * 8; \
    _Pragma("unroll") for (int d0 = 0; d0 < NQREG; ++d0) qr[d0] = *reinterpret_cast<const bf16x8*>(Qw + d0 * 16); \
    _Pragma("unroll") for (int d0 = NQREG; d0 < 12; ++d0) *reinterpret_cast<bf16x8*>(Qr + (d0 - NQREG) * 8192) = *reinterpret_cast<const bf16x8*>(Qw + d0 * 16); } while (0)
#define EPI_PREFETCH(un_) do { const int qb_ = (un_) & 7, h_ = ((un_) >> 3) & 15, b_ = (un_) >> 7; \
    const size_t ob = (size_t)(b_ * SEQ + qb_ * 256 + wid * QBLK + (lane >> 3)) * DM + h_ * 128 + (lane & 7) * 8; \
    _Pragma("unroll") for (int hf = 0; hf < 2; ++hf) _Pragma("unroll") for (int i4 = 0; i4 < 4; ++i4) gv[hf][i4] = *(const u32x4*)(SG + ob + (size_t)(i4 * 8) * DM + hf * 64); } while (0)
#define EPILOGUE(un_) do { const int qb_ = (un_) & 7, h_ = ((un_) >> 3) & 15, b_ = (un_) >> 7; \
    if (hi == 0) li_l[r32] = l_reg; asm volatile("s_waitcnt lgkmcnt(0)" ::: "memory"); \
    const size_t ob = (size_t)(b_ * SEQ + qb_ * 256 + wid * QBLK + (lane >> 3)) * DM + h_ * 128 + (lane & 7) * 8; \
    _Pragma("unroll") for (int hf = 0; hf < 2; ++hf) { \
      _Pragma("unroll") for (int r = 0; r < 16; ++r) { const float rl = __builtin_amdgcn_rcpf(li_l[crow(r, hi)]); \
        _Pragma("unroll") for (int dd = 0; dd < 2; ++dd) epi[crow(r, hi) * 64 + dd * 32 + r32] = (bf16_t)(cvt_pk_bf16(o[hf * 2 + dd][r] * rl, 0.f) & 0xffffu); } \
      asm volatile("s_waitcnt lgkmcnt(0)" ::: "memory"); \
      _Pragma("unroll") for (int i4 = 0; i4 < 4; ++i4) { const u32x4 ov = *(const u32x4*)(epi + (i4 * 8 + (lane >> 3)) * 64 + (lane & 7) * 8); \
        const size_t gi = ob + (size_t)(i4 * 8) * DM + hf * 64; const u32x4 gvv = gv[hf][i4]; u32x4 zv; \
        zv.x = cvt_pk_bf16(bf_lo(ov.x) * bf_lo(gvv.x), bf_hi(ov.x) * bf_hi(gvv.x)); zv.y = cvt_pk_bf16(bf_lo(ov.y) * bf_lo(gvv.y), bf_hi(ov.y) * bf_hi(gvv.y)); \
        zv.z = cvt_pk_bf16(bf_lo(ov.z) * bf_lo(gvv.z), bf_hi(ov.z) * bf_hi(gvv.z)); zv.w = cvt_pk_bf16(bf_lo(ov.w) * bf_lo(gvv.w), bf_hi(ov.w) * bf_hi(gvv.w)); \
        *(u32x4*)(Z + gi) = zv; } \
      asm volatile("s_waitcnt lgkmcnt(0)" ::: "memory"); } } while (0)
  bf16_t* epi = (bf16_t*)(lds + RING_BYTES + NW * 64 * 4 + SHM_QR + wid * 4096);
  if (T > 0) {
    float m_reg = -1e30f, l_reg = 0, mn, al; f32x16 o[4] = {}; bf16x8 qr[NQREG]; f32x16 p0, p1; bf16x8 pa0, pa1, pa2, pa3; u32x4 gv[2][4];
    if (half == 1) { DMA_TK(0); DMA_TK(1); } else { DMA_TV(0); DMA_TV(1); }
    LOADQ(vcu);
    VWAIT(); __syncthreads();
    if (half == 1) ABAR();
    int slot = 0, pslot = 2, t = 0;
#define SEG_S() do { const bool vis_ = (half == 0) && t >= 1 && t + 1 < T; \
      if (half == 1) { if (t + 2 < T) DMA_TK(t + 2); } else if (vis_) DMA_TV(t + 1); \
      partialSM(p0, p1, m_reg, mn, al); RESC(al); finishSM(p0, p1, al, l_reg, pa0, pa1, pa2, pa3); \
      if (half == 0) { if (vis_) asm volatile("s_waitcnt vmcnt(4)" ::: "memory"); else VWAIT(); } \
      SBAR(); ABAR(); pslot = slot; slot = slot == 2 ? 0 : slot + 1; ++t; } while (0)
    for (int ui = 0; ui < nun_wg; ++ui) {
      SBAR();
      if (ui > 0) {
        EPI_PREFETCH(vcu + (ui - 1) * G);
        pv_d0(o, vb0 + pslot * SLOT_V, pa0, pa1, pa2, pa3);
        EPILOGUE(vcu + (ui - 1) * G);
        m_reg = -1e30f; l_reg = 0;
#pragma unroll
        for (int d = 0; d < 4; ++d) o[d] = f32x16{};
      }
      qkt(p0, p1, K_lds + slot * SLOT_K, qr, Qr, kbase);
      if (half == 1) VWAIT();
      SBAR(); ABAR();
      SEG_S();
      for (int j = 1; j < NT; ++j) {
        SBAR();
        qkt(p0, p1, K_lds + slot * SLOT_K, qr, Qr, kbase); SBAR();
        if (j == NT - 1 && ui + 1 < nun_wg) LOADQ(vcu + (ui + 1) * G);
        pv_d0(o, vb0 + pslot * SLOT_V, pa0, pa1, pa2, pa3);
        if (half == 1) VWAIT();
        SBAR(); ABAR();
        SEG_S();
      }
    }
#undef SEG_S
    EPI_PREFETCH(vcu + (nun_wg - 1) * G);
    pv_d0(o, vb0 + pslot * SLOT_V, pa0, pa1, pa2, pa3);
    EPILOGUE(vcu + (nun_wg - 1) * G);
    if (half == 0) ABAR();
  }
  asm volatile("s_waitcnt vmcnt(0)" ::: "memory"); __syncthreads();
#undef ABAR
#undef VWAIT
#undef DMA_TK
#undef DMA_TV
#undef LOADQ
#undef EPILOGUE
#undef EPI_PREFETCH
#undef KROW
#undef DMA_K
#undef DMA_V
#undef TILE_SYNC
#undef RESC
}
}


#define XB_TMO      128
#define XB_XCNT(j)  (256  + 64 * (j))
#define XB_XSUB(j)  (1280 + 64 * (j))
#define XB_XGEN(j)  (2304 + 64 * (j))
#define XB_TOP      3328
#define XB_TOPGEN   3392
#define XCD_BAR_WORDS 3456
#define XB_SPIN_CAP (1u << 22)
__device__ __forceinline__ unsigned xb_ld(unsigned* p)              { return __hip_atomic_load(p, __ATOMIC_RELAXED, __HIP_MEMORY_SCOPE_AGENT); }
__device__ __forceinline__ unsigned xb_add(unsigned* p, unsigned v) { return __hip_atomic_fetch_add(p, v, __ATOMIC_RELAXED, __HIP_MEMORY_SCOPE_AGENT); }
__device__ __forceinline__ unsigned xb_xcc_id() { return (unsigned)__builtin_amdgcn_s_getreg((3 << 11) | 20) & 0xFu; }
#define XB_SPIN(cond, bar) do { unsigned _sp = 0; while (cond) { __builtin_amdgcn_s_sleep(1); \
    if ((++_sp & 255u) == 0u) { if (xb_ld(&(bar)[XB_TMO])) break; if (_sp > XB_SPIN_CAP) { atomicAdd(&(bar)[XB_TMO], 1u); break; } } } } while (0)
struct XcdBarrier { unsigned* bar; unsigned x; volatile LAS unsigned* st; };
__device__ __forceinline__ XcdBarrier xcd_barrier_post(unsigned* bar, volatile LAS unsigned* st) {
    XcdBarrier b; b.bar = bar; b.x = xb_xcc_id(); b.st = st;
    if (threadIdx.x == 0) (void)xb_add(&bar[XB_XCNT(b.x)], 1u);
    return b;
}
__device__ __forceinline__ void xcd_barrier_complete(unsigned* bar, unsigned x, unsigned& nloc, unsigned& nx) {
    const unsigned G = gridDim.x;
    unsigned sum, cnt, mine, sp = 0u;
    for (;;) {
        sum = 0u; cnt = 0u; mine = 0u;
#pragma unroll
        for (unsigned j = 0; j < 16; ++j) { const unsigned c = xb_ld(&bar[XB_XCNT(j)]); sum += c; cnt += (c > 0u) ? 1u : 0u; mine = (j == x) ? c : mine; }
        if (sum == G) break;
        __builtin_amdgcn_s_sleep(1);
        if ((++sp & 255u) == 0u) { if (xb_ld(&bar[XB_TMO])) break; if (sp > XB_SPIN_CAP) { atomicAdd(&bar[XB_TMO], 1u); break; } }
    }
    nloc = mine > 0u ? mine : 1u; nx = cnt > 0u ? cnt : 1u;
}
__device__ __forceinline__ void xcd_barrier(const XcdBarrier& b) {
    asm volatile("s_waitcnt vmcnt(0)" ::: "memory");
    __syncthreads();
    if (threadIdx.x == 0) {
        unsigned* bar = b.bar;
        __builtin_amdgcn_s_waitcnt(0);
        unsigned nloc = b.st[0], nx = b.st[1];
        if (nloc == 0u) { xcd_barrier_complete(bar, b.x, nloc, nx); b.st[0] = nloc; b.st[1] = nx; }
        const unsigned old = xb_add(&bar[XB_XSUB(b.x)], 1u);
        const unsigned gen = old / nloc;
        if (old + 1u == (gen + 1u) * nloc) {
            __builtin_amdgcn_fence(__ATOMIC_RELEASE, "agent");
            asm volatile("s_waitcnt vmcnt(0)" ::: "memory");
            const unsigned og = xb_add(&bar[XB_TOP], 1u);
            const unsigned tg = og / nx;
            if (og + 1u == (tg + 1u) * nx) xb_add(&bar[XB_TOPGEN], 1u);
            else XB_SPIN(xb_ld(&bar[XB_TOPGEN]) == tg, bar);
            __builtin_amdgcn_fence(__ATOMIC_ACQUIRE, "agent");
            xb_add(&bar[XB_XGEN(b.x)], 1u);
            asm volatile("s_waitcnt vmcnt(0)" ::: "memory");
        } else {
            XB_SPIN(xb_ld(&bar[XB_XGEN(b.x)]) == gen, bar);
            __builtin_amdgcn_fence(__ATOMIC_ACQUIRE, "agent");
            asm volatile("s_waitcnt vmcnt(0)" ::: "memory");
        }
    }
    __syncthreads();
}
constexpr int NWAVES = 8;
constexpr int LDS_BYTES = 163840;
constexpr int N_PHASES = 12;
constexpr int MISC_OFF = 163840 - 256; static_assert(att::SHM_ATTN <= MISC_OFF, "LDS map");


struct Frame {
    LAS unsigned char* lds;
    int tid, lane, wave, gw, NGW, G;
    unsigned char* ws;
};

struct Args { const float* in[19]; float* out; unsigned char* ws; int ph_lo, ph_hi; };
struct TrDesc { const float* W; bf16_t* WT; const float* gk; int K, N, item; bool reorder; };
__device__ __forceinline__ void tr_load(const TrDesc& d, int lane, f32x4 (&wv)[8]) {
    const int nblk = d.N / 32, kb = d.item / nblk, nb = d.item % nblk, k0 = 64 * kb, n0 = 32 * nb;
#pragma unroll
    for (int i = 0; i < 8; ++i) wv[i] = *(const f32x4*)(d.W + (size_t)(k0 + 8 * i + (lane >> 3)) * d.N + n0 + (lane & 7) * 4);
}
__device__ __forceinline__ void tr_finish(const TrDesc& d, int lane, const f32x4 (&wv)[8], LAS float* scr) {
    const int nblk = d.N / 32, kb = d.item / nblk, nb = d.item % nblk, k0 = 64 * kb, n0 = 32 * nb;
    const int d0 = d.reorder ? (nb < 32 ? n0 : (nb < 34 ? n0 + 2048 : n0 - 64)) : n0;
#pragma unroll
    for (int i = 0; i < 8; ++i) { const int kk = 8 * i + (lane >> 3); f32x4 v = wv[i]; if (d.gk) v = v * d.gk[k0 + kk];
        LAS float* p = scr + kk * 33 + (lane & 7) * 4; p[0] = v[0]; p[1] = v[1]; p[2] = v[2]; p[3] = v[3]; }
    asm volatile("s_waitcnt lgkmcnt(0)" ::: "memory");
    const int c = lane & 7;
#pragma unroll
    for (int j = 0; j < 4; ++j) { const int n = (lane >> 3) + 8 * j; const LAS float* sp = scr + (8 * c) * 33 + n;
        u32x4 o; o.x = cvt_pk_bf16(sp[0 * 33], sp[1 * 33]); o.y = cvt_pk_bf16(sp[2 * 33], sp[3 * 33]); o.z = cvt_pk_bf16(sp[4 * 33], sp[5 * 33]); o.w = cvt_pk_bf16(sp[6 * 33], sp[7 * 33]);
        *(u32x4*)(d.WT + (size_t)(d0 + n) * d.K + k0 + 8 * c) = o; }
    asm volatile("s_waitcnt lgkmcnt(0)" ::: "memory");
}
constexpr int I_WIN = 32 * 128, I_WG = 4 * 8 * 16, I_WOUT = 32 * 64, I_WMLA = 32 * 98, I_WUQ = 8 * 96, I_WUKV = 8 * 128, I_WMO = 32 * 64;
constexpr int I_LIST0 = I_WIN + I_WG + I_WOUT, I_LIST1 = I_WMLA + I_WUQ + I_WUKV, I_LIST2 = I_WMO;
__device__ __forceinline__ TrDesc tr_desc(const Args& a, int list, int r) {
    unsigned char* ws = a.ws; TrDesc d; d.gk = nullptr; d.reorder = false;
    if (list == 0) {
        if (r < I_WIN) { d.W = a.in[8]; d.WT = (bf16_t*)(ws + WS_WIN); d.K = DM; d.N = 4096; d.item = r; return d; } r -= I_WIN;
        if (r < I_WG) { const int g = r / 128; d.W = a.in[9] + (size_t)g * 512 * 512; d.WT = (bf16_t*)(ws + WS_WG) + (size_t)g * 512 * 512; d.K = 512; d.N = 512; d.item = r % 128; return d; } r -= I_WG;
        d.W = a.in[12]; d.WT = (bf16_t*)(ws + WS_WOUT); d.K = DM; d.N = DM; d.item = r; return d;
    }
    if (list == 1) {
    if (r < I_WMLA) { d.W = a.in[13]; d.WT = (bf16_t*)(ws + WS_WMLA); d.K = DM; d.N = 3136; d.item = r; d.reorder = true; return d; } r -= I_WMLA;
    if (r < I_WUQ) { d.W = a.in[16]; d.WT = (bf16_t*)(ws + WS_WUQ); d.K = 512; d.N = 3072; d.item = r; d.gk = a.in[14]; return d; } r -= I_WUQ;
    { d.W = a.in[17]; d.WT = (bf16_t*)(ws + WS_WUKV); d.K = 512; d.N = 4096; d.item = r; d.gk = a.in[15]; return d; } }
    d.W = a.in[18]; d.WT = (bf16_t*)(ws + WS_WMO); d.K = DM; d.N = DM; d.item = r; return d;
}
__device__ __forceinline__ void tr_run(const Args& a, int list, int first, int stride, int lane, LAS float* scr, int n_end = -1) {
    const int n = n_end >= 0 ? n_end : (list == 0 ? I_LIST0 : (list == 1 ? I_LIST1 : I_LIST2));
    int it = first; if (it >= n) return;
    TrDesc d = tr_desc(a, list, it); f32x4 wv[8]; tr_load(d, lane, wv);
    for (;;) {
        const int nit = it + stride; const bool more = nit < n;
        TrDesc dn = d; f32x4 wn[8];
        if (more) { dn = tr_desc(a, list, nit); tr_load(dn, lane, wn); }
        tr_finish(d, lane, wv, scr);
        if (!more) break;
#pragma unroll
        for (int i = 0; i < 8; ++i) wv[i] = wn[i];
        d = dn; it = nit;
    }
}

__device__ __forceinline__ void gemv_item(const float* c, const float* c_ctx, const float* ada_w, const float* ada_b, float* mod, int it, int lane) {
    const int l = it / 768, rem = it % 768, kc = rem / 24, cgp = rem % 24, k0 = kc * 64;
    float s[9];
#pragma unroll
    for (int r = 0; r < 8; ++r) s[r] = silu_f(c[r * DM + k0 + lane]);
    s[8] = silu_f(c_ctx[k0 + lane]);
    const float* W = ada_w + (size_t)l * DM * 6144 + (size_t)k0 * 6144 + cgp * 256 + lane * 4;
    f32x4 acc[9];
#pragma unroll
    for (int r = 0; r < 9; ++r) acc[r] = (f32x4){0.f, 0.f, 0.f, 0.f};
#pragma unroll 16
    for (int kk = 0; kk < 64; ++kk) { const f32x4 w = *(const f32x4*)(W + (size_t)kk * 6144);
#pragma unroll
        for (int r = 0; r < 9; ++r) { const float sk = __uint_as_float(__builtin_amdgcn_readlane(__float_as_uint(s[r]), kk)); acc[r] += w * sk; } }
    const int col = cgp * 256 + lane * 4;
    f32x4 bv = (f32x4){0.f, 0.f, 0.f, 0.f};
    if (kc == 0) bv = *(const f32x4*)(ada_b + l * 6144 + col);
#pragma unroll
    for (int r = 0; r < 9; ++r) { float* m = mod + (size_t)(l * 9 + r) * 6144 + col;
#pragma unroll
        for (int j = 0; j < 4; ++j) atomicAdd(m + j, acc[r][j] + bv[j]); }
}

__device__ __forceinline__ void load_row_f32(const float* p, int lane, f32x4 (&v)[8]) {
#pragma unroll
    for (int j = 0; j < 8; ++j) v[j] = *(const f32x4*)(p + 4 * lane + 256 * j);
}
__device__ __forceinline__ float sumsq8(const f32x4 (&v)[8]) {
    float s = 0.f;
#pragma unroll
    for (int j = 0; j < 8; ++j) s += (v[j][0] * v[j][0] + v[j][1] * v[j][1]) + (v[j][2] * v[j][2] + v[j][3] * v[j][3]);
    return wave_sum(s);
}
__device__ __forceinline__ void modulate_store(const f32x4 (&v)[8], float rstd, const float* pn, const float* modr, bf16_t* orow, int lane) {
#pragma unroll
    for (int j = 0; j < 8; ++j) { const int col = 4 * lane + 256 * j;
        const f32x4 g = *(const f32x4*)(pn + col), sh = *(const f32x4*)(modr + col), sc = *(const f32x4*)(modr + DM + col);
        const f32x4 hh = v[j] * rstd * g * (sc + 1.f) + sh;
        u32x2 w; w.x = cvt_pk_bf16(hh[0], hh[1]); w.y = cvt_pk_bf16(hh[2], hh[3]);
        *(u32x2*)(orow + col) = w; }
}


template <int WIN> __device__ __forceinline__ void pool_chunk(const bf16_t* Ub, bf16_t* Pb, int t0, int L) {
    constexpr int LEFT = WIN / 2, RIGHT = WIN - 1 - LEFT, NR = 8 + WIN - 1;
    u32x4 rw[NR];
#pragma unroll
    for (int k = 0; k < NR; ++k) { const int t = t0 - LEFT + k; rw[k] = (t >= 0 && t < L) ? *(const u32x4*)(Ub + (size_t)t * DM) : (u32x4){0u, 0u, 0u, 0u}; }
    float S8[8];
#pragma unroll
    for (int e = 0; e < 8; ++e) S8[e] = 0.f;
#define ACC8(q_, sgn) do { const u32x4 a_ = (q_); S8[0] += sgn bf_lo(a_.x); S8[1] += sgn bf_hi(a_.x); S8[2] += sgn bf_lo(a_.y); S8[3] += sgn bf_hi(a_.y); \
                          S8[4] += sgn bf_lo(a_.z); S8[5] += sgn bf_hi(a_.z); S8[6] += sgn bf_lo(a_.w); S8[7] += sgn bf_hi(a_.w); } while (0)
#pragma unroll
    for (int k = 0; k < WIN; ++k) ACC8(rw[k], +);
#pragma unroll
    for (int i = 0; i < 8; ++i) { const int t = t0 + i; const int lo_ = t - LEFT < 0 ? 0 : t - LEFT, hi_ = t + RIGHT + 1 > L ? L : t + RIGHT + 1;
        const float inv = 1.f / (float)(hi_ - lo_); const u32x4 w = rw[i + LEFT];
        u32x4 o; o.x = cvt_pk_bf16(S8[0] * inv - bf_lo(w.x), S8[1] * inv - bf_hi(w.x)); o.y = cvt_pk_bf16(S8[2] * inv - bf_lo(w.y), S8[3] * inv - bf_hi(w.y));
        o.z = cvt_pk_bf16(S8[4] * inv - bf_lo(w.z), S8[5] * inv - bf_hi(w.z)); o.w = cvt_pk_bf16(S8[6] * inv - bf_lo(w.w), S8[7] * inv - bf_hi(w.w));
        *(u32x4*)(Pb + (size_t)t * DM) = o;
        if (i < 7) { ACC8(rw[i + WIN], +); ACC8(rw[i], -); } }
#undef ACC8
}

__global__ void __launch_bounds__(NWAVES * 64, 2) mk_fwd(Args args) {
    extern __shared__ __attribute__((aligned(16))) unsigned char lds[];
    cg::grid_group grid = cg::this_grid();
    Frame F;
    F.lds = (LAS unsigned char*)lds;
    F.tid = threadIdx.x; F.lane = F.tid & 63; F.wave = __builtin_amdgcn_readfirstlane(F.tid >> 6);
    F.G = gridDim.x; F.gw = blockIdx.x * NWAVES + F.wave; F.NGW = F.G * NWAVES; F.ws = args.ws;
    unsigned char* ws = args.ws;
    const int lo = args.ph_lo, hi = args.ph_hi;
#ifndef PHASE_MASK
#define PHASE_MASK 0xFFF
#endif
#define IN(k) (((PHASE_MASK >> (k)) & 1) && lo <= (k) && (k) < hi)
#ifndef DBL_MASK
#define DBL_MASK 0
#endif

#define SEAM(k) do { if (IN(k) && IN((k) + 1)) xcd_barrier(bar); } while (0)
    if (args.ph_hi > 4096) grid.sync();
    volatile LAS unsigned* MISC = (volatile LAS unsigned*)(F.lds + MISC_OFF);
    if (F.tid < 16) MISC[F.tid] = 0u;
    __syncthreads();
    XcdBarrier bar; bar.bar = (unsigned*)(args.ws + WS_BAR); bar.x = 0; bar.st = MISC;
    if (hi - lo > 1) bar = xcd_barrier_post((unsigned*)(args.ws + WS_BAR), MISC);
    const float* x = args.in[0]; const float* c = args.in[1]; const float* ctx = args.in[2]; const float* c_ctx = args.in[3];
    const float* ada_w = args.in[4]; const float* ada_b = args.in[5]; const float* pre_norm = args.in[6]; const float* post_norm = args.in[7];
    float* mod = (float*)(ws + WS_MOD); float* ssq = (float*)(ws + WS_SSQ); f32x2* tab = (f32x2*)(ws + WS_TAB);
    bf16_t* WIN = (bf16_t*)(ws + WS_WIN); bf16_t* WG = (bf16_t*)(ws + WS_WG); bf16_t* WOUT = (bf16_t*)(ws + WS_WOUT); bf16_t* WMLA = (bf16_t*)(ws + WS_WMLA);
    bf16_t* WUQ = (bf16_t*)(ws + WS_WUQ); bf16_t* WUKV = (bf16_t*)(ws + WS_WUKV); bf16_t* WMO = (bf16_t*)(ws + WS_WMO);
    bf16_t* H = (bf16_t*)(ws + WS_H); bf16_t* SG = (bf16_t*)(ws + WS_SG); bf16_t* Z = (bf16_t*)(ws + WS_Z); bf16_t* Y = (bf16_t*)(ws + WS_Y);
    bf16_t* U = (bf16_t*)(ws + WS_U); bf16_t* P = (bf16_t*)(ws + WS_P); bf16_t* Q = (bf16_t*)(ws + WS_Q); bf16_t* CQ = (bf16_t*)(ws + WS_CQ);
    bf16_t* CKV = (bf16_t*)(ws + WS_CKV); bf16_t* KR = (bf16_t*)(ws + WS_KR); bf16_t* KN = (bf16_t*)(ws + WS_KN); bf16_t* V = (bf16_t*)(ws + WS_V);
    const int NTHR = F.G * NWAVES * 64;
#define FRESH() int gtid; do { int t_ = threadIdx.x; asm volatile("" : "+v"(t_)); F.tid = t_; F.lane = t_ & 63; gtid = blockIdx.x * (NWAVES * 64) + t_; (void)gtid; } while (0)

    if (IN(0)) { FRESH();
        LAS float* scr = (LAS float*)(F.lds + F.wave * 16384);
        constexpr int I_GEMV = 2 * 32 * 24;
        if (F.G == 256) {
            if (F.wave < 3) gemv_item(c, c_ctx, ada_w, ada_b, mod, (int)blockIdx.x * 3 + F.wave, F.lane);
            const int b0 = (int)blockIdx.x * 26 + (F.wave < 3 ? F.wave * 2 : 6 + (F.wave - 3) * 4);
            tr_run(args, 0, b0, 1, F.lane, scr, b0 + (F.wave < 3 ? 2 : 4));
        } else {
            for (int it = F.gw; it < I_GEMV; it += F.NGW) gemv_item(c, c_ctx, ada_w, ada_b, mod, it, F.lane);
            tr_run(args, 0, F.gw, F.NGW, F.lane, scr); tr_run(args, 1, F.gw, F.NGW, F.lane, scr); tr_run(args, 2, F.gw, F.NGW, F.lane, scr);
        }
        for (int i = gtid; i < (NMLA - 3136) * DM / 8; i += NTHR) *(u32x4*)(WMLA + (size_t)3136 * DM + (size_t)i * 8) = (u32x4){0u, 0u, 0u, 0u};
        if (gtid < 1024) { const int pos = gtid >> 4, i = gtid & 15; const float fr = powf(10000.f, -(float)i / 16.f); const float ang = (float)pos * fr; float sn, cs; sincosf(ang, &sn, &cs); tab[gtid] = (f32x2){cs, sn}; }
    }
    SEAM(0);
    if (IN(1)) { FRESH();
        for (int row0 = F.gw * 3; row0 < MT; row0 += F.NGW * 3) {
            f32x4 v[3][8];
#pragma unroll
            for (int q = 0; q < 3; ++q) { const int row = row0 + q; const float* src = row < ML ? x + (size_t)row * DM : ctx + (size_t)(row - ML) * DM; load_row_f32(src, F.lane, v[q]); }
#pragma unroll
            for (int q = 0; q < 3; ++q) { const int row = row0 + q; const int r = row < ML ? row / SEQ : 8;
                const float rstd = __builtin_amdgcn_rsqf(sumsq8(v[q]) * (1.f / DM) + EPS);
                modulate_store(v[q], rstd, pre_norm, mod + (size_t)r * 6144, H + (size_t)row * DM, F.lane); }
        }
    }
    SEAM(1);
    if (IN(2)) {
        pg8::Gemm g{H, WIN, MT, 4096, DM, DM, DM, 0}; pg8::StaticOrder S; S.init(MT, 4096, F.G, (int)blockIdx.x);
        pg8::EpiPoolIn E{U, SG};
        pg8::gemm_phase<pg8::EpiPoolIn>(F.lds, g, S, E);
        if (F.G == 256 && (int)blockIdx.x >= 128)
            tr_run(args, 1, ((int)blockIdx.x - 128) * NWAVES + F.wave, 128 * NWAVES, threadIdx.x & 63, (LAS float*)(F.lds + F.wave * 16384));
    }
    SEAM(2);
    if (IN(3)) { FRESH();
        for (int item = gtid; item < (MT / 8) * 256; item += NTHR) {
            const int cc = item & 255, row0 = (item >> 8) * 8;
            int base, L; if (row0 < ML) { base = row0 & ~(SEQ - 1); L = SEQ; } else { base = ML + ((row0 - ML) & ~(CTXL - 1)); L = CTXL; }
            const int t0 = row0 - base, gidx = cc >> 6;
            const bf16_t* Ub = U + (size_t)base * DM + cc * 8; bf16_t* Pb = P + (size_t)base * DM + cc * 8;
            switch (gidx) {
                case 0: pool_chunk<2>(Ub, Pb, t0, L); break;
                case 1: pool_chunk<4>(Ub, Pb, t0, L); break;
                case 2: pool_chunk<8>(Ub, Pb, t0, L); break;
                default: pool_chunk<16>(Ub, Pb, t0, L); break;
            }
        }
    }
    SEAM(3);
    if (IN(4)) {
        pg8::Gemm g{P, WG, MT, DM, 512, DM, 512, 2}; pg8::StaticOrder S; S.init(MT, DM, F.G, (int)blockIdx.x);
        pg8::EpiGrp E{SG, Z, args.in[10], args.in[11]};
        pg8::gemm_phase<pg8::EpiGrp>(F.lds, g, S, E);
    }
    SEAM(4);
    if (IN(5)) {
        pg8::Gemm g{Z, WOUT, MT, DM, DM, DM, DM, 0}; pg8::StaticOrder S; S.init(MT, DM, F.G, (int)blockIdx.x);
        pg8::EpiPlain E{Y, DM};
        pg8::gemm_phase<pg8::EpiPlain>(F.lds, g, S, E);
        if (F.G == 256 && (int)blockIdx.x >= 64) {
            const int lb = (int)blockIdx.x - 64;
            if (F.wave < 4) gemv_item(c, c_ctx, ada_w, ada_b, mod, 768 + lb * 4 + F.wave, threadIdx.x & 63);
            else tr_run(args, 2, lb * 4 + (F.wave - 4), 192 * 4, threadIdx.x & 63, (LAS float*)(F.lds + F.wave * 16384));
        }
    }
    SEAM(5);
    if (IN(6)) { FRESH();
        for (int row0 = F.gw * 3; row0 < MT; row0 += F.NGW * 3) {
            f32x4 v[3][8]; u32x2 yw[3][8];
#pragma unroll
            for (int q = 0; q < 3; ++q) { const int row = row0 + q; const float* src = row < ML ? x + (size_t)row * DM : ctx + (size_t)(row - ML) * DM; load_row_f32(src, F.lane, v[q]);
                const bf16_t* yr = Y + (size_t)row * DM;
#pragma unroll
                for (int j = 0; j < 8; ++j) yw[q][j] = *(const u32x2*)(yr + 4 * F.lane + 256 * j); }
#pragma unroll
            for (int q = 0; q < 3; ++q) { const int row = row0 + q; const bool lat = row < ML; const int r = lat ? row / SEQ : 8;
                float sy = 0.f;
#pragma unroll
                for (int j = 0; j < 8; ++j) { const float a = bf_lo(yw[q][j].x), b = bf_hi(yw[q][j].x), c2 = bf_lo(yw[q][j].y), d = bf_hi(yw[q][j].y); sy += (a * a + b * b) + (c2 * c2 + d * d); }
                const float rsy = __builtin_amdgcn_rsqf(wave_sum(sy) * (1.f / DM) + EPS);
                const float* m0 = mod + (size_t)r * 6144;
#pragma unroll
                for (int j = 0; j < 8; ++j) { const int col = 4 * F.lane + 256 * j; const f32x4 gt = *(const f32x4*)(m0 + 2 * DM + col), pn = *(const f32x4*)(post_norm + col);
                    const f32x4 y4 = (f32x4){bf_lo(yw[q][j].x), bf_hi(yw[q][j].x), bf_lo(yw[q][j].y), bf_hi(yw[q][j].y)};
                    v[q][j] = v[q][j] + gt * (y4 * rsy * pn);
                    if (lat) *(f32x4*)(args.out + (size_t)row * DM + col) = v[q][j]; }
                const float rstd = __builtin_amdgcn_rsqf(sumsq8(v[q]) * (1.f / DM) + EPS);
                modulate_store(v[q], rstd, pre_norm + DM, mod + (size_t)(9 + r) * 6144, H + (size_t)row * DM, F.lane); }
        }
    }
    SEAM(6);
    if (IN(7)) {
        pg8::Gemm g{H, WMLA, MT, NMLA, DM, DM, DM, 0}; pg8::StaticOrder S; S.init(MT, NMLA, F.G, (int)blockIdx.x);
        pg8::EpiMlaIn E{CQ, CKV, KR, SG, ssq, tab};
        pg8::gemm_phase<pg8::EpiMlaIn>(F.lds, g, S, E);
    }
    SEAM(7);
    if (IN(8)) {
        { pg8::Gemm g{CQ, WUQ, ML, 3072, 512, 512, 512, 0}; pg8::StaticOrder S; S.init(ML, 3072, F.G, (int)blockIdx.x);
          pg8::EpiQ E{Q, ssq, tab};
          pg8::gemm_phase<pg8::EpiQ>(F.lds, g, S, E); }
        { pg8::Gemm g{CKV, WUKV, MT, 4096, 512, 512, 512, 0}; pg8::StaticOrder S; S.init(MT, 4096, F.G, (int)blockIdx.x);
          pg8::EpiKV E{KN, V, ssq + MT};
          pg8::gemm_phase<pg8::EpiKV>(F.lds, g, S, E); }
    }
    SEAM(8);
    if (IN(9)) {
        const int bx = blockIdx.x, vcu = (F.G % 8 == 0) ? (bx % 8) * (F.G / 8) + bx / 8 : bx;
        att::attn_phase(Q, KN, KR, V, SG, Z, vcu, F.G, (char*)lds, F.lds);
    }
    SEAM(9);
    if (IN(10)) {
        pg8::Gemm g{Z, WMO, ML, DM, DM, DM, DM, 0}; pg8::StaticOrder S; S.init(ML, DM, F.G, (int)blockIdx.x);
        pg8::EpiPlain E{Y, DM};
        pg8::gemm_phase<pg8::EpiPlain>(F.lds, g, S, E);
    }
    SEAM(10);
    if (IN(11)) { FRESH();
        for (int row0 = F.gw * 2; row0 < ML; row0 += F.NGW * 2) {
            f32x4 v[2][8]; u32x2 yw[2][8];
#pragma unroll
            for (int q = 0; q < 2; ++q) { const int row = row0 + q; load_row_f32(args.out + (size_t)row * DM, F.lane, v[q]);
                const bf16_t* yr = Y + (size_t)row * DM;
#pragma unroll
                for (int j = 0; j < 8; ++j) yw[q][j] = *(const u32x2*)(yr + 4 * F.lane + 256 * j); }
#pragma unroll
            for (int q = 0; q < 2; ++q) { const int row = row0 + q; const int r = row / SEQ;
                float sy = 0.f;
#pragma unroll
                for (int j = 0; j < 8; ++j) { const float a = bf_lo(yw[q][j].x), b = bf_hi(yw[q][j].x), c2 = bf_lo(yw[q][j].y), d = bf_hi(yw[q][j].y); sy += (a * a + b * b) + (c2 * c2 + d * d); }
                const float rsy = __builtin_amdgcn_rsqf(wave_sum(sy) * (1.f / DM) + EPS);
                const float* m1 = mod + (size_t)(9 + r) * 6144;
#pragma unroll
                for (int j = 0; j < 8; ++j) { const int col = 4 * F.lane + 256 * j; const f32x4 gt = *(const f32x4*)(m1 + 2 * DM + col), pn = *(const f32x4*)(post_norm + DM + col);
                    const f32x4 y4 = (f32x4){bf_lo(yw[q][j].x), bf_hi(yw[q][j].x), bf_lo(yw[q][j].y), bf_hi(yw[q][j].y)};
                    *(f32x4*)(args.out + (size_t)row * DM + col) = v[q][j] + gt * (y4 * rsy * pn); }
            }
        }
    }
#undef IN
#undef SEAM
}

extern "C" void kernel_launch(void* const* d_in, const int* in_sizes, int n_in, void* d_out, int out_size, void* d_ws, size_t ws_size, hipStream_t stream) {
    static int grid = 0;
    if (grid == 0) {
        if (n_in != 19 || out_size != ML * DM || ws_size < WS_END) { fprintf(stderr, "kernel_launch: unexpected shapes (n_in %d out %d ws %zu)\n", n_in, out_size, ws_size); grid = -1; return; }
        int dev = 0, cus = 0, per_cu = 0;
        hipGetDevice(&dev); hipDeviceGetAttribute(&cus, hipDeviceAttributeMultiprocessorCount, dev);
        if (hipFuncSetAttribute((const void*)mk_fwd, hipFuncAttributeMaxDynamicSharedMemorySize, LDS_BYTES) != hipSuccess) { fprintf(stderr, "kernel_launch: hipFuncSetAttribute failed\n"); grid = -1; return; }
        hipOccupancyMaxActiveBlocksPerMultiprocessor(&per_cu, (const void*)mk_fwd, NWAVES * 64, LDS_BYTES);
        (void)hipGetLastError();
        if (per_cu < 1) per_cu = 1;
        grid = cus * 1;
        (void)per_cu;
    }
    if (grid < 0) return;
    hipMemsetAsync((char*)d_ws, 0, CTL_ZERO_BYTES, stream);
    Args a{};
    for (int i = 0; i < 19; ++i) a.in[i] = (const float*)d_in[i];
    a.out = (float*)d_out; a.ws = (unsigned char*)d_ws;
#if MK_N_LAUNCHES == 1
    a.ph_lo = 0; a.ph_hi = N_PHASES;
    void* kargs[] = {&a};
    hipError_t e = hipLaunchCooperativeKernel((const void*)mk_fwd, dim3(grid), dim3(NWAVES * 64), kargs, LDS_BYTES, stream);
    if (e != hipSuccess) fprintf(stderr, "cooperative launch failed: %s (grid %d)\n", hipGetErrorString(e), grid);
#else
    for (int p = 0; p < N_PHASES; ++p) for (int rep = 0; rep < (((DBL_MASK >> p) & 1) ? 2 : 1); ++rep) { a.ph_lo = p; a.ph_hi = p + 1; hipLaunchKernelGGL(mk_fwd, dim3(grid), dim3(NWAVES * 64), LDS_BYTES, stream, a); }
#endif
}
```

```cpp
#include <hip/hip_runtime.h>
#include <hip/hip_cooperative_groups.h>
#include <hip/hip_bf16.h>
#include <cstdio>
#include <cstdint>
namespace cg = cooperative_groups;

#ifndef MK_N_LAUNCHES
#define MK_N_LAUNCHES 1
#endif

#define LAS __attribute__((address_space(3)))
typedef unsigned short bf16_t;
typedef short bf16x8 __attribute__((ext_vector_type(8)));
typedef short s16x4 __attribute__((ext_vector_type(4)));
typedef float f32x4 __attribute__((ext_vector_type(4)));
typedef float f32x2 __attribute__((ext_vector_type(2)));
typedef float f32x16 __attribute__((ext_vector_type(16)));
typedef unsigned u32x4 __attribute__((ext_vector_type(4)));
typedef unsigned u32x2 __attribute__((ext_vector_type(2)));

constexpr int DM = 2048, NB = 8, SEQ = 2048, CTXL = 256;
constexpr int ML = NB * SEQ, MC = NB * CTXL, MT = ML + MC;
constexpr int NMLA = 3328;
constexpr float EPS = 1e-6f;
constexpr float QSCALE = 0.07216878364870322f * 1.4426950408889634f;

constexpr size_t MiB = 1u << 20;
constexpr size_t WS_MOD = 0;
constexpr size_t WS_SSQ = 512 * 1024;
constexpr size_t WS_BAR = 768 * 1024;
constexpr size_t CTL_ZERO_BYTES = 1 * MiB;
constexpr size_t WS_TAB = 1 * MiB;
constexpr size_t WS_WIN = 2 * MiB, WS_WG = 18 * MiB, WS_WOUT = 20 * MiB, WS_WMLA = 28 * MiB, WS_WUQ = 41 * MiB, WS_WUKV = 44 * MiB, WS_WMO = 48 * MiB;
constexpr size_t WS_H = 64 * MiB, WS_SG = 136 * MiB, WS_Z = 208 * MiB, WS_Y = 280 * MiB, WS_U = 352 * MiB, WS_P = 424 * MiB;
constexpr size_t WS_Q = 352 * MiB, WS_CQ = 448 * MiB, WS_CKV = 466 * MiB, WS_KR = 484 * MiB, WS_KN = WS_H, WS_V = WS_Y;
constexpr size_t WS_END = 496 * MiB;

__device__ __forceinline__ unsigned cvt_pk_bf16(float lo, float hi) { unsigned r; asm volatile("v_cvt_pk_bf16_f32 %0, %1, %2" : "=v"(r) : "v"(lo), "v"(hi)); return r; }
__device__ __forceinline__ float bf_lo(unsigned w) { return __uint_as_float(w << 16); }
__device__ __forceinline__ float bf_hi(unsigned w) { return __uint_as_float(w & 0xffff0000u); }
__device__ __forceinline__ float silu_f(float v) { return v * __builtin_amdgcn_rcpf(1.f + __builtin_amdgcn_exp2f(-1.4426950408889634f * v)); }
__device__ __forceinline__ float wave_sum(float v) {
#pragma unroll
    for (int o = 1; o < 64; o <<= 1) v += __shfl_xor(v, o);
    return v;
}

namespace pg8 {
constexpr int BM = 256, BK = 64, HALF = 128, HTB = HALF * BK * 2, STAGE_BYTES = 8 * HTB, NXCD = 8, WGM = 8;
__host__ __device__ __forceinline__ int lds_byte(int r, int c) { const int st = (r >> 4) * 2 + (c >> 5), rr = r & 15, cc = c & 31, ob = rr * 64 + cc * 2; return st * 1024 + (ob ^ (((ob >> 9) & 1) << 5)); }
__host__ __device__ __forceinline__ void stage_rc(int b, int& R, int& C) { const int st = b / 1024, sb = b % 1024, swz = sb ^ (((sb >> 9) & 1) << 5); R = (st >> 1) * 16 + swz / 64; C = (st & 1) * 32 + (swz % 64) / 2; }
__host__ __device__ __forceinline__ int perm32(int rho) { const int n = rho >> 4, i = rho & 15; return 8 * (i >> 2) + 4 * n + (i & 3); }

struct Unit { int pm, pn; };
struct Gemm { const bf16_t* A; const bf16_t* Bt; int M, N, K, lda, ldb, agrp; };

struct StaticOrder {
    int nM, nN, nwg, G, c;
    __host__ __device__ void init(int M, int N, int G_, int c_) { nM = M / BM; nN = N / BM; nwg = nM * nN; G = G_; c = c_; }
    __host__ __device__ bool next(int i, Unit& u) const {
        const long L = (long)i * G + c; if (L >= nwg) return false;
        int wgid = (int)L; { const int q = nwg / NXCD, r = nwg % NXCD, xcd = wgid % NXCD, off = wgid / NXCD; wgid = (xcd < r ? xcd * (q + 1) : r * (q + 1) + (xcd - r) * q) + off; }
        const int nig = WGM * nN, gid = wgid / nig, fm = gid * WGM, gsz = (nM - fm) < WGM ? (nM - fm) : WGM;
        u.pm = fm + ((wgid % nig) % gsz); u.pn = (wgid % nig) / gsz; return true;
    }
};

template <class Epi>
__device__ __forceinline__ void gemm_phase(LAS unsigned char* lds, const Gemm g, const StaticOrder& S, const Epi& E) {
    const int tid = threadIdx.x, wid = __builtin_amdgcn_readfirstlane(tid >> 6), lane = tid & 63, wr = wid >> 2, wc = wid & 3, fr = lane & 15, fq = lane >> 4;
    const int K = g.K, nt = K / BK;
    unsigned voffA[2], voffB[2];
#pragma unroll
    for (int i = 0; i < 2; ++i) { int R, C; stage_rc(tid * 16 + i * 8192, R, C); const int Rb = Epi::PERM ? ((R & ~31) + perm32(R & 31)) : R;
        voffA[i] = (unsigned)(R * g.lda + C) * 2u; voffB[i] = (unsigned)(Rb * g.ldb + C) * 2u; }
    const size_t kstep = (size_t)(BK * 2);
    const size_t hsA = (size_t)HALF * g.lda * 2, hsB = (size_t)HALF * g.ldb * 2;
    const size_t tsA = 2 * hsA, tsB = 2 * hsB;
    const unsigned ldsw = (unsigned)wid * 1024u;
    const int aoff = lds_byte(wr * 64 + fr, fq * 8), boff = lds_byte(wc * 32 + fr, fq * 8);
#define PG8_SA(b, h) (((b) * 2 + (h)) * HTB)
#define PG8_SB(b, h) ((4 + (b) * 2 + (h)) * HTB)
#define PG8_STAGE(bufoff, gbase, voff) do { _Pragma("unroll") for (int _i = 0; _i < 2; ++_i) \
        __builtin_amdgcn_global_load_lds((const unsigned*)((const char*)(gbase) + (voff)[_i]), (LAS unsigned*)(lds + (bufoff) + ldsw + _i * 8192), 16, 0, 0); } while (0)
#define PG8_LDA(dst, b, h) do { _Pragma("unroll") for (int m = 0; m < 4; ++m) _Pragma("unroll") for (int k = 0; k < 2; ++k) dst[m][k] = *(const LAS bf16x8*)(lds + PG8_SA(b, h) + aoff + m * 2048 + k * 1024); } while (0)
#define PG8_LDB(dst, b, h) do { _Pragma("unroll") for (int n = 0; n < 2; ++n) _Pragma("unroll") for (int k = 0; k < 2; ++k) dst[n][k] = *(const LAS bf16x8*)(lds + PG8_SB(b, h) + boff + n * 2048 + k * 1024); } while (0)
#define PG8_MMA(ai, bj, At, Bt) do { __builtin_amdgcn_s_setprio(1); _Pragma("unroll") for (int m = 0; m < 4; ++m) _Pragma("unroll") for (int n = 0; n < 2; ++n) _Pragma("unroll") for (int k = 0; k < 2; ++k) \
        acc[ai][bj][m][n] = __builtin_amdgcn_mfma_f32_16x16x32_bf16(Bt[n][k], At[m][k], acc[ai][bj][m][n], 0, 0, 0); __builtin_amdgcn_s_setprio(0); } while (0)
#define PG8_WAIT_V(n) asm volatile("s_waitcnt vmcnt(" #n ")" ::: "memory")
#define PG8_WAIT_L(n) asm volatile("s_waitcnt lgkmcnt(" #n ")" ::: "memory")
#define PG8_BAR __builtin_amdgcn_s_barrier()
#define PG8_SCHED __builtin_amdgcn_sched_barrier(0)
#define PG8_AOFF(u) ((g.agrp > 0) ? (size_t)((u).pn / g.agrp) * (size_t)K * 2 : (size_t)0)
    Unit cur, nxt; int ui = 0;
    if (!S.next(0, cur)) return;
    f32x4 acc[2][2][4][2];
#pragma unroll
    for (int a = 0; a < 2; ++a)
#pragma unroll
        for (int b = 0; b < 2; ++b)
#pragma unroll
            for (int m = 0; m < 4; ++m)
#pragma unroll
                for (int n = 0; n < 2; ++n) acc[a][b][m][n] = (f32x4){0.f, 0.f, 0.f, 0.f};
    bf16x8 At[4][2], B0[2][2], B1[2][2];
    const char* cA = (const char*)g.A + (size_t)cur.pm * tsA + PG8_AOFF(cur); const char* cB = (const char*)g.Bt + (size_t)cur.pn * tsB;
    PG8_STAGE(PG8_SB(0, 0), cB, voffB); PG8_STAGE(PG8_SB(0, 1), cB + hsB, voffB); PG8_STAGE(PG8_SA(0, 0), cA, voffA); PG8_STAGE(PG8_SA(0, 1), cA + hsA, voffA);
    if (wr == 1) PG8_BAR;
    PG8_WAIT_V(2); PG8_BAR;
    PG8_STAGE(PG8_SB(1, 0), cB + kstep, voffB); PG8_STAGE(PG8_SA(1, 0), cA + kstep, voffA); PG8_STAGE(PG8_SB(1, 1), cB + hsB + kstep, voffB);
    PG8_WAIT_V(6); PG8_BAR;
    for (;;) {
        const bool has_next = S.next(ui + 1, nxt);
        const char* nA = has_next ? (const char*)g.A + (size_t)nxt.pm * tsA + PG8_AOFF(nxt) : cA; const char* nB = has_next ? (const char*)g.Bt + (size_t)nxt.pn * tsB : cB;
        for (int t = 0; t < nt; t += 2) {
            const bool last = (t == nt - 2);
            const char* a1 = cA + (size_t)(t + 1) * kstep;
            const char* a2 = last ? nA : cA + (size_t)(t + 2) * kstep; const char* b2 = last ? nB : cB + (size_t)(t + 2) * kstep;
            const char* a3 = a2 + kstep; const char* b3 = b2 + kstep;
            PG8_LDB(B0, 0, 0); PG8_LDB(B1, 0, 1); PG8_SCHED; PG8_LDA(At, 0, 0); PG8_STAGE(PG8_SA(1, 1), a1 + hsA, voffA);
            PG8_WAIT_V(8); PG8_WAIT_L(0); PG8_BAR; PG8_MMA(0, 0, At, B0); PG8_MMA(0, 1, At, B1); PG8_BAR; PG8_SCHED;
            PG8_LDA(At, 0, 1); PG8_STAGE(PG8_SB(0, 0), b2, voffB); PG8_STAGE(PG8_SB(0, 1), b2 + hsB, voffB); PG8_STAGE(PG8_SA(0, 0), a2, voffA);
            PG8_WAIT_V(8); PG8_WAIT_L(0); PG8_BAR; PG8_MMA(1, 0, At, B0); PG8_MMA(1, 1, At, B1); PG8_BAR; PG8_SCHED;
            PG8_LDB(B0, 1, 0); PG8_LDB(B1, 1, 1); PG8_SCHED; PG8_LDA(At, 1, 0); PG8_STAGE(PG8_SA(0, 1), a2 + hsA, voffA);
            PG8_WAIT_V(8); PG8_WAIT_L(0); PG8_BAR; PG8_MMA(0, 0, At, B0); PG8_MMA(0, 1, At, B1); PG8_BAR; PG8_SCHED;
            PG8_LDA(At, 1, 1); PG8_STAGE(PG8_SB(1, 0), b3, voffB); PG8_STAGE(PG8_SB(1, 1), b3 + hsB, voffB); PG8_STAGE(PG8_SA(1, 0), a3, voffA);
            PG8_WAIT_V(8); PG8_WAIT_L(0); PG8_BAR; PG8_MMA(1, 0, At, B0); PG8_MMA(1, 1, At, B1); PG8_BAR; PG8_SCHED;
        }
        if (wr == 0) PG8_BAR;
        E(acc, cur, wr, wc, fr, fq);
        if (!has_next) break;
#pragma unroll
        for (int a = 0; a < 2; ++a)
#pragma unroll
            for (int b = 0; b < 2; ++b)
#pragma unroll
                for (int m = 0; m < 4; ++m)
#pragma unroll
                    for (int n = 0; n < 2; ++n) acc[a][b][m][n] = (f32x4){0.f, 0.f, 0.f, 0.f};
        cur = nxt; cA = nA; cB = nB; ++ui;
        if (wr == 1) PG8_BAR;
    }
    PG8_WAIT_V(0);
    PG8_BAR;
#undef PG8_SA
#undef PG8_SB
#undef PG8_STAGE
#undef PG8_LDA
#undef PG8_LDB
#undef PG8_MMA
#undef PG8_WAIT_V
#undef PG8_WAIT_L
#undef PG8_BAR
#undef PG8_SCHED
#undef PG8_AOFF
}

__device__ __forceinline__ u32x4 pack8(f32x4 v0, f32x4 v1) { u32x4 w; w.x = cvt_pk_bf16(v0[0], v0[1]); w.y = cvt_pk_bf16(v0[2], v0[3]); w.z = cvt_pk_bf16(v1[0], v1[1]); w.w = cvt_pk_bf16(v1[2], v1[3]); return w; }
__device__ __forceinline__ f32x4 silu4(f32x4 v) { return (f32x4){silu_f(v[0]), silu_f(v[1]), silu_f(v[2]), silu_f(v[3])}; }

struct EpiPlain {
    static constexpr bool PERM = true;
    bf16_t* O; int ldc;
    __device__ __forceinline__ void operator()(const f32x4 (&acc)[2][2][4][2], const Unit& u, int wr, int wc, int fr, int fq) const {
        const int row0 = u.pm * BM + wr * 64 + fr, col0 = u.pn * BM + wc * 32 + 8 * fq;
#pragma unroll
        for (int ai = 0; ai < 2; ++ai)
#pragma unroll
            for (int m = 0; m < 4; ++m) { bf16_t* rowp = O + (size_t)(row0 + ai * HALF + m * 16) * ldc + col0;
#pragma unroll
                for (int bj = 0; bj < 2; ++bj) *(u32x4*)(rowp + bj * HALF) = pack8(acc[ai][bj][m][0], acc[ai][bj][m][1]); }
    }
};
struct EpiPoolIn {
    static constexpr bool PERM = true;
    bf16_t* U; bf16_t* SG;
    __device__ __forceinline__ void operator()(const f32x4 (&acc)[2][2][4][2], const Unit& u, int wr, int wc, int fr, int fq) const {
        const int t = u.pn >> 3; bf16_t* base = t ? SG : U;
        const int row0 = u.pm * BM + wr * 64 + fr, col0 = (u.pn & 7) * BM + wc * 32 + 8 * fq;
#pragma unroll
        for (int ai = 0; ai < 2; ++ai)
#pragma unroll
            for (int m = 0; m < 4; ++m) { bf16_t* rowp = base + (size_t)(row0 + ai * HALF + m * 16) * DM + col0;
#pragma unroll
                for (int bj = 0; bj < 2; ++bj) { f32x4 v0 = acc[ai][bj][m][0], v1 = acc[ai][bj][m][1];
                    if (t) { v0 = silu4(v0); v1 = silu4(v1); }
                    *(u32x4*)(rowp + bj * HALF) = pack8(v0, v1); } }
    }
};
struct EpiGrp {
    static constexpr bool PERM = true;
    const bf16_t* SG; bf16_t* Z; const float* bias; const float* scale;
    __device__ __forceinline__ void operator()(const f32x4 (&acc)[2][2][4][2], const Unit& u, int wr, int wc, int fr, int fq) const {
        const int row0 = u.pm * BM + wr * 64 + fr, col0 = u.pn * BM + wc * 32 + 8 * fq;
        f32x4 bv[2][2], sv[2][2];
#pragma unroll
        for (int bj = 0; bj < 2; ++bj)
#pragma unroll
            for (int n = 0; n < 2; ++n) { bv[bj][n] = *(const f32x4*)(bias + col0 + bj * HALF + 4 * n); sv[bj][n] = *(const f32x4*)(scale + col0 + bj * HALF + 4 * n); }
#pragma unroll
        for (int ai = 0; ai < 2; ++ai)
#pragma unroll
            for (int m = 0; m < 4; ++m) { const size_t off = (size_t)(row0 + ai * HALF + m * 16) * DM + col0;
#pragma unroll
                for (int bj = 0; bj < 2; ++bj) { const u32x4 gw = *(const u32x4*)(SG + off + bj * HALF);
                    f32x4 v0 = (acc[ai][bj][m][0] + bv[bj][0]) * sv[bj][0], v1 = (acc[ai][bj][m][1] + bv[bj][1]) * sv[bj][1];
                    v0 = v0 * (f32x4){bf_lo(gw.x), bf_hi(gw.x), bf_lo(gw.y), bf_hi(gw.y)}; v1 = v1 * (f32x4){bf_lo(gw.z), bf_hi(gw.z), bf_lo(gw.w), bf_hi(gw.w)};
                    *(u32x4*)(Z + off + bj * HALF) = pack8(v0, v1); } }
    }
};
struct EpiMlaIn {
    static constexpr bool PERM = true;
    bf16_t *CQ, *CKV, *KR, *SG; float* ssq; const f32x2* tab;
    __device__ __forceinline__ void operator()(const f32x4 (&acc)[2][2][4][2], const Unit& u, int wr, int wc, int fr, int fq) const {
        const int pn = u.pn, row0 = u.pm * BM + wr * 64 + fr;
        if (pn < 4) {
            bf16_t* base = pn < 2 ? CQ : CKV; float* ss = ssq + (pn < 2 ? 0 : MT);
            const int col0 = (pn & 1) * BM + wc * 32 + 8 * fq;
#pragma unroll
            for (int ai = 0; ai < 2; ++ai)
#pragma unroll
                for (int m = 0; m < 4; ++m) { const int row = row0 + ai * HALF + m * 16; bf16_t* rowp = base + (size_t)row * 512 + col0; float s = 0.f;
#pragma unroll
                    for (int bj = 0; bj < 2; ++bj) { const f32x4 v0 = acc[ai][bj][m][0], v1 = acc[ai][bj][m][1];
                        s += (v0[0] * v0[0] + v0[1] * v0[1]) + (v0[2] * v0[2] + v0[3] * v0[3]) + (v1[0] * v1[0] + v1[1] * v1[1]) + (v1[2] * v1[2] + v1[3] * v1[3]);
                        *(u32x4*)(rowp + bj * HALF) = pack8(v0, v1); }
                    s += __shfl_xor(s, 16); s += __shfl_xor(s, 32);
                    if (fq == 0) atomicAdd(ss + row, s); }
        } else if (pn < 12) {
            if (u.pm < ML / BM) {
                const int col0 = (pn - 4) * BM + wc * 32 + 8 * fq;
#pragma unroll
                for (int ai = 0; ai < 2; ++ai)
#pragma unroll
                    for (int m = 0; m < 4; ++m) { bf16_t* rowp = SG + (size_t)(row0 + ai * HALF + m * 16) * DM + col0;
#pragma unroll
                        for (int bj = 0; bj < 2; ++bj) *(u32x4*)(rowp + bj * HALF) = pack8(silu4(acc[ai][bj][m][0]), silu4(acc[ai][bj][m][1])); }
            }
        } else {
            if (wc < 2) {
                const bool lat = u.pm < ML / BM;
#pragma unroll
                for (int ai = 0; ai < 2; ++ai)
#pragma unroll
                    for (int m = 0; m < 4; ++m) { const int row = row0 + ai * HALF + m * 16;
                        f32x4 v0 = acc[ai][0][m][0], v1 = acc[ai][0][m][1];
                        if (lat) {
                            const int t = row & (SEQ - 1), pos = wc == 0 ? (t >> 6) : (t & 63);
                            const f32x2* tp = tab + pos * 16 + 8 * (fq & 1);
                            f32x4 p0, p1;
#pragma unroll
                            for (int j = 0; j < 4; ++j) { p0[j] = __shfl_xor(v0[j], 32); p1[j] = __shfl_xor(v1[j], 32); }
                            const bool first = fq < 2;
#pragma unroll
                            for (int j = 0; j < 4; ++j) { const f32x2 c0 = tp[j], c1 = tp[4 + j];
                                v0[j] = first ? (v0[j] * c0.x - p0[j] * c0.y) : (p0[j] * c0.y + v0[j] * c0.x);
                                v1[j] = first ? (v1[j] * c1.x - p1[j] * c1.y) : (p1[j] * c1.y + v1[j] * c1.x); }
                        }
                        *(u32x4*)(KR + (size_t)row * 64 + wc * 32 + 8 * fq) = pack8(v0, v1); }
            }
        }
    }
};
struct EpiQ {
    static constexpr bool PERM = true;
    bf16_t* Q; const float* ssq; const f32x2* tab;
    __device__ __forceinline__ void operator()(const f32x4 (&acc)[2][2][4][2], const Unit& u, int wr, int wc, int fr, int fq) const {
        const int row0 = u.pm * BM + wr * 64 + fr; const bool first = fq < 2;
#pragma unroll
        for (int ai = 0; ai < 2; ++ai)
#pragma unroll
            for (int m = 0; m < 4; ++m) { const int row = row0 + ai * HALF + m * 16; const float rs = __builtin_amdgcn_rsqf(ssq[row] * (1.f / 512.f) + EPS) * QSCALE; const int t = row & (SEQ - 1);
#pragma unroll
                for (int bj = 0; bj < 2; ++bj) { const int gcol = u.pn * 8 + bj * 4 + wc, hg = gcol % 6;
                    f32x4 v0 = acc[ai][bj][m][0] * rs, v1 = acc[ai][bj][m][1] * rs;
                    if (hg >= 4) { const int pos = hg == 4 ? (t >> 6) : (t & 63); const f32x2* tp = tab + pos * 16 + 8 * (fq & 1);
                        f32x4 p0, p1;
#pragma unroll
                        for (int j = 0; j < 4; ++j) { p0[j] = __shfl_xor(v0[j], 32); p1[j] = __shfl_xor(v1[j], 32); }
#pragma unroll
                        for (int j = 0; j < 4; ++j) { const f32x2 c0 = tp[j], c1 = tp[4 + j];
                            v0[j] = first ? (v0[j] * c0.x - p0[j] * c0.y) : (p0[j] * c0.y + v0[j] * c0.x);
                            v1[j] = first ? (v1[j] * c1.x - p1[j] * c1.y) : (p1[j] * c1.y + v1[j] * c1.x); } }
                    *(u32x4*)(Q + (size_t)row * 3072 + gcol * 32 + 8 * fq) = pack8(v0, v1); } }
    }
};
struct EpiKV {
    static constexpr bool PERM = true;
    bf16_t* KN; bf16_t* V; const float* ssq;
    __device__ __forceinline__ void operator()(const f32x4 (&acc)[2][2][4][2], const Unit& u, int wr, int wc, int fr, int fq) const {
        const int row0 = u.pm * BM + wr * 64 + fr, col0 = u.pn * 128 + wc * 32 + 8 * fq;
#pragma unroll
        for (int ai = 0; ai < 2; ++ai)
#pragma unroll
            for (int m = 0; m < 4; ++m) { const int row = row0 + ai * HALF + m * 16; const float rs = __builtin_amdgcn_rsqf(ssq[row] * (1.f / 512.f) + EPS);
                *(u32x4*)(KN + (size_t)row * DM + col0) = pack8(acc[ai][0][m][0] * rs, acc[ai][0][m][1] * rs);
                *(u32x4*)(V + (size_t)row * DM + col0) = pack8(acc[ai][1][m][0] * rs, acc[ai][1][m][1] * rs); }
    }
};
}

namespace att {
constexpr int NW = 8, QBLK = 32, KVBLK = 64, NT = (CTXL + SEQ) / KVBLK;
constexpr int SHM_V = KVBLK * 128 * 2, SHM_K = KVBLK * 192 * 2;
#ifndef ATT_NQREG
#define ATT_NQREG 12
#endif
constexpr int NQREG = ATT_NQREG, SHM_QR = (12 - NQREG) * 8192, SHM_ATTN = 3 * SHM_V + 3 * SHM_K + NW * 64 * 4 + SHM_QR + NW * 4096;
constexpr float THRL = 8.f * 1.4426950408889634f;
#define KSWZ(row, colB) ((row) * 384 + ((colB) ^ (((row) & 7) << 4)))
#define SBAR() __builtin_amdgcn_sched_barrier(0)
__device__ __forceinline__ int crow(int r, int hi) { return (r & 3) + 8 * (r >> 2) + 4 * hi; }
__device__ __forceinline__ void partialSM(f32x16& p0, f32x16& p1, float& m_reg, float& mn, float& alpha) {
  float pmax = p0[0];
#pragma unroll
  for (int r = 1; r < 16; ++r) pmax = fmaxf(pmax, p0[r]);
#pragma unroll
  for (int r = 0; r < 16; ++r) pmax = fmaxf(pmax, p1[r]);
  { auto rr = __builtin_amdgcn_permlane32_swap(__float_as_uint(pmax), __float_as_uint(pmax), false, false);
    pmax = fmaxf(__uint_as_float(rr[0]), __uint_as_float(rr[1])); }
  if (__builtin_expect(__all(pmax - m_reg <= THRL), 1)) { mn = m_reg; alpha = 1.f; }
  else { mn = fmaxf(m_reg, pmax); alpha = __builtin_amdgcn_exp2f(m_reg - mn); m_reg = mn; }
#pragma unroll
  for (int r = 0; r < 16; ++r) p0[r] = p0[r] - mn;
#pragma unroll
  for (int r = 0; r < 16; ++r) p1[r] = p1[r] - mn;
#pragma unroll
  for (int r = 0; r < 16; ++r) p0[r] = __builtin_amdgcn_exp2f(p0[r]);
}
__device__ __forceinline__ void finishSM(f32x16& p0, f32x16& p1, float alpha, float& l_reg, bf16x8& pa0, bf16x8& pa1, bf16x8& pa2, bf16x8& pa3) {
#pragma unroll
  for (int r = 0; r < 16; ++r) p1[r] = __builtin_amdgcn_exp2f(p1[r]);
  float ps = 0;
#pragma unroll
  for (int r = 0; r < 16; ++r) ps += p0[r];
#pragma unroll
  for (int r = 0; r < 16; ++r) ps += p1[r];
  { auto rr = __builtin_amdgcn_permlane32_swap(__float_as_uint(ps), __float_as_uint(ps), false, false);
    ps = __uint_as_float(rr[0]) + __uint_as_float(rr[1]); }
  l_reg = l_reg * alpha + ps;
#define PK4(P, BASE, OUT) do { unsigned a0 = cvt_pk_bf16(P[BASE + 0], P[BASE + 1]), a1 = cvt_pk_bf16(P[BASE + 2], P[BASE + 3]);   \
    unsigned b0 = cvt_pk_bf16(P[BASE + 4], P[BASE + 5]), b1 = cvt_pk_bf16(P[BASE + 6], P[BASE + 7]);                              \
    auto r0 = __builtin_amdgcn_permlane32_swap(a0, b0, false, false); auto r1 = __builtin_amdgcn_permlane32_swap(a1, b1, false, false); \
    u32x4 w = {r0[0], r1[0], r0[1], r1[1]}; OUT = *reinterpret_cast<bf16x8*>(&w); } while (0)
  PK4(p0, 0, pa0); PK4(p0, 8, pa1); PK4(p1, 0, pa2); PK4(p1, 8, pa3);
#undef PK4
}
__device__ __forceinline__ void qkt(f32x16& p0, f32x16& p1, const char* Ks, const bf16x8* qr, const char* Qr, int kbase) {
  p0 = f32x16{}; p1 = f32x16{};
  const char* kb = Ks + kbase;
  bf16x8 k0[4], k1[4];
#define KLD(d) do { k0[(d) % 4] = *reinterpret_cast<const bf16x8*>(kb + (d) * 512); k1[(d) % 4] = *reinterpret_cast<const bf16x8*>(kb + 12288 + (d) * 512); } while (0)
  KLD(0); KLD(1); KLD(2);
  __builtin_amdgcn_s_setprio(1);
#pragma unroll
  for (int d0 = 0; d0 < 12; ++d0) {
    if (d0 + 3 < 12) KLD(d0 + 3);
    const bf16x8 qf = d0 < NQREG ? qr[d0 < NQREG ? d0 : 0] : *reinterpret_cast<const bf16x8*>(Qr + (d0 - NQREG) * 8192);
    p0 = __builtin_amdgcn_mfma_f32_32x32x16_bf16(k0[d0 % 4], qf, p0, 0, 0, 0);
    p1 = __builtin_amdgcn_mfma_f32_32x32x16_bf16(k1[d0 % 4], qf, p1, 0, 0, 0);
    SBAR(); }
  __builtin_amdgcn_s_setprio(0);
#undef KLD
}
__device__ __forceinline__ int v_st(int k, int c) { const int kk = (k & ~0xC) | ((k & 4) << 1) | ((k & 8) >> 1); return ((kk >> 3) * 4 + (c >> 5)) * 512 + ((kk & 7) * 32 + (c & 31)) * 2; }
__device__ __forceinline__ int v_rd_base(int lane) { return ((lane & 3) << 3) | (((lane >> 2) & 3) << 6) | (((lane >> 4) & 1) << 5) | (((lane >> 5) & 1) << 8); }
constexpr int v_rd_off(int d0, int ks, int half) { return d0 * 512 + ks * 4096 + half * 2048; }
template <int OFF> __device__ __forceinline__ s16x4 tr_read(int vb) {
  s16x4 r; asm volatile("ds_read_b64_tr_b16 %0, %1 offset:%2" : "=&v"(r) : "v"(vb), "i"(OFF) : "memory"); return r;
}
struct VFrag { s16x4 l0, h0, l1, h1, l2, h2, l3, h3; };
template <int D0> __device__ __forceinline__ void v_read8(VFrag& f, int vb) {
  f.l0 = tr_read<v_rd_off(D0, 0, 0)>(vb); f.h0 = tr_read<v_rd_off(D0, 0, 1)>(vb); f.l1 = tr_read<v_rd_off(D0, 1, 0)>(vb); f.h1 = tr_read<v_rd_off(D0, 1, 1)>(vb);
  f.l2 = tr_read<v_rd_off(D0, 2, 0)>(vb); f.h2 = tr_read<v_rd_off(D0, 2, 1)>(vb); f.l3 = tr_read<v_rd_off(D0, 3, 0)>(vb); f.h3 = tr_read<v_rd_off(D0, 3, 1)>(vb);
}
__device__ __forceinline__ void pv_mma(f32x16& od, const VFrag& f, bf16x8 pa0, bf16x8 pa1, bf16x8 pa2, bf16x8 pa3) {
#define PK(L, H) (bf16x8){L[0], L[1], L[2], L[3], H[0], H[1], H[2], H[3]}
  od = __builtin_amdgcn_mfma_f32_32x32x16_bf16(pa0, PK(f.l0, f.h0), od, 0, 0, 0);
  od = __builtin_amdgcn_mfma_f32_32x32x16_bf16(pa1, PK(f.l1, f.h1), od, 0, 0, 0);
  od = __builtin_amdgcn_mfma_f32_32x32x16_bf16(pa2, PK(f.l2, f.h2), od, 0, 0, 0);
  od = __builtin_amdgcn_mfma_f32_32x32x16_bf16(pa3, PK(f.l3, f.h3), od, 0, 0, 0);
#undef PK
}
__device__ __forceinline__ void pv_d0(f32x16* o, int vb, bf16x8 pa0, bf16x8 pa1, bf16x8 pa2, bf16x8 pa3) {
  VFrag fa, fb;
  v_read8<0>(fa, vb); v_read8<1>(fb, vb);
  asm volatile("s_waitcnt lgkmcnt(8)" ::: "memory"); SBAR(); pv_mma(o[0], fa, pa0, pa1, pa2, pa3); SBAR();
  v_read8<2>(fa, vb);
  asm volatile("s_waitcnt lgkmcnt(8)" ::: "memory"); SBAR(); pv_mma(o[1], fb, pa0, pa1, pa2, pa3); SBAR();
  v_read8<3>(fb, vb);
  asm volatile("s_waitcnt lgkmcnt(8)" ::: "memory"); SBAR(); pv_mma(o[2], fa, pa0, pa1, pa2, pa3); SBAR();
  asm volatile("s_waitcnt lgkmcnt(0)" ::: "memory"); SBAR(); pv_mma(o[3], fb, pa0, pa1, pa2, pa3); SBAR();
}
__device__ __forceinline__ void qkt_pv(f32x16& p0, f32x16& p1, const char* Ks, const bf16x8* qr, const char* Qr, int kbase, f32x16* o, int vb, bf16x8 pa0, bf16x8 pa1, bf16x8 pa2, bf16x8 pa3) {
  p0 = f32x16{}; p1 = f32x16{};
  const char* kb = Ks + kbase;
  bf16x8 k0[4], k1[4]; VFrag fa, fb;
#define KLD(d) do { k0[(d) % 4] = *reinterpret_cast<const bf16x8*>(kb + (d) * 512); k1[(d) % 4] = *reinterpret_cast<const bf16x8*>(kb + 12288 + (d) * 512); } while (0)
  KLD(0); KLD(1); KLD(2);
  __builtin_amdgcn_s_setprio(1);
#pragma unroll
  for (int d0 = 0; d0 < 12; ++d0) {
    if (d0 + 3 < 12) KLD(d0 + 3);
    if (d0 == 10) v_read8<0>(fa, vb);
    const bf16x8 qf = d0 < NQREG ? qr[d0 < NQREG ? d0 : 0] : *reinterpret_cast<const bf16x8*>(Qr + (d0 - NQREG) * 8192);
    p0 = __builtin_amdgcn_mfma_f32_32x32x16_bf16(k0[d0 % 4], qf, p0, 0, 0, 0);
    p1 = __builtin_amdgcn_mfma_f32_32x32x16_bf16(k1[d0 % 4], qf, p1, 0, 0, 0);
    SBAR(); }
#undef KLD
  v_read8<1>(fb, vb);
  asm volatile("s_waitcnt lgkmcnt(8)" ::: "memory"); SBAR(); pv_mma(o[0], fa, pa0, pa1, pa2, pa3); SBAR();
  v_read8<2>(fa, vb);
  asm volatile("s_waitcnt lgkmcnt(8)" ::: "memory"); SBAR(); pv_mma(o[1], fb, pa0, pa1, pa2, pa3); SBAR();
  v_read8<3>(fb, vb);
  asm volatile("s_waitcnt lgkmcnt(8)" ::: "memory"); SBAR(); pv_mma(o[2], fa, pa0, pa1, pa2, pa3); SBAR();
  asm volatile("s_waitcnt lgkmcnt(0)" ::: "memory"); SBAR(); pv_mma(o[3], fb, pa0, pa1, pa2, pa3); SBAR();
  __builtin_amdgcn_s_setprio(0);
}
constexpr int SLOT_K = SHM_K, SLOT_V = SHM_V, RING_BYTES = 3 * (SLOT_K + SLOT_V);
constexpr int NUNITS = NB * 16 * (SEQ / 256);
__device__ __forceinline__ void attn_phase(const bf16_t* __restrict__ Q, const bf16_t* __restrict__ KN, const bf16_t* __restrict__ KR, const bf16_t* __restrict__ V,
                                           const bf16_t* __restrict__ SG, bf16_t* __restrict__ Z, int vcu, int G, char* lds, LAS unsigned char* ldsl) {
  const int tid = threadIdx.x, wid = __builtin_amdgcn_readfirstlane(tid >> 6), lane = tid & 63, r32 = lane & 31, hi = lane >> 5;
  char* K_lds = lds; char* V_lds = lds + 3 * SLOT_K;
  float* wsf = (float*)(lds + RING_BYTES) + wid * 64; float* li_l = wsf; float* al_l = wsf + 32;
  char* Qr = lds + RING_BYTES + NW * 64 * 4 + tid * 16;
  const int vb0 = (int)(uintptr_t)V_lds + v_rd_base(lane);
  const int kbase = ((r32 >> 4) * 384 + (r32 & 15)) * 16 + hi * 256;
  int kofs[6], vofs[4]; bool krope[6];
  const int wq = wid & 3;
#pragma unroll
  for (int i = 0; i < 6; ++i) { const int p = 6 * wq + i, row = (p / 6) * 16 + (lane & 15), chunk = 4 * (p % 6) + (lane >> 4);
    krope[i] = chunk >= 16; kofs[i] = krope[i] ? row * 128 + (chunk - 16) * 16 : row * 4096 + chunk * 16; }
#pragma unroll
  for (int i = 0; i < 4; ++i) { const int B = (4 * wq + i) * 1024 + lane * 16, sub = B >> 9, within = (B & 511) >> 1, kk = (sub >> 2) * 8 + (within >> 5);
    const int k = (kk & ~0xC) | ((kk & 4) << 1) | ((kk & 8) >> 1), c = (sub & 3) * 32 + (within & 31); vofs[i] = k * 4096 + c * 2; }
#define KROW(j, b_) ((j) < 4 ? ML + (b_) * CTXL + (j) * KVBLK : (b_) * SEQ + ((j) - 4) * KVBLK)
#define DMA_K(j, b_, h_, slot) do { const int rb_ = KROW(j, b_); \
    const char* kn_ = (const char*)KN + (size_t)rb_ * 4096 + (h_) * 256; const char* kr_ = (const char*)KR + (size_t)rb_ * 128; \
    _Pragma("unroll") for (int i_ = 0; i_ < 6; ++i_) __builtin_amdgcn_global_load_lds((const unsigned*)((krope[i_] ? kr_ : kn_) + kofs[i_]), (LAS unsigned*)(ldsl + (slot) * SLOT_K + (6 * wq + i_) * 1024), 16, 0, 0); } while (0)
#define DMA_V(j, b_, h_, slot) do { const int rb_ = KROW(j, b_); const char* v_ = (const char*)V + (size_t)rb_ * 4096 + (h_) * 256; \
    _Pragma("unroll") for (int i_ = 0; i_ < 4; ++i_) __builtin_amdgcn_global_load_lds((const unsigned*)(v_ + vofs[i_]), (LAS unsigned*)(ldsl + 3 * SLOT_K + (slot) * SLOT_V + (4 * wq + i_) * 1024), 16, 0, 0); } while (0)
#define TILE_SYNC() do { asm volatile("s_waitcnt vmcnt(0)" ::: "memory"); __syncthreads(); } while (0)
#define RESC(a) do { if (__any((a) < 1.f)) { if (hi == 0) al_l[r32] = (a); asm volatile("s_waitcnt lgkmcnt(0)" ::: "memory"); \
    _Pragma("unroll") for (int d = 0; d < 4; ++d) _Pragma("unroll") for (int r = 0; r < 16; ++r) o[d][r] *= al_l[crow(r, hi)]; } } while (0)
  const int half = wid >> 2;
  const int nun_wg = vcu < NUNITS ? (NUNITS - 1 - vcu) / G + 1 : 0, T = nun_wg * NT;
#define ABAR() do { asm volatile("s_waitcnt lgkmcnt(0)" ::: "memory"); __builtin_amdgcn_s_barrier(); asm volatile("" ::: "memory"); } while (0)
#define VWAIT() asm volatile("s_waitcnt vmcnt(0)" ::: "memory")
#define DMA_TK(t_) do { const int ui_ = (t_) / NT, j_ = (t_) - ui_ * NT, un_ = vcu + ui_ * G; DMA_K(j_, (un_ >> 7), ((un_ >> 3) & 15), ((t_) % 3)); } while (0)
#define DMA_TV(t_) do { const int ui_ = (t_) / NT, j_ = (t_) - ui_ * NT, un_ = vcu + ui_ * G; DMA_V(j_, (un_ >> 7), ((un_ >> 3) & 15), ((t_) % 3)); } while (0)
#define LOADQ(un_) do { const int qb_ = (un_) & 7, h_ = ((un_) >> 3) & 15, b_ = (un_) >> 7; const bf16_t* Qw = Q + (size_t)(b_ * SEQ + qb_ * 256 + wid * QBLK + r32) * 3072 + h_ * 192 + hi * 8; \
    _Pragma("unroll") for (int d0 = 0; d0 < NQREG; ++d0) qr[d0] = *reinterpret_cast<const bf16x8*>(Qw + d0 * 16); \
    _Pragma("unroll") for (int d0 = NQREG; d0 < 12; ++d0) *reinterpret_cast<bf16x8*>(Qr + (d0 - NQREG) * 8192) = *reinterpret_cast<const bf16x8*>(Qw + d0 * 16); } while (0)
#define EPI_PREFETCH(un_) do { const int qb_ = (un_) & 7, h_ = ((un_) >> 3) & 15, b_ = (un_) >> 7; \
    const size_t ob = (size_t)(b_ * SEQ + qb_ * 256 + wid * QBLK + (lane >> 3)) * DM + h_ * 128 + (lane & 7) * 8; \
    _Pragma("unroll") for (int hf = 0; hf < 2; ++hf) _Pragma("unroll") for (int i4 = 0; i4 < 4; ++i4) gv[hf][i4] = *(const u32x4*)(SG + ob + (size_t)(i4 * 8) * DM + hf * 64); } while (0)
#define EPILOGUE(un_) do { const int qb_ = (un_) & 7, h_ = ((un_) >> 3) & 15, b_ = (un_) >> 7; \
    if (hi == 0) li_l[r32] = l_reg; asm volatile("s_waitcnt lgkmcnt(0)" ::: "memory"); \
    const size_t ob = (size_t)(b_ * SEQ + qb_ * 256 + wid * QBLK + (lane >> 3)) * DM + h_ * 128 + (lane & 7) * 8; \
    _Pragma("unroll") for (int hf = 0; hf < 2; ++hf) { \
      _Pragma("unroll") for (int r = 0; r < 16; ++r) { const float rl = __builtin_amdgcn_rcpf(li_l[crow(r, hi)]); \
        _Pragma("unroll") for (int dd = 0; dd < 2; ++dd) epi[crow(r, hi) * 64 + dd * 32 + r32] = (bf16_t)(cvt_pk_bf16(o[hf * 2 + dd][r] * rl, 0.f) & 0xffffu); } \
      asm volatile("s_waitcnt lgkmcnt(0)" ::: "memory"); \
      _Pragma("unroll") for (int i4 = 0; i4 < 4; ++i4) { const u32x4 ov = *(const u32x4*)(epi + (i4 * 8 + (lane >> 3)) * 64 + (lane & 7) * 8); \
        const size_t gi = ob + (size_t)(i4 * 8) * DM + hf * 64; const u32x4 gvv = gv[hf][i4]; u32x4 zv; \
        zv.x = cvt_pk_bf16(bf_lo(ov.x) * bf_lo(gvv.x), bf_hi(ov.x) * bf_hi(gvv.x)); zv.y = cvt_pk_bf16(bf_lo(ov.y) * bf_lo(gvv.y), bf_hi(ov.y) * bf_hi(gvv.y)); \
        zv.z = cvt_pk_bf16(bf_lo(ov.z) * bf_lo(gvv.z), bf_hi(ov.z) * bf_hi(gvv.z)); zv.w = cvt_pk_bf16(bf_lo(ov.w) * bf_lo(gvv.w), bf_hi(ov.w) * bf_hi(gvv.w)); \
        *(u32x4*)(Z + gi) = zv; } \
      asm volatile("s_waitcnt lgkmcnt(0)" ::: "memory"); } } while (0)
  bf16_t* epi = (bf16_t*)(lds + RING_BYTES + NW * 64 * 4 + SHM_QR + wid * 4096);
  if (T > 0) {
    float m_reg = -1e30f, l_reg = 0, mn, al; f32x16 o[4] = {}; bf16x8 qr[NQREG]; f32x16 p0, p1; bf16x8 pa0, pa1, pa2, pa3; u32x4 gv[2][4];
    if (half == 1) { DMA_TK(0); DMA_TK(1); } else { DMA_TV(0); DMA_TV(1); }
    LOADQ(vcu);
    VWAIT(); __syncthreads();
    if (half == 1) ABAR();
    int slot = 0, pslot = 2, t = 0;
#define SEG_S() do { const bool vis_ = (half == 0) && t >= 1 && t + 1 < T; \
      if (half == 1) { if (t + 2 < T) DMA_TK(t + 2); } else if (vis_) DMA_TV(t + 1); \
      partialSM(p0, p1, m_reg, mn, al); RESC(al); finishSM(p0, p1, al, l_reg, pa0, pa1, pa2, pa3); \
      if (half == 0) { if (vis_) asm volatile("s_waitcnt vmcnt(4)" ::: "memory"); else VWAIT(); } \
      SBAR(); ABAR(); pslot = slot; slot = slot == 2 ? 0 : slot + 1; ++t; } while (0)
    for (int ui = 0; ui < nun_wg; ++ui) {
      SBAR();
      if (ui > 0) {
        EPI_PREFETCH(vcu + (ui - 1) * G);
        pv_d0(o, vb0 + pslot * SLOT_V, pa0, pa1, pa2, pa3);
        EPILOGUE(vcu + (ui - 1) * G);
        m_reg = -1e30f; l_reg = 0;
#pragma unroll
        for (int d = 0; d < 4; ++d) o[d] = f32x16{};
      }
      qkt(p0, p1, K_lds + slot * SLOT_K, qr, Qr, kbase);
      if (half == 1) VWAIT();
      SBAR(); ABAR();
      SEG_S();
      for (int j = 1; j < NT; ++j) {
        SBAR();
        qkt_pv(p0, p1, K_lds + slot * SLOT_K, qr, Qr, kbase, o, vb0 + pslot * SLOT_V, pa0, pa1, pa2, pa3);
        if (j == NT - 1 && ui + 1 < nun_wg) LOADQ(vcu + (ui + 1) * G);
        if (half == 1) VWAIT();
        SBAR(); ABAR();
        SEG_S();
      }
    }
#undef SEG_S
    EPI_PREFETCH(vcu + (nun_wg - 1) * G);
    pv_d0(o, vb0 + pslot * SLOT_V, pa0, pa1, pa2, pa3);
    EPILOGUE(vcu + (nun_wg - 1) * G);
    if (half == 0) ABAR();
  }
  asm volatile("s_waitcnt vmcnt(0)" ::: "memory"); __syncthreads();
#undef ABAR
#undef VWAIT
#undef DMA_TK
#undef DMA_TV
#undef LOADQ
#undef EPILOGUE
#undef EPI_PREFETCH
#undef KROW
#undef DMA_K
#undef DMA_V
#undef TILE_SYNC
#undef RESC
}
}


#define XB_TMO      128
#define XB_XCNT(j)  (256  + 64 * (j))
#define XB_XSUB(j)  (1280 + 64 * (j))
#define XB_XGEN(j)  (2304 + 64 * (j))
#define XB_TOP      3328
#define XB_TOPGEN   3392
#define XCD_BAR_WORDS 3456
#define XB_SPIN_CAP (1u << 22)
__device__ __forceinline__ unsigned xb_ld(unsigned* p)              { return __hip_atomic_load(p, __ATOMIC_RELAXED, __HIP_MEMORY_SCOPE_AGENT); }
__device__ __forceinline__ unsigned xb_add(unsigned* p, unsigned v) { return __hip_atomic_fetch_add(p, v, __ATOMIC_RELAXED, __HIP_MEMORY_SCOPE_AGENT); }
__device__ __forceinline__ unsigned xb_xcc_id() { return (unsigned)__builtin_amdgcn_s_getreg((3 << 11) | 20) & 0xFu; }
#define XB_SPIN(cond, bar) do { unsigned _sp = 0; while (cond) { __builtin_amdgcn_s_sleep(1); \
    if ((++_sp & 255u) == 0u) { if (xb_ld(&(bar)[XB_TMO])) break; if (_sp > XB_SPIN_CAP) { atomicAdd(&(bar)[XB_TMO], 1u); break; } } } } while (0)
struct XcdBarrier { unsigned* bar; unsigned x; volatile LAS unsigned* st; };
__device__ __forceinline__ XcdBarrier xcd_barrier_post(unsigned* bar, volatile LAS unsigned* st) {
    XcdBarrier b; b.bar = bar; b.x = xb_xcc_id(); b.st = st;
    if (threadIdx.x == 0) (void)xb_add(&bar[XB_XCNT(b.x)], 1u);
    return b;
}
__device__ __forceinline__ void xcd_barrier_complete(unsigned* bar, unsigned x, unsigned& nloc, unsigned& nx) {
    const unsigned G = gridDim.x;
    unsigned sum, cnt, mine, sp = 0u;
    for (;;) {
        sum = 0u; cnt = 0u; mine = 0u;
#pragma unroll
        for (unsigned j = 0; j < 16; ++j) { const unsigned c = xb_ld(&bar[XB_XCNT(j)]); sum += c; cnt += (c > 0u) ? 1u : 0u; mine = (j == x) ? c : mine; }
        if (sum == G) break;
        __builtin_amdgcn_s_sleep(1);
        if ((++sp & 255u) == 0u) { if (xb_ld(&bar[XB_TMO])) break; if (sp > XB_SPIN_CAP) { atomicAdd(&bar[XB_TMO], 1u); break; } }
    }
    nloc = mine > 0u ? mine : 1u; nx = cnt > 0u ? cnt : 1u;
}
__device__ __forceinline__ void xcd_barrier(const XcdBarrier& b) {
    asm volatile("s_waitcnt vmcnt(0)" ::: "memory");
    __syncthreads();
    if (threadIdx.x == 0) {
        unsigned* bar = b.bar;
        __builtin_amdgcn_s_waitcnt(0);
        unsigned nloc = b.st[0], nx = b.st[1];
        if (nloc == 0u) { xcd_barrier_complete(bar, b.x, nloc, nx); b.st[0] = nloc; b.st[1] = nx; }
        const unsigned old = xb_add(&bar[XB_XSUB(b.x)], 1u);
        const unsigned gen = old / nloc;
        if (old + 1u == (gen + 1u) * nloc) {
            __builtin_amdgcn_fence(__ATOMIC_RELEASE, "agent");
            asm volatile("s_waitcnt vmcnt(0)" ::: "memory");
            const unsigned og = xb_add(&bar[XB_TOP], 1u);
            const unsigned tg = og / nx;
            if (og + 1u == (tg + 1u) * nx) xb_add(&bar[XB_TOPGEN], 1u);
            else XB_SPIN(xb_ld(&bar[XB_TOPGEN]) == tg, bar);
            __builtin_amdgcn_fence(__ATOMIC_ACQUIRE, "agent");
            xb_add(&bar[XB_XGEN(b.x)], 1u);
            asm volatile("s_waitcnt vmcnt(0)" ::: "memory");
        } else {
            XB_SPIN(xb_ld(&bar[XB_XGEN(b.x)]) == gen, bar);
            __builtin_amdgcn_fence(__ATOMIC_ACQUIRE, "agent");
            asm volatile("s_waitcnt vmcnt(0)" ::: "memory");
        }
    }
    __syncthreads();
}
constexpr int NWAVES = 8;
constexpr int LDS_BYTES = 163840;
constexpr int N_PHASES = 12;
constexpr int MISC_OFF = 163840 - 256; static_assert(att::SHM_ATTN <= MISC_OFF, "LDS map");


struct Frame {
    LAS unsigned char* lds;
    int tid, lane, wave, gw, NGW, G;
    unsigned char* ws;
};

struct Args { const float* in[19]; float* out; unsigned char* ws; int ph_lo, ph_hi; };
struct TrDesc { const float* W; bf16_t* WT; const float* gk; int K, N, item; bool reorder; };
__device__ __forceinline__ void tr_load(const TrDesc& d, int lane, f32x4 (&wv)[8]) {
    const int nblk = d.N / 32, kb = d.item / nblk, nb = d.item % nblk, k0 = 64 * kb, n0 = 32 * nb;
#pragma unroll
    for (int i = 0; i < 8; ++i) wv[i] = *(const f32x4*)(d.W + (size_t)(k0 + 8 * i + (lane >> 3)) * d.N + n0 + (lane & 7) * 4);
}
__device__ __forceinline__ void tr_finish(const TrDesc& d, int lane, const f32x4 (&wv)[8], LAS float* scr) {
    const int nblk = d.N / 32, kb = d.item / nblk, nb = d.item % nblk, k0 = 64 * kb, n0 = 32 * nb;
    const int d0 = d.reorder ? (nb < 32 ? n0 : (nb < 34 ? n0 + 2048 : n0 - 64)) : n0;
#pragma unroll
    for (int i = 0; i < 8; ++i) { const int kk = 8 * i + (lane >> 3); f32x4 v = wv[i]; if (d.gk) v = v * d.gk[k0 + kk];
        LAS float* p = scr + kk * 33 + (lane & 7) * 4; p[0] = v[0]; p[1] = v[1]; p[2] = v[2]; p[3] = v[3]; }
    asm volatile("s_waitcnt lgkmcnt(0)" ::: "memory");
    const int c = lane & 7;
#pragma unroll
    for (int j = 0; j < 4; ++j) { const int n = (lane >> 3) + 8 * j; const LAS float* sp = scr + (8 * c) * 33 + n;
        u32x4 o; o.x = cvt_pk_bf16(sp[0 * 33], sp[1 * 33]); o.y = cvt_pk_bf16(sp[2 * 33], sp[3 * 33]); o.z = cvt_pk_bf16(sp[4 * 33], sp[5 * 33]); o.w = cvt_pk_bf16(sp[6 * 33], sp[7 * 33]);
        *(u32x4*)(d.WT + (size_t)(d0 + n) * d.K + k0 + 8 * c) = o; }
    asm volatile("s_waitcnt lgkmcnt(0)" ::: "memory");
}
constexpr int I_WIN = 32 * 128, I_WG = 4 * 8 * 16, I_WOUT = 32 * 64, I_WMLA = 32 * 98, I_WUQ = 8 * 96, I_WUKV = 8 * 128, I_WMO = 32 * 64;
constexpr int I_LIST0 = I_WIN + I_WG + I_WOUT, I_LIST1 = I_WMLA + I_WUQ + I_WUKV, I_LIST2 = I_WMO;
__device__ __forceinline__ TrDesc tr_desc(const Args& a, int list, int r) {
    unsigned char* ws = a.ws; TrDesc d; d.gk = nullptr; d.reorder = false;
    if (list == 0) {
        if (r < I_WIN) { d.W = a.in[8]; d.WT = (bf16_t*)(ws + WS_WIN); d.K = DM; d.N = 4096; d.item = r; return d; } r -= I_WIN;
        if (r < I_WG) { const int g = r / 128; d.W = a.in[9] + (size_t)g * 512 * 512; d.WT = (bf16_t*)(ws + WS_WG) + (size_t)g * 512 * 512; d.K = 512; d.N = 512; d.item = r % 128; return d; } r -= I_WG;
        d.W = a.in[12]; d.WT = (bf16_t*)(ws + WS_WOUT); d.K = DM; d.N = DM; d.item = r; return d;
    }
    if (list == 1) {
    if (r < I_WMLA) { d.W = a.in[13]; d.WT = (bf16_t*)(ws + WS_WMLA); d.K = DM; d.N = 3136; d.item = r; d.reorder = true; return d; } r -= I_WMLA;
    if (r < I_WUQ) { d.W = a.in[16]; d.WT = (bf16_t*)(ws + WS_WUQ); d.K = 512; d.N = 3072; d.item = r; d.gk = a.in[14]; return d; } r -= I_WUQ;
    { d.W = a.in[17]; d.WT = (bf16_t*)(ws + WS_WUKV); d.K = 512; d.N = 4096; d.item = r; d.gk = a.in[15]; return d; } }
    d.W = a.in[18]; d.WT = (bf16_t*)(ws + WS_WMO); d.K = DM; d.N = DM; d.item = r; return d;
}
__device__ __forceinline__ void tr_run(const Args& a, int list, int first, int stride, int lane, LAS float* scr, int n_end = -1) {
    const int n = n_end >= 0 ? n_end : (list == 0 ? I_LIST0 : (list == 1 ? I_LIST1 : I_LIST2));
    int it = first; if (it >= n) return;
    TrDesc d = tr_desc(a, list, it); f32x4 wv[8]; tr_load(d, lane, wv);
    for (;;) {
        const int nit = it + stride; const bool more = nit < n;
        TrDesc dn = d; f32x4 wn[8];
        if (more) { dn = tr_desc(a, list, nit); tr_load(dn, lane, wn); }
        tr_finish(d, lane, wv, scr);
        if (!more) break;
#pragma unroll
        for (int i = 0; i < 8; ++i) wv[i] = wn[i];
        d = dn; it = nit;
    }
}

__device__ __forceinline__ void gemv_item(const float* c, const float* c_ctx, const float* ada_w, const float* ada_b, float* mod, int it, int lane) {
    const int l = it / 768, rem = it % 768, kc = rem / 24, cgp = rem % 24, k0 = kc * 64;
    float s[9];
#pragma unroll
    for (int r = 0; r < 8; ++r) s[r] = silu_f(c[r * DM + k0 + lane]);
    s[8] = silu_f(c_ctx[k0 + lane]);
    const float* W = ada_w + (size_t)l * DM * 6144 + (size_t)k0 * 6144 + cgp * 256 + lane * 4;
    f32x4 acc[9];
#pragma unroll
    for (int r = 0; r < 9; ++r) acc[r] = (f32x4){0.f, 0.f, 0.f, 0.f};
#pragma unroll 16
    for (int kk = 0; kk < 64; ++kk) { const f32x4 w = *(const f32x4*)(W + (size_t)kk * 6144);
#pragma unroll
        for (int r = 0; r < 9; ++r) { const float sk = __uint_as_float(__builtin_amdgcn_readlane(__float_as_uint(s[r]), kk)); acc[r] += w * sk; } }
    const int col = cgp * 256 + lane * 4;
    f32x4 bv = (f32x4){0.f, 0.f, 0.f, 0.f};
    if (kc == 0) bv = *(const f32x4*)(ada_b + l * 6144 + col);
#pragma unroll
    for (int r = 0; r < 9; ++r) { float* m = mod + (size_t)(l * 9 + r) * 6144 + col;
#pragma unroll
        for (int j = 0; j < 4; ++j) atomicAdd(m + j, acc[r][j] + bv[j]); }
}

__device__ __forceinline__ void load_row_f32(const float* p, int lane, f32x4 (&v)[8]) {
#pragma unroll
    for (int j = 0; j < 8; ++j) v[j] = *(const f32x4*)(p + 4 * lane + 256 * j);
}
__device__ __forceinline__ float sumsq8(const f32x4 (&v)[8]) {
    float s = 0.f;
#pragma unroll
    for (int j = 0; j < 8; ++j) s += (v[j][0] * v[j][0] + v[j][1] * v[j][1]) + (v[j][2] * v[j][2] + v[j][3] * v[j][3]);
    return wave_sum(s);
}
__device__ __forceinline__ void modulate_store(const f32x4 (&v)[8], float rstd, const float* pn, const float* modr, bf16_t* orow, int lane) {
#pragma unroll
    for (int j = 0; j < 8; ++j) { const int col = 4 * lane + 256 * j;
        const f32x4 g = *(const f32x4*)(pn + col), sh = *(const f32x4*)(modr + col), sc = *(const f32x4*)(modr + DM + col);
        const f32x4 hh = v[j] * rstd * g * (sc + 1.f) + sh;
        u32x2 w; w.x = cvt_pk_bf16(hh[0], hh[1]); w.y = cvt_pk_bf16(hh[2], hh[3]);
        *(u32x2*)(orow + col) = w; }
}


template <int WIN> __device__ __forceinline__ void pool_chunk(const bf16_t* Ub, bf16_t* Pb, int t0, int L) {
    constexpr int LEFT = WIN / 2, RIGHT = WIN - 1 - LEFT, NR = 8 + WIN - 1;
    u32x4 rw[NR];
#pragma unroll
    for (int k = 0; k < NR; ++k) { const int t = t0 - LEFT + k; rw[k] = (t >= 0 && t < L) ? *(const u32x4*)(Ub + (size_t)t * DM) : (u32x4){0u, 0u, 0u, 0u}; }
    float S8[8];
#pragma unroll
    for (int e = 0; e < 8; ++e) S8[e] = 0.f;
#define ACC8(q_, sgn) do { const u32x4 a_ = (q_); S8[0] += sgn bf_lo(a_.x); S8[1] += sgn bf_hi(a_.x); S8[2] += sgn bf_lo(a_.y); S8[3] += sgn bf_hi(a_.y); \
                          S8[4] += sgn bf_lo(a_.z); S8[5] += sgn bf_hi(a_.z); S8[6] += sgn bf_lo(a_.w); S8[7] += sgn bf_hi(a_.w); } while (0)
#pragma unroll
    for (int k = 0; k < WIN; ++k) ACC8(rw[k], +);
#pragma unroll
    for (int i = 0; i < 8; ++i) { const int t = t0 + i; const int lo_ = t - LEFT < 0 ? 0 : t - LEFT, hi_ = t + RIGHT + 1 > L ? L : t + RIGHT + 1;
        const float inv = 1.f / (float)(hi_ - lo_); const u32x4 w = rw[i + LEFT];
        u32x4 o; o.x = cvt_pk_bf16(S8[0] * inv - bf_lo(w.x), S8[1] * inv - bf_hi(w.x)); o.y = cvt_pk_bf16(S8[2] * inv - bf_lo(w.y), S8[3] * inv - bf_hi(w.y));
        o.z = cvt_pk_bf16(S8[4] * inv - bf_lo(w.z), S8[5] * inv - bf_hi(w.z)); o.w = cvt_pk_bf16(S8[6] * inv - bf_lo(w.w), S8[7] * inv - bf_hi(w.w));
        *(u32x4*)(Pb + (size_t)t * DM) = o;
        if (i < 7) { ACC8(rw[i + WIN], +); ACC8(rw[i], -); } }
#undef ACC8
}

__global__ void __launch_bounds__(NWAVES * 64, 2) mk_fwd(Args args) {
    extern __shared__ __attribute__((aligned(16))) unsigned char lds[];
    cg::grid_group grid = cg::this_grid();
    Frame F;
    F.lds = (LAS unsigned char*)lds;
    F.tid = threadIdx.x; F.lane = F.tid & 63; F.wave = __builtin_amdgcn_readfirstlane(F.tid >> 6);
    F.G = gridDim.x; F.gw = blockIdx.x * NWAVES + F.wave; F.NGW = F.G * NWAVES; F.ws = args.ws;
    unsigned char* ws = args.ws;
    const int lo = args.ph_lo, hi = args.ph_hi;
#ifndef PHASE_MASK
#define PHASE_MASK 0xFFF
#endif
#define IN(k) (((PHASE_MASK >> (k)) & 1) && lo <= (k) && (k) < hi)
#ifndef DBL_MASK
#define DBL_MASK 0
#endif

#define SEAM(k) do { if (IN(k) && IN((k) + 1)) xcd_barrier(bar); } while (0)
    if (args.ph_hi > 4096) grid.sync();
    volatile LAS unsigned* MISC = (volatile LAS unsigned*)(F.lds + MISC_OFF);
    if (F.tid < 16) MISC[F.tid] = 0u;
    __syncthreads();
    XcdBarrier bar; bar.bar = (unsigned*)(args.ws + WS_BAR); bar.x = 0; bar.st = MISC;
    if (hi - lo > 1) bar = xcd_barrier_post((unsigned*)(args.ws + WS_BAR), MISC);
    const float* x = args.in[0]; const float* c = args.in[1]; const float* ctx = args.in[2]; const float* c_ctx = args.in[3];
    const float* ada_w = args.in[4]; const float* ada_b = args.in[5]; const float* pre_norm = args.in[6]; const float* post_norm = args.in[7];
    float* mod = (float*)(ws + WS_MOD); float* ssq = (float*)(ws + WS_SSQ); f32x2* tab = (f32x2*)(ws + WS_TAB);
    bf16_t* WIN = (bf16_t*)(ws + WS_WIN); bf16_t* WG = (bf16_t*)(ws + WS_WG); bf16_t* WOUT = (bf16_t*)(ws + WS_WOUT); bf16_t* WMLA = (bf16_t*)(ws + WS_WMLA);
    bf16_t* WUQ = (bf16_t*)(ws + WS_WUQ); bf16_t* WUKV = (bf16_t*)(ws + WS_WUKV); bf16_t* WMO = (bf16_t*)(ws + WS_WMO);
    bf16_t* H = (bf16_t*)(ws + WS_H); bf16_t* SG = (bf16_t*)(ws + WS_SG); bf16_t* Z = (bf16_t*)(ws + WS_Z); bf16_t* Y = (bf16_t*)(ws + WS_Y);
    bf16_t* U = (bf16_t*)(ws + WS_U); bf16_t* P = (bf16_t*)(ws + WS_P); bf16_t* Q = (bf16_t*)(ws + WS_Q); bf16_t* CQ = (bf16_t*)(ws + WS_CQ);
    bf16_t* CKV = (bf16_t*)(ws + WS_CKV); bf16_t* KR = (bf16_t*)(ws + WS_KR); bf16_t* KN = (bf16_t*)(ws + WS_KN); bf16_t* V = (bf16_t*)(ws + WS_V);
    const int NTHR = F.G * NWAVES * 64;
#define FRESH() int gtid; do { int t_ = threadIdx.x; asm volatile("" : "+v"(t_)); F.tid = t_; F.lane = t_ & 63; gtid = blockIdx.x * (NWAVES * 64) + t_; (void)gtid; } while (0)

    if (IN(0)) { FRESH();
        LAS float* scr = (LAS float*)(F.lds + F.wave * 16384);
        constexpr int I_GEMV = 2 * 32 * 24;
        if (F.G == 256) {
            if (F.wave < 3) gemv_item(c, c_ctx, ada_w, ada_b, mod, (int)blockIdx.x * 3 + F.wave, F.lane);
            const int b0 = (int)blockIdx.x * 26 + (F.wave < 3 ? F.wave * 2 : 6 + (F.wave - 3) * 4);
            tr_run(args, 0, b0, 1, F.lane, scr, b0 + (F.wave < 3 ? 2 : 4));
        } else {
            for (int it = F.gw; it < I_GEMV; it += F.NGW) gemv_item(c, c_ctx, ada_w, ada_b, mod, it, F.lane);
            tr_run(args, 0, F.gw, F.NGW, F.lane, scr); tr_run(args, 1, F.gw, F.NGW, F.lane, scr); tr_run(args, 2, F.gw, F.NGW, F.lane, scr);
        }
        for (int i = gtid; i < (NMLA - 3136) * DM / 8; i += NTHR) *(u32x4*)(WMLA + (size_t)3136 * DM + (size_t)i * 8) = (u32x4){0u, 0u, 0u, 0u};
        if (gtid < 1024) { const int pos = gtid >> 4, i = gtid & 15; const float fr = powf(10000.f, -(float)i / 16.f); const float ang = (float)pos * fr; float sn, cs; sincosf(ang, &sn, &cs); tab[gtid] = (f32x2){cs, sn}; }
    }
    SEAM(0);
    if (IN(1)) { FRESH();
        for (int row0 = F.gw * 3; row0 < MT; row0 += F.NGW * 3) {
            f32x4 v[3][8];
#pragma unroll
            for (int q = 0; q < 3; ++q) { const int row = row0 + q; const float* src = row < ML ? x + (size_t)row * DM : ctx + (size_t)(row - ML) * DM; load_row_f32(src, F.lane, v[q]); }
#pragma unroll
            for (int q = 0; q < 3; ++q) { const int row = row0 + q; const int r = row < ML ? row / SEQ : 8;
                const float rstd = __builtin_amdgcn_rsqf(sumsq8(v[q]) * (1.f / DM) + EPS);
                modulate_store(v[q], rstd, pre_norm, mod + (size_t)r * 6144, H + (size_t)row * DM, F.lane); }
        }
    }
    SEAM(1);
    if (IN(2)) {
        pg8::Gemm g{H, WIN, MT, 4096, DM, DM, DM, 0}; pg8::StaticOrder S; S.init(MT, 4096, F.G, (int)blockIdx.x);
        pg8::EpiPoolIn E{U, SG};
        pg8::gemm_phase<pg8::EpiPoolIn>(F.lds, g, S, E);
        if (F.G == 256 && (int)blockIdx.x >= 128)
            tr_run(args, 1, ((int)blockIdx.x - 128) * NWAVES + F.wave, 128 * NWAVES, threadIdx.x & 63, (LAS float*)(F.lds + F.wave * 16384));
    }
    SEAM(2);
    if (IN(3)) { FRESH();
        for (int item = gtid; item < (MT / 8) * 256; item += NTHR) {
            const int cc = item & 255, row0 = (item >> 8) * 8;
            int base, L; if (row0 < ML) { base = row0 & ~(SEQ - 1); L = SEQ; } else { base = ML + ((row0 - ML) & ~(CTXL - 1)); L = CTXL; }
            const int t0 = row0 - base, gidx = cc >> 6;
            const bf16_t* Ub = U + (size_t)base * DM + cc * 8; bf16_t* Pb = P + (size_t)base * DM + cc * 8;
            switch (gidx) {
                case 0: pool_chunk<2>(Ub, Pb, t0, L); break;
                case 1: pool_chunk<4>(Ub, Pb, t0, L); break;
                case 2: pool_chunk<8>(Ub, Pb, t0, L); break;
                default: pool_chunk<16>(Ub, Pb, t0, L); break;
            }
        }
    }
    SEAM(3);
    if (IN(4)) {
        pg8::Gemm g{P, WG, MT, DM, 512, DM, 512, 2}; pg8::StaticOrder S; S.init(MT, DM, F.G, (int)blockIdx.x);
        pg8::EpiGrp E{SG, Z, args.in[10], args.in[11]};
        pg8::gemm_phase<pg8::EpiGrp>(F.lds, g, S, E);
    }
    SEAM(4);
    if (IN(5)) {
        pg8::Gemm g{Z, WOUT, MT, DM, DM, DM, DM, 0}; pg8::StaticOrder S; S.init(MT, DM, F.G, (int)blockIdx.x);
        pg8::EpiPlain E{Y, DM};
        pg8::gemm_phase<pg8::EpiPlain>(F.lds, g, S, E);
        if (F.G == 256 && (int)blockIdx.x >= 64) {
            const int lb = (int)blockIdx.x - 64;
            if (F.wave < 4) gemv_item(c, c_ctx, ada_w, ada_b, mod, 768 + lb * 4 + F.wave, threadIdx.x & 63);
            else tr_run(args, 2, lb * 4 + (F.wave - 4), 192 * 4, threadIdx.x & 63, (LAS float*)(F.lds + F.wave * 16384));
        }
    }
    SEAM(5);
    if (IN(6)) { FRESH();
        for (int row0 = F.gw * 3; row0 < MT; row0 += F.NGW * 3) {
            f32x4 v[3][8]; u32x2 yw[3][8];
#pragma unroll
            for (int q = 0; q < 3; ++q) { const int row = row0 + q; const float* src = row < ML ? x + (size_t)row * DM : ctx + (size_t)(row - ML) * DM; load_row_f32(src, F.lane, v[q]);
                const bf16_t* yr = Y + (size_t)row * DM;
#pragma unroll
                for (int j = 0; j < 8; ++j) yw[q][j] = *(const u32x2*)(yr + 4 * F.lane + 256 * j); }
#pragma unroll
            for (int q = 0; q < 3; ++q) { const int row = row0 + q; const bool lat = row < ML; const int r = lat ? row / SEQ : 8;
                float sy = 0.f;
#pragma unroll
                for (int j = 0; j < 8; ++j) { const float a = bf_lo(yw[q][j].x), b = bf_hi(yw[q][j].x), c2 = bf_lo(yw[q][j].y), d = bf_hi(yw[q][j].y); sy += (a * a + b * b) + (c2 * c2 + d * d); }
                const float rsy = __builtin_amdgcn_rsqf(wave_sum(sy) * (1.f / DM) + EPS);
                const float* m0 = mod + (size_t)r * 6144;
#pragma unroll
                for (int j = 0; j < 8; ++j) { const int col = 4 * F.lane + 256 * j; const f32x4 gt = *(const f32x4*)(m0 + 2 * DM + col), pn = *(const f32x4*)(post_norm + col);
                    const f32x4 y4 = (f32x4){bf_lo(yw[q][j].x), bf_hi(yw[q][j].x), bf_lo(yw[q][j].y), bf_hi(yw[q][j].y)};
                    v[q][j] = v[q][j] + gt * (y4 * rsy * pn);
                    if (lat) *(f32x4*)(args.out + (size_t)row * DM + col) = v[q][j]; }
                const float rstd = __builtin_amdgcn_rsqf(sumsq8(v[q]) * (1.f / DM) + EPS);
                modulate_store(v[q], rstd, pre_norm + DM, mod + (size_t)(9 + r) * 6144, H + (size_t)row * DM, F.lane); }
        }
    }
    SEAM(6);
    if (IN(7)) {
        pg8::Gemm g{H, WMLA, MT, NMLA, DM, DM, DM, 0}; pg8::StaticOrder S; S.init(MT, NMLA, F.G, (int)blockIdx.x);
        pg8::EpiMlaIn E{CQ, CKV, KR, SG, ssq, tab};
        pg8::gemm_phase<pg8::EpiMlaIn>(F.lds, g, S, E);
    }
    SEAM(7);
    if (IN(8)) {
        { pg8::Gemm g{CQ, WUQ, ML, 3072, 512, 512, 512, 0}; pg8::StaticOrder S; S.init(ML, 3072, F.G, (int)blockIdx.x);
          pg8::EpiQ E{Q, ssq, tab};
          pg8::gemm_phase<pg8::EpiQ>(F.lds, g, S, E); }
        { pg8::Gemm g{CKV, WUKV, MT, 4096, 512, 512, 512, 0}; pg8::StaticOrder S; S.init(MT, 4096, F.G, (int)blockIdx.x);
          pg8::EpiKV E{KN, V, ssq + MT};
          pg8::gemm_phase<pg8::EpiKV>(F.lds, g, S, E); }
    }
    SEAM(8);
    if (IN(9)) {
        const int bx = blockIdx.x, vcu = (F.G % 8 == 0) ? (bx % 8) * (F.G / 8) + bx / 8 : bx;
        att::attn_phase(Q, KN, KR, V, SG, Z, vcu, F.G, (char*)lds, F.lds);
    }
    SEAM(9);
    if (IN(10)) {
        pg8::Gemm g{Z, WMO, ML, DM, DM, DM, DM, 0}; pg8::StaticOrder S; S.init(ML, DM, F.G, (int)blockIdx.x);
        pg8::EpiPlain E{Y, DM};
        pg8::gemm_phase<pg8::EpiPlain>(F.lds, g, S, E);
    }
    SEAM(10);
    if (IN(11)) { FRESH();
        for (int row0 = F.gw * 2; row0 < ML; row0 += F.NGW * 2) {
            f32x4 v[2][8]; u32x2 yw[2][8];
#pragma unroll
            for (int q = 0; q < 2; ++q) { const int row = row0 + q; load_row_f32(args.out + (size_t)row * DM, F.lane, v[q]);
                const bf16_t* yr = Y + (size_t)row * DM;
#pragma unroll
                for (int j = 0; j < 8; ++j) yw[q][j] = *(const u32x2*)(yr + 4 * F.lane + 256 * j); }
#pragma unroll
            for (int q = 0; q < 2; ++q) { const int row = row0 + q; const int r = row / SEQ;
                float sy = 0.f;
#pragma unroll
                for (int j = 0; j < 8; ++j) { const float a = bf_lo(yw[q][j].x), b = bf_hi(yw[q][j].x), c2 = bf_lo(yw[q][j].y), d = bf_hi(yw[q][j].y); sy += (a * a + b * b) + (c2 * c2 + d * d); }
                const float rsy = __builtin_amdgcn_rsqf(wave_sum(sy) * (1.f / DM) + EPS);
                const float* m1 = mod + (size_t)(9 + r) * 6144;
#pragma unroll
                for (int j = 0; j < 8; ++j) { const int col = 4 * F.lane + 256 * j; const f32x4 gt = *(const f32x4*)(m1 + 2 * DM + col), pn = *(const f32x4*)(post_norm + DM + col);
                    const f32x4 y4 = (f32x4){bf_lo(yw[q][j].x), bf_hi(yw[q][j].x), bf_lo(yw[q][j].y), bf_hi(yw[q][j].y)};
                    *(f32x4*)(args.out + (size_t)row * DM + col) = v[q][j] + gt * (y4 * rsy * pn); }
            }
        }
    }
#undef IN
#undef SEAM
}

extern "C" void kernel_launch(void* const* d_in, const int* in_sizes, int n_in, void* d_out, int out_size, void* d_ws, size_t ws_size, hipStream_t stream) {
    static int grid = 0;
    if (grid == 0) {
        if (n_in != 19 || out_size != ML * DM || ws_size < WS_END) { fprintf(stderr, "kernel_launch: unexpected shapes (n_in %d out %d ws %zu)\n", n_in, out_size, ws_size); grid = -1; return; }
        int dev = 0, cus = 0, per_cu = 0;
        hipGetDevice(&dev); hipDeviceGetAttribute(&cus, hipDeviceAttributeMultiprocessorCount, dev);
        if (hipFuncSetAttribute((const void*)mk_fwd, hipFuncAttributeMaxDynamicSharedMemorySize, LDS_BYTES) != hipSuccess) { fprintf(stderr, "kernel_launch: hipFuncSetAttribute failed\n"); grid = -1; return; }
        hipOccupancyMaxActiveBlocksPerMultiprocessor(&per_cu, (const void*)mk_fwd, NWAVES * 64, LDS_BYTES);
        (void)hipGetLastError();
        if (per_cu < 1) per_cu = 1;
        grid = cus * 1;
        (void)per_cu;
    }
    if (grid < 0) return;
    hipMemsetAsync((char*)d_ws, 0, CTL_ZERO_BYTES, stream);
    Args a{};
    for (int i = 0; i < 19; ++i) a.in[i] = (const float*)d_in[i];
    a.out = (float*)d_out; a.ws = (unsigned char*)d_ws;
#if MK_N_LAUNCHES == 1
    a.ph_lo = 0; a.ph_hi = N_PHASES;
    void* kargs[] = {&a};
    hipError_t e = hipLaunchCooperativeKernel((const void*)mk_fwd, dim3(grid), dim3(NWAVES * 64), kargs, LDS_BYTES, stream);
    if (e != hipSuccess) fprintf(stderr, "cooperative launch failed: %s (grid %d)\n", hipGetErrorString(e), grid);
#else
    for (int p = 0; p < N_PHASES; ++p) for (int rep = 0; rep < (((DBL_MASK >> p) & 1) ? 2 : 1); ++rep) { a.ph_lo = p; a.ph_hi = p + 1; hipLaunchKernelGGL(mk_fwd, dim3(grid), dim3(NWAVES * 64), LDS_BYTES, stream, a); }
#endif
}
```

```cpp
#include <hip/hip_runtime.h>
#include <hip/hip_cooperative_groups.h>
#include <hip/hip_bf16.h>
#include <cstdio>
#include <cstdint>
namespace cg = cooperative_groups;

#ifndef MK_N_LAUNCHES
#define MK_N_LAUNCHES 1
#endif

#define LAS __attribute__((address_space(3)))
typedef unsigned short bf16_t;
typedef short bf16x8 __attribute__((ext_vector_type(8)));
typedef short s16x4 __attribute__((ext_vector_type(4)));
typedef float f32x4 __attribute__((ext_vector_type(4)));
typedef float f32x2 __attribute__((ext_vector_type(2)));
typedef float f32x16 __attribute__((ext_vector_type(16)));
typedef unsigned u32x4 __attribute__((ext_vector_type(4)));
typedef unsigned u32x2 __attribute__((ext_vector_type(2)));

constexpr int DM = 2048, NB = 8, SEQ = 2048, CTXL = 256;
constexpr int ML = NB * SEQ, MC = NB * CTXL, MT = ML + MC;
constexpr int NMLA = 3328;
constexpr float EPS = 1e-6f;
constexpr float QSCALE = 0.07216878364870322f * 1.4426950408889634f;

constexpr size_t MiB = 1u << 20;
constexpr size_t WS_MOD = 0;
constexpr size_t WS_SSQ = 512 * 1024;
constexpr size_t WS_BAR = 768 * 1024;
constexpr size_t CTL_ZERO_BYTES = 1 * MiB;
constexpr size_t WS_TAB = 1 * MiB;
constexpr size_t WS_WIN = 2 * MiB, WS_WG = 18 * MiB, WS_WOUT = 20 * MiB, WS_WMLA = 28 * MiB, WS_WUQ = 41 * MiB, WS_WUKV = 44 * MiB, WS_WMO = 48 * MiB;
constexpr size_t WS_H = 64 * MiB, WS_SG = 136 * MiB, WS_Z = 208 * MiB, WS_Y = 280 * MiB, WS_U = 352 * MiB, WS_P = 424 * MiB;
constexpr size_t WS_Q = 352 * MiB, WS_CQ = 448 * MiB, WS_CKV = 466 * MiB, WS_KR = 484 * MiB, WS_KN = WS_H, WS_V = WS_Y;
constexpr size_t WS_END = 496 * MiB;

__device__ __forceinline__ unsigned cvt_pk_bf16(float lo, float hi) { unsigned r; asm volatile("v_cvt_pk_bf16_f32 %0, %1, %2" : "=v"(r) : "v"(lo), "v"(hi)); return r; }
__device__ __forceinline__ float bf_lo(unsigned w) { return __uint_as_float(w << 16); }
__device__ __forceinline__ float bf_hi(unsigned w) { return __uint_as_float(w & 0xffff0000u); }
__device__ __forceinline__ float silu_f(float v) { return v * __builtin_amdgcn_rcpf(1.f + __builtin_amdgcn_exp2f(-1.4426950408889634f * v)); }
__device__ __forceinline__ float wave_sum(float v) {
#pragma unroll
    for (int o = 1; o < 64; o <<= 1) v += __shfl_xor(v, o);
    return v;
}

namespace pg8 {
constexpr int BM = 256, BK = 64, HALF = 128, HTB = HALF * BK * 2, STAGE_BYTES = 8 * HTB, NXCD = 8, WGM = 8;
__host__ __device__ __forceinline__ int lds_byte(int r, int c) { const int st = (r >> 4) * 2 + (c >> 5), rr = r & 15, cc = c & 31, ob = rr * 64 + cc * 2; return st * 1024 + (ob ^ (((ob >> 9) & 1) << 5)); }
__host__ __device__ __forceinline__ void stage_rc(int b, int& R, int& C) { const int st = b / 1024, sb = b % 1024, swz = sb ^ (((sb >> 9) & 1) << 5); R = (st >> 1) * 16 + swz / 64; C = (st & 1) * 32 + (swz % 64) / 2; }
__host__ __device__ __forceinline__ int perm32(int rho) { const int n = rho >> 4, i = rho & 15; return 8 * (i >> 2) + 4 * n + (i & 3); }

struct Unit { int pm, pn; };
struct Gemm { const bf16_t* A; const bf16_t* Bt; int M, N, K, lda, ldb, agrp, apair; };

struct StaticOrder {
    int nM, nN, nwg, G, c;
    __host__ __device__ void init(int M, int N, int G_, int c_) { nM = M / BM; nN = N / BM; nwg = nM * nN; G = G_; c = c_; }
    __host__ __device__ bool next(int i, Unit& u) const {
        const long L = (long)i * G + c; if (L >= nwg) return false;
        int wgid = (int)L; { const int q = nwg / NXCD, r = nwg % NXCD, xcd = wgid % NXCD, off = wgid / NXCD; wgid = (xcd < r ? xcd * (q + 1) : r * (q + 1) + (xcd - r) * q) + off; }
        const int nig = WGM * nN, gid = wgid / nig, fm = gid * WGM, gsz = (nM - fm) < WGM ? (nM - fm) : WGM;
        u.pm = fm + ((wgid % nig) % gsz); u.pn = (wgid % nig) / gsz; return true;
    }
};

template <class Epi>
__device__ __forceinline__ void gemm_phase(LAS unsigned char* lds, const Gemm g, const StaticOrder& S, const Epi& E) {
    const int tid = threadIdx.x, wid = __builtin_amdgcn_readfirstlane(tid >> 6), lane = tid & 63, wr = wid >> 2, wc = wid & 3, fr = lane & 15, fq = lane >> 4;
    const int K = g.K, nt = K / BK;
    unsigned voffA[2], voffB[2];
#pragma unroll
    for (int i = 0; i < 2; ++i) { int R, C; stage_rc(tid * 16 + i * 8192, R, C); const int Rb = Epi::PERM ? ((R & ~31) + perm32(R & 31)) : R;
        voffA[i] = (unsigned)(R * g.lda + C) * 2u; voffB[i] = (unsigned)(Rb * g.ldb + C) * 2u; }
    const size_t kstep = (size_t)(BK * 2);
    const size_t pairA = g.apair ? (size_t)g.apair : 2 * kstep;
    const size_t hsA = (size_t)HALF * g.lda * 2, hsB = (size_t)HALF * g.ldb * 2;
    const size_t tsA = 2 * hsA, tsB = 2 * hsB;
    const unsigned ldsw = (unsigned)wid * 1024u;
    const int aoff = lds_byte(wr * 64 + fr, fq * 8), boff = lds_byte(wc * 32 + fr, fq * 8);
#define PG8_SA(b, h) (((b) * 2 + (h)) * HTB)
#define PG8_SB(b, h) ((4 + (b) * 2 + (h)) * HTB)
#define PG8_STAGE(bufoff, gbase, voff) do { _Pragma("unroll") for (int _i = 0; _i < 2; ++_i) \
        __builtin_amdgcn_global_load_lds((const unsigned*)((const char*)(gbase) + (voff)[_i]), (LAS unsigned*)(lds + (bufoff) + ldsw + _i * 8192), 16, 0, 0); } while (0)
#define PG8_LDA(dst, b, h) do { _Pragma("unroll") for (int m = 0; m < 4; ++m) _Pragma("unroll") for (int k = 0; k < 2; ++k) dst[m][k] = *(const LAS bf16x8*)(lds + PG8_SA(b, h) + aoff + m * 2048 + k * 1024); } while (0)
#define PG8_LDB(dst, b, h) do { _Pragma("unroll") for (int n = 0; n < 2; ++n) _Pragma("unroll") for (int k = 0; k < 2; ++k) dst[n][k] = *(const LAS bf16x8*)(lds + PG8_SB(b, h) + boff + n * 2048 + k * 1024); } while (0)
#define PG8_MMA(ai, bj, At, Bt) do { __builtin_amdgcn_s_setprio(1); _Pragma("unroll") for (int m = 0; m < 4; ++m) _Pragma("unroll") for (int n = 0; n < 2; ++n) _Pragma("unroll") for (int k = 0; k < 2; ++k) \
        acc[ai][bj][m][n] = __builtin_amdgcn_mfma_f32_16x16x32_bf16(Bt[n][k], At[m][k], acc[ai][bj][m][n], 0, 0, 0); __builtin_amdgcn_s_setprio(0); } while (0)
#define PG8_WAIT_V(n) asm volatile("s_waitcnt vmcnt(" #n ")" ::: "memory")
#define PG8_WAIT_L(n) asm volatile("s_waitcnt lgkmcnt(" #n ")" ::: "memory")
#define PG8_BAR __builtin_amdgcn_s_barrier()
#define PG8_SCHED __builtin_amdgcn_sched_barrier(0)
#define PG8_AOFF(u) ((g.agrp > 0) ? (size_t)((u).pn / g.agrp) * (size_t)K * 2 : (size_t)0)
    Unit cur, nxt; int ui = 0;
    if (!S.next(0, cur)) return;
    f32x4 acc[2][2][4][2];
#pragma unroll
    for (int a = 0; a < 2; ++a)
#pragma unroll
        for (int b = 0; b < 2; ++b)
#pragma unroll
            for (int m = 0; m < 4; ++m)
#pragma unroll
                for (int n = 0; n < 2; ++n) acc[a][b][m][n] = (f32x4){0.f, 0.f, 0.f, 0.f};
    bf16x8 At[4][2], B0[2][2], B1[2][2];
    const char* cA = (const char*)g.A + (size_t)cur.pm * tsA + PG8_AOFF(cur); const char* cB = (const char*)g.Bt + (size_t)cur.pn * tsB;
    PG8_STAGE(PG8_SB(0, 0), cB, voffB); PG8_STAGE(PG8_SB(0, 1), cB + hsB, voffB); PG8_STAGE(PG8_SA(0, 0), cA, voffA); PG8_STAGE(PG8_SA(0, 1), cA + hsA, voffA);
    if (wr == 1) PG8_BAR;
    PG8_WAIT_V(2); PG8_BAR;
    PG8_STAGE(PG8_SB(1, 0), cB + kstep, voffB); PG8_STAGE(PG8_SA(1, 0), cA + kstep, voffA); PG8_STAGE(PG8_SB(1, 1), cB + hsB + kstep, voffB);
    PG8_WAIT_V(6); PG8_BAR;
    for (;;) {
        const bool has_next = S.next(ui + 1, nxt);
        const char* nA = has_next ? (const char*)g.A + (size_t)nxt.pm * tsA + PG8_AOFF(nxt) : cA; const char* nB = has_next ? (const char*)g.Bt + (size_t)nxt.pn * tsB : cB;
        for (int t = 0; t < nt; t += 2) {
            const bool last = (t == nt - 2);
            const char* a1 = cA + (size_t)(t >> 1) * pairA + kstep;
            const char* a2 = last ? nA : cA + (size_t)((t >> 1) + 1) * pairA; const char* b2 = last ? nB : cB + (size_t)(t + 2) * kstep;
            const char* a3 = a2 + kstep; const char* b3 = b2 + kstep;
            PG8_LDB(B0, 0, 0); PG8_LDB(B1, 0, 1); PG8_SCHED; PG8_LDA(At, 0, 0); PG8_STAGE(PG8_SA(1, 1), a1 + hsA, voffA);
            PG8_WAIT_V(8); PG8_WAIT_L(0); PG8_BAR; PG8_MMA(0, 0, At, B0); PG8_MMA(0, 1, At, B1); PG8_BAR; PG8_SCHED;
            PG8_LDA(At, 0, 1); PG8_STAGE(PG8_SB(0, 0), b2, voffB); PG8_STAGE(PG8_SB(0, 1), b2 + hsB, voffB); PG8_STAGE(PG8_SA(0, 0), a2, voffA);
            PG8_WAIT_V(8); PG8_WAIT_L(0); PG8_BAR; PG8_MMA(1, 0, At, B0); PG8_MMA(1, 1, At, B1); PG8_BAR; PG8_SCHED;
            PG8_LDB(B0, 1, 0); PG8_LDB(B1, 1, 1); PG8_SCHED; PG8_LDA(At, 1, 0); PG8_STAGE(PG8_SA(0, 1), a2 + hsA, voffA);
            PG8_WAIT_V(8); PG8_WAIT_L(0); PG8_BAR; PG8_MMA(0, 0, At, B0); PG8_MMA(0, 1, At, B1); PG8_BAR; PG8_SCHED;
            PG8_LDA(At, 1, 1); PG8_STAGE(PG8_SB(1, 0), b3, voffB); PG8_STAGE(PG8_SB(1, 1), b3 + hsB, voffB); PG8_STAGE(PG8_SA(1, 0), a3, voffA);
            PG8_WAIT_V(8); PG8_WAIT_L(0); PG8_BAR; PG8_MMA(1, 0, At, B0); PG8_MMA(1, 1, At, B1); PG8_BAR; PG8_SCHED;
        }
        if (wr == 0) PG8_BAR;
        E(acc, cur, wr, wc, fr, fq);
        if (!has_next) break;
#pragma unroll
        for (int a = 0; a < 2; ++a)
#pragma unroll
            for (int b = 0; b < 2; ++b)
#pragma unroll
                for (int m = 0; m < 4; ++m)
#pragma unroll
                    for (int n = 0; n < 2; ++n) acc[a][b][m][n] = (f32x4){0.f, 0.f, 0.f, 0.f};
        cur = nxt; cA = nA; cB = nB; ++ui;
        if (wr == 1) PG8_BAR;
    }
    PG8_WAIT_V(0);
    PG8_BAR;
#undef PG8_SA
#undef PG8_SB
#undef PG8_STAGE
#undef PG8_LDA
#undef PG8_LDB
#undef PG8_MMA
#undef PG8_WAIT_V
#undef PG8_WAIT_L
#undef PG8_BAR
#undef PG8_SCHED
#undef PG8_AOFF
}

__device__ __forceinline__ u32x4 pack8(f32x4 v0, f32x4 v1) { u32x4 w; w.x = cvt_pk_bf16(v0[0], v0[1]); w.y = cvt_pk_bf16(v0[2], v0[3]); w.z = cvt_pk_bf16(v1[0], v1[1]); w.w = cvt_pk_bf16(v1[2], v1[3]); return w; }
__device__ __forceinline__ f32x4 silu4(f32x4 v) { return (f32x4){silu_f(v[0]), silu_f(v[1]), silu_f(v[2]), silu_f(v[3])}; }

struct EpiPlain {
    static constexpr bool PERM = true;
    bf16_t* O; int ldc;
    __device__ __forceinline__ void operator()(const f32x4 (&acc)[2][2][4][2], const Unit& u, int wr, int wc, int fr, int fq) const {
        const int row0 = u.pm * BM + wr * 64 + fr, col0 = u.pn * BM + wc * 32 + 8 * fq;
#pragma unroll
        for (int ai = 0; ai < 2; ++ai)
#pragma unroll
            for (int m = 0; m < 4; ++m) { bf16_t* rowp = O + (size_t)(row0 + ai * HALF + m * 16) * ldc + col0;
#pragma unroll
                for (int bj = 0; bj < 2; ++bj) *(u32x4*)(rowp + bj * HALF) = pack8(acc[ai][bj][m][0], acc[ai][bj][m][1]); }
    }
};
struct EpiPoolIn {
    static constexpr bool PERM = true;
    bf16_t* U; bf16_t* SG;
    __device__ __forceinline__ void operator()(const f32x4 (&acc)[2][2][4][2], const Unit& u, int wr, int wc, int fr, int fq) const {
        const int t = u.pn >> 3; bf16_t* base = t ? SG : U;
        const int row0 = u.pm * BM + wr * 64 + fr, col0 = (u.pn & 7) * BM + wc * 32 + 8 * fq;
#pragma unroll
        for (int ai = 0; ai < 2; ++ai)
#pragma unroll
            for (int m = 0; m < 4; ++m) { bf16_t* rowp = base + (size_t)(row0 + ai * HALF + m * 16) * DM + col0;
#pragma unroll
                for (int bj = 0; bj < 2; ++bj) { f32x4 v0 = acc[ai][bj][m][0], v1 = acc[ai][bj][m][1];
                    if (t) { v0 = silu4(v0); v1 = silu4(v1); }
                    *(u32x4*)(rowp + bj * HALF) = pack8(v0, v1); } }
    }
};
struct EpiGrp {
    static constexpr bool PERM = true;
    const bf16_t* SG; bf16_t* Z; const float* bias; const float* scale;
    __device__ __forceinline__ void operator()(const f32x4 (&acc)[2][2][4][2], const Unit& u, int wr, int wc, int fr, int fq) const {
        const int row0 = u.pm * BM + wr * 64 + fr, col0 = u.pn * BM + wc * 32 + 8 * fq;
        f32x4 bv[2][2], sv[2][2];
#pragma unroll
        for (int bj = 0; bj < 2; ++bj)
#pragma unroll
            for (int n = 0; n < 2; ++n) { bv[bj][n] = *(const f32x4*)(bias + col0 + bj * HALF + 4 * n); sv[bj][n] = *(const f32x4*)(scale + col0 + bj * HALF + 4 * n); }
#pragma unroll
        for (int ai = 0; ai < 2; ++ai)
#pragma unroll
            for (int m = 0; m < 4; ++m) { const size_t off = (size_t)(row0 + ai * HALF + m * 16) * DM + col0;
#pragma unroll
                for (int bj = 0; bj < 2; ++bj) { const u32x4 gw = *(const u32x4*)(SG + off + bj * HALF);
                    f32x4 v0 = (acc[ai][bj][m][0] + bv[bj][0]) * sv[bj][0], v1 = (acc[ai][bj][m][1] + bv[bj][1]) * sv[bj][1];
                    v0 = v0 * (f32x4){bf_lo(gw.x), bf_hi(gw.x), bf_lo(gw.y), bf_hi(gw.y)}; v1 = v1 * (f32x4){bf_lo(gw.z), bf_hi(gw.z), bf_lo(gw.w), bf_hi(gw.w)};
                    *(u32x4*)(Z + off + bj * HALF) = pack8(v0, v1); } }
    }
};
struct EpiMlaIn {
    static constexpr bool PERM = true;
    bf16_t *CQ, *CKV, *KR, *SG; float* ssq; const f32x2* tab;
    __device__ __forceinline__ void operator()(const f32x4 (&acc)[2][2][4][2], const Unit& u, int wr, int wc, int fr, int fq) const {
        const int pn = u.pn, row0 = u.pm * BM + wr * 64 + fr;
        if (pn < 4) {
            bf16_t* base = pn < 2 ? CQ : CKV; float* ss = ssq + (pn < 2 ? 0 : MT);
            const int col0 = (pn & 1) * BM + wc * 32 + 8 * fq;
#pragma unroll
            for (int ai = 0; ai < 2; ++ai)
#pragma unroll
                for (int m = 0; m < 4; ++m) { const int row = row0 + ai * HALF + m * 16; bf16_t* rowp = base + (size_t)row * 512 + col0; float s = 0.f;
#pragma unroll
                    for (int bj = 0; bj < 2; ++bj) { const f32x4 v0 = acc[ai][bj][m][0], v1 = acc[ai][bj][m][1];
                        s += (v0[0] * v0[0] + v0[1] * v0[1]) + (v0[2] * v0[2] + v0[3] * v0[3]) + (v1[0] * v1[0] + v1[1] * v1[1]) + (v1[2] * v1[2] + v1[3] * v1[3]);
                        *(u32x4*)(rowp + bj * HALF) = pack8(v0, v1); }
                    s += __shfl_xor(s, 16); s += __shfl_xor(s, 32);
                    if (fq == 0) atomicAdd(ss + row, s); }
        } else if (pn < 12) {
            if (u.pm < ML / BM) {
                const int col0 = (pn - 4) * BM + wc * 32 + 8 * fq;
#pragma unroll
                for (int ai = 0; ai < 2; ++ai)
#pragma unroll
                    for (int m = 0; m < 4; ++m) { bf16_t* rowp = SG + (size_t)(row0 + ai * HALF + m * 16) * DM + col0;
#pragma unroll
                        for (int bj = 0; bj < 2; ++bj) *(u32x4*)(rowp + bj * HALF) = pack8(silu4(acc[ai][bj][m][0]), silu4(acc[ai][bj][m][1])); }
            }
        } else {
            if (wc < 2) {
                const bool lat = u.pm < ML / BM;
#pragma unroll
                for (int ai = 0; ai < 2; ++ai)
#pragma unroll
                    for (int m = 0; m < 4; ++m) { const int row = row0 + ai * HALF + m * 16;
                        f32x4 v0 = acc[ai][0][m][0], v1 = acc[ai][0][m][1];
                        if (lat) {
                            const int t = row & (SEQ - 1), pos = wc == 0 ? (t >> 6) : (t & 63);
                            const f32x2* tp = tab + pos * 16 + 8 * (fq & 1);
                            f32x4 p0, p1;
#pragma unroll
                            for (int j = 0; j < 4; ++j) { p0[j] = __shfl_xor(v0[j], 32); p1[j] = __shfl_xor(v1[j], 32); }
                            const bool first = fq < 2;
#pragma unroll
                            for (int j = 0; j < 4; ++j) { const f32x2 c0 = tp[j], c1 = tp[4 + j];
                                v0[j] = first ? (v0[j] * c0.x - p0[j] * c0.y) : (p0[j] * c0.y + v0[j] * c0.x);
                                v1[j] = first ? (v1[j] * c1.x - p1[j] * c1.y) : (p1[j] * c1.y + v1[j] * c1.x); }
                        }
                        *(u32x4*)(KR + (size_t)row * 64 + wc * 32 + 8 * fq) = pack8(v0, v1); }
            }
        }
    }
};
struct EpiQ {
    static constexpr bool PERM = true;
    bf16_t* Q; const float* ssq; const f32x2* tab;
    __device__ __forceinline__ void operator()(const f32x4 (&acc)[2][2][4][2], const Unit& u, int wr, int wc, int fr, int fq) const {
        const int row0 = u.pm * BM + wr * 64 + fr; const bool first = fq < 2;
#pragma unroll
        for (int ai = 0; ai < 2; ++ai)
#pragma unroll
            for (int m = 0; m < 4; ++m) { const int row = row0 + ai * HALF + m * 16; const float rs = __builtin_amdgcn_rsqf(ssq[row] * (1.f / 512.f) + EPS) * QSCALE; const int t = row & (SEQ - 1);
#pragma unroll
                for (int bj = 0; bj < 2; ++bj) { const int gcol = u.pn * 8 + bj * 4 + wc, hg = gcol % 6;
                    f32x4 v0 = acc[ai][bj][m][0] * rs, v1 = acc[ai][bj][m][1] * rs;
                    if (hg >= 4) { const int pos = hg == 4 ? (t >> 6) : (t & 63); const f32x2* tp = tab + pos * 16 + 8 * (fq & 1);
                        f32x4 p0, p1;
#pragma unroll
                        for (int j = 0; j < 4; ++j) { p0[j] = __shfl_xor(v0[j], 32); p1[j] = __shfl_xor(v1[j], 32); }
#pragma unroll
                        for (int j = 0; j < 4; ++j) { const f32x2 c0 = tp[j], c1 = tp[4 + j];
                            v0[j] = first ? (v0[j] * c0.x - p0[j] * c0.y) : (p0[j] * c0.y + v0[j] * c0.x);
                            v1[j] = first ? (v1[j] * c1.x - p1[j] * c1.y) : (p1[j] * c1.y + v1[j] * c1.x); } }
                    *(u32x4*)(Q + (size_t)row * 3072 + gcol * 32 + 8 * fq) = pack8(v0, v1); } }
    }
};
struct EpiKV {
    static constexpr bool PERM = true;
    bf16_t* KN; bf16_t* V; const float* ssq;
    __device__ __forceinline__ void operator()(const f32x4 (&acc)[2][2][4][2], const Unit& u, int wr, int wc, int fr, int fq) const {
        const int row0 = u.pm * BM + wr * 64 + fr, col0 = u.pn * 128 + wc * 32 + 8 * fq;
#pragma unroll
        for (int ai = 0; ai < 2; ++ai)
#pragma unroll
            for (int m = 0; m < 4; ++m) { const int row = row0 + ai * HALF + m * 16; const float rs = __builtin_amdgcn_rsqf(ssq[row] * (1.f / 512.f) + EPS);
                *(u32x4*)(KN + (size_t)row * DM + col0) = pack8(acc[ai][0][m][0] * rs, acc[ai][0][m][1] * rs);
                *(u32x4*)(V + (size_t)row * DM + col0) = pack8(acc[ai][1][m][0] * rs, acc[ai][1][m][1] * rs); }
    }
};
}

namespace att {
constexpr int NW = 8, QBLK = 32, KVBLK = 64, NT = (CTXL + SEQ) / KVBLK;
constexpr int SHM_V = KVBLK * 128 * 2, SHM_K = KVBLK * 192 * 2;
#ifndef ATT_NQREG
#define ATT_NQREG 12
#endif
constexpr int NQREG = ATT_NQREG, SHM_QR = (12 - NQREG) * 8192, SHM_ATTN = 3 * SHM_V + 3 * SHM_K + NW * 64 * 4 + SHM_QR + NW * 4096;
constexpr float THRL = 8.f * 1.4426950408889634f;
#define KSWZ(row, colB) ((row) * 384 + ((colB) ^ (((row) & 7) << 4)))
#define SBAR() __builtin_amdgcn_sched_barrier(0)
__device__ __forceinline__ int crow(int r, int hi) { return (r & 3) + 8 * (r >> 2) + 4 * hi; }
__device__ __forceinline__ void partialSM(f32x16& p0, f32x16& p1, float& m_reg, float& mn, float& alpha) {
  float pmax = p0[0];
#pragma unroll
  for (int r = 1; r < 16; ++r) pmax = fmaxf(pmax, p0[r]);
#pragma unroll
  for (int r = 0; r < 16; ++r) pmax = fmaxf(pmax, p1[r]);
  { auto rr = __builtin_amdgcn_permlane32_swap(__float_as_uint(pmax), __float_as_uint(pmax), false, false);
    pmax = fmaxf(__uint_as_float(rr[0]), __uint_as_float(rr[1])); }
  if (__builtin_expect(__all(pmax - m_reg <= THRL), 1)) { mn = m_reg; alpha = 1.f; }
  else { mn = fmaxf(m_reg, pmax); alpha = __builtin_amdgcn_exp2f(m_reg - mn); m_reg = mn; }
#pragma unroll
  for (int r = 0; r < 16; ++r) p0[r] = p0[r] - mn;
#pragma unroll
  for (int r = 0; r < 16; ++r) p1[r] = p1[r] - mn;
#pragma unroll
  for (int r = 0; r < 16; ++r) p0[r] = __builtin_amdgcn_exp2f(p0[r]);
}
__device__ __forceinline__ void finishSM(f32x16& p0, f32x16& p1, float alpha, float& l_reg, bf16x8& pa0, bf16x8& pa1, bf16x8& pa2, bf16x8& pa3) {
#pragma unroll
  for (int r = 0; r < 16; ++r) p1[r] = __builtin_amdgcn_exp2f(p1[r]);
  float ps = 0;
#pragma unroll
  for (int r = 0; r < 16; ++r) ps += p0[r];
#pragma unroll
  for (int r = 0; r < 16; ++r) ps += p1[r];
  { auto rr = __builtin_amdgcn_permlane32_swap(__float_as_uint(ps), __float_as_uint(ps), false, false);
    ps = __uint_as_float(rr[0]) + __uint_as_float(rr[1]); }
  l_reg = l_reg * alpha + ps;
#define PK4(P, BASE, OUT) do { unsigned a0 = cvt_pk_bf16(P[BASE + 0], P[BASE + 1]), a1 = cvt_pk_bf16(P[BASE + 2], P[BASE + 3]);   \
    unsigned b0 = cvt_pk_bf16(P[BASE + 4], P[BASE + 5]), b1 = cvt_pk_bf16(P[BASE + 6], P[BASE + 7]);                              \
    auto r0 = __builtin_amdgcn_permlane32_swap(a0, b0, false, false); auto r1 = __builtin_amdgcn_permlane32_swap(a1, b1, false, false); \
    u32x4 w = {r0[0], r1[0], r0[1], r1[1]}; OUT = *reinterpret_cast<bf16x8*>(&w); } while (0)
  PK4(p0, 0, pa0); PK4(p0, 8, pa1); PK4(p1, 0, pa2); PK4(p1, 8, pa3);
#undef PK4
}
__device__ __forceinline__ void qkt(f32x16& p0, f32x16& p1, const char* Ks, const bf16x8* qr, const char* Qr, int kbase) {
  p0 = f32x16{}; p1 = f32x16{};
  const char* kb = Ks + kbase;
  bf16x8 k0[4], k1[4];
#define KLD(d) do { k0[(d) % 4] = *reinterpret_cast<const bf16x8*>(kb + (d) * 512); k1[(d) % 4] = *reinterpret_cast<const bf16x8*>(kb + 12288 + (d) * 512); } while (0)
  KLD(0); KLD(1); KLD(2);
  __builtin_amdgcn_s_setprio(1);
#pragma unroll
  for (int d0 = 0; d0 < 12; ++d0) {
    if (d0 + 3 < 12) KLD(d0 + 3);
    const bf16x8 qf = d0 < NQREG ? qr[d0 < NQREG ? d0 : 0] : *reinterpret_cast<const bf16x8*>(Qr + (d0 - NQREG) * 8192);
    p0 = __builtin_amdgcn_mfma_f32_32x32x16_bf16(k0[d0 % 4], qf, p0, 0, 0, 0);
    p1 = __builtin_amdgcn_mfma_f32_32x32x16_bf16(k1[d0 % 4], qf, p1, 0, 0, 0);
    SBAR(); }
  __builtin_amdgcn_s_setprio(0);
#undef KLD
}
__device__ __forceinline__ int v_st(int k, int c) { const int kk = (k & ~0xC) | ((k & 4) << 1) | ((k & 8) >> 1); return ((kk >> 3) * 4 + (c >> 5)) * 512 + ((kk & 7) * 32 + (c & 31)) * 2; }
__device__ __forceinline__ int v_rd_base(int lane) { return ((lane & 3) << 3) | (((lane >> 2) & 3) << 6) | (((lane >> 4) & 1) << 5) | (((lane >> 5) & 1) << 8); }
constexpr int v_rd_off(int d0, int ks, int half) { return d0 * 512 + ks * 4096 + half * 2048; }
template <int OFF> __device__ __forceinline__ s16x4 tr_read(int vb) {
  s16x4 r; asm volatile("ds_read_b64_tr_b16 %0, %1 offset:%2" : "=&v"(r) : "v"(vb), "i"(OFF) : "memory"); return r;
}
struct VFrag { s16x4 l0, h0, l1, h1, l2, h2, l3, h3; };
template <int D0> __device__ __forceinline__ void v_read8(VFrag& f, int vb) {
  f.l0 = tr_read<v_rd_off(D0, 0, 0)>(vb); f.h0 = tr_read<v_rd_off(D0, 0, 1)>(vb); f.l1 = tr_read<v_rd_off(D0, 1, 0)>(vb); f.h1 = tr_read<v_rd_off(D0, 1, 1)>(vb);
  f.l2 = tr_read<v_rd_off(D0, 2, 0)>(vb); f.h2 = tr_read<v_rd_off(D0, 2, 1)>(vb); f.l3 = tr_read<v_rd_off(D0, 3, 0)>(vb); f.h3 = tr_read<v_rd_off(D0, 3, 1)>(vb);
}
__device__ __forceinline__ void pv_mma(f32x16& od, const VFrag& f, bf16x8 pa0, bf16x8 pa1, bf16x8 pa2, bf16x8 pa3) {
#define PK(L, H) (bf16x8){L[0], L[1], L[2], L[3], H[0], H[1], H[2], H[3]}
  od = __builtin_amdgcn_mfma_f32_32x32x16_bf16(pa0, PK(f.l0, f.h0), od, 0, 0, 0);
  od = __builtin_amdgcn_mfma_f32_32x32x16_bf16(pa1, PK(f.l1, f.h1), od, 0, 0, 0);
  od = __builtin_amdgcn_mfma_f32_32x32x16_bf16(pa2, PK(f.l2, f.h2), od, 0, 0, 0);
  od = __builtin_amdgcn_mfma_f32_32x32x16_bf16(pa3, PK(f.l3, f.h3), od, 0, 0, 0);
#undef PK
}
__device__ __forceinline__ void pv_d0(f32x16* o, int vb, bf16x8 pa0, bf16x8 pa1, bf16x8 pa2, bf16x8 pa3) {
  VFrag fa, fb;
  v_read8<0>(fa, vb); v_read8<1>(fb, vb);
  asm volatile("s_waitcnt lgkmcnt(8)" ::: "memory"); SBAR(); pv_mma(o[0], fa, pa0, pa1, pa2, pa3); SBAR();
  v_read8<2>(fa, vb);
  asm volatile("s_waitcnt lgkmcnt(8)" ::: "memory"); SBAR(); pv_mma(o[1], fb, pa0, pa1, pa2, pa3); SBAR();
  v_read8<3>(fb, vb);
  asm volatile("s_waitcnt lgkmcnt(8)" ::: "memory"); SBAR(); pv_mma(o[2], fa, pa0, pa1, pa2, pa3); SBAR();
  asm volatile("s_waitcnt lgkmcnt(0)" ::: "memory"); SBAR(); pv_mma(o[3], fb, pa0, pa1, pa2, pa3); SBAR();
}
__device__ __forceinline__ void qkt_pv(f32x16& p0, f32x16& p1, const char* Ks, const bf16x8* qr, const char* Qr, int kbase, f32x16* o, int vb, bf16x8 pa0, bf16x8 pa1, bf16x8 pa2, bf16x8 pa3) {
  p0 = f32x16{}; p1 = f32x16{};
  const char* kb = Ks + kbase;
  bf16x8 k0[4], k1[4]; VFrag fa, fb;
#define KLD(d) do { k0[(d) % 4] = *reinterpret_cast<const bf16x8*>(kb + (d) * 512); k1[(d) % 4] = *reinterpret_cast<const bf16x8*>(kb + 12288 + (d) * 512); } while (0)
  KLD(0); KLD(1); KLD(2);
  __builtin_amdgcn_s_setprio(1);
#pragma unroll
  for (int d0 = 0; d0 < 12; ++d0) {
    if (d0 + 3 < 12) KLD(d0 + 3);
    if (d0 == 10) v_read8<0>(fa, vb);
    const bf16x8 qf = d0 < NQREG ? qr[d0 < NQREG ? d0 : 0] : *reinterpret_cast<const bf16x8*>(Qr + (d0 - NQREG) * 8192);
    p0 = __builtin_amdgcn_mfma_f32_32x32x16_bf16(k0[d0 % 4], qf, p0, 0, 0, 0);
    p1 = __builtin_amdgcn_mfma_f32_32x32x16_bf16(k1[d0 % 4], qf, p1, 0, 0, 0);
    SBAR(); }
#undef KLD
  v_read8<1>(fb, vb);
  asm volatile("s_waitcnt lgkmcnt(8)" ::: "memory"); SBAR(); pv_mma(o[0], fa, pa0, pa1, pa2, pa3); SBAR();
  v_read8<2>(fa, vb);
  asm volatile("s_waitcnt lgkmcnt(8)" ::: "memory"); SBAR(); pv_mma(o[1], fb, pa0, pa1, pa2, pa3); SBAR();
  v_read8<3>(fb, vb);
  asm volatile("s_waitcnt lgkmcnt(8)" ::: "memory"); SBAR(); pv_mma(o[2], fa, pa0, pa1, pa2, pa3); SBAR();
  asm volatile("s_waitcnt lgkmcnt(0)" ::: "memory"); SBAR(); pv_mma(o[3], fb, pa0, pa1, pa2, pa3); SBAR();
  __builtin_amdgcn_s_setprio(0);
}
constexpr int SLOT_K = SHM_K, SLOT_V = SHM_V, RING_BYTES = 3 * (SLOT_K + SLOT_V);
constexpr int NUNITS = NB * 16 * (SEQ / 256);
__device__ __forceinline__ void attn_phase(const bf16_t* Q, const bf16_t* __restrict__ KN, const bf16_t* __restrict__ KR, const bf16_t* __restrict__ V,
                                           const bf16_t* __restrict__ SG, bf16_t* __restrict__ Z, int vcu, int G, char* lds, LAS unsigned char* ldsl) {
  const int tid = threadIdx.x, wid = __builtin_amdgcn_readfirstlane(tid >> 6), lane = tid & 63, r32 = lane & 31, hi = lane >> 5;
  char* K_lds = lds; char* V_lds = lds + 3 * SLOT_K;
  float* wsf = (float*)(lds + RING_BYTES) + wid * 64; float* li_l = wsf; float* al_l = wsf + 32;
  char* Qr = lds + RING_BYTES + NW * 64 * 4 + tid * 16;
  const int vb0 = (int)(uintptr_t)V_lds + v_rd_base(lane);
  const int kbase = ((r32 >> 4) * 384 + (r32 & 15)) * 16 + hi * 256;
  int kofs[6], vofs[4]; bool krope[6];
  const int wq = wid & 3;
#pragma unroll
  for (int i = 0; i < 6; ++i) { const int p = 6 * wq + i, row = (p / 6) * 16 + (lane & 15), chunk = 4 * (p % 6) + (lane >> 4);
    krope[i] = chunk >= 16; kofs[i] = krope[i] ? row * 128 + (chunk - 16) * 16 : row * 4096 + chunk * 16; }
#pragma unroll
  for (int i = 0; i < 4; ++i) { const int B = (4 * wq + i) * 1024 + lane * 16, sub = B >> 9, within = (B & 511) >> 1, kk = (sub >> 2) * 8 + (within >> 5);
    const int k = (kk & ~0xC) | ((kk & 4) << 1) | ((kk & 8) >> 1), c = (sub & 3) * 32 + (within & 31); vofs[i] = k * 4096 + c * 2; }
#define KROW(j, b_) ((j) < 4 ? ML + (b_) * CTXL + (j) * KVBLK : (b_) * SEQ + ((j) - 4) * KVBLK)
#define DMA_K(j, b_, h_, slot) do { const int rb_ = KROW(j, b_); \
    const char* kn_ = (const char*)KN + (size_t)rb_ * 4096 + (h_) * 256; const char* kr_ = (const char*)KR + (size_t)rb_ * 128; \
    _Pragma("unroll") for (int i_ = 0; i_ < 6; ++i_) __builtin_amdgcn_global_load_lds((const unsigned*)((krope[i_] ? kr_ : kn_) + kofs[i_]), (LAS unsigned*)(ldsl + (slot) * SLOT_K + (6 * wq + i_) * 1024), 16, 0, 0); } while (0)
#define DMA_V(j, b_, h_, slot) do { const int rb_ = KROW(j, b_); const char* v_ = (const char*)V + (size_t)rb_ * 4096 + (h_) * 256; \
    _Pragma("unroll") for (int i_ = 0; i_ < 4; ++i_) __builtin_amdgcn_global_load_lds((const unsigned*)(v_ + vofs[i_]), (LAS unsigned*)(ldsl + 3 * SLOT_K + (slot) * SLOT_V + (4 * wq + i_) * 1024), 16, 0, 0); } while (0)
#define TILE_SYNC() do { asm volatile("s_waitcnt vmcnt(0)" ::: "memory"); __syncthreads(); } while (0)
#define RESC(a) do { if (__any((a) < 1.f)) { if (hi == 0) al_l[r32] = (a); asm volatile("s_waitcnt lgkmcnt(0)" ::: "memory"); \
    _Pragma("unroll") for (int d = 0; d < 4; ++d) _Pragma("unroll") for (int r = 0; r < 16; ++r) o[d][r] *= al_l[crow(r, hi)]; } } while (0)
  const int half = wid >> 2;
  const int nun_wg = vcu < NUNITS ? (NUNITS - 1 - vcu) / G + 1 : 0, T = nun_wg * NT;
#define ABAR() do { asm volatile("s_waitcnt lgkmcnt(0)" ::: "memory"); __builtin_amdgcn_s_barrier(); asm volatile("" ::: "memory"); } while (0)
#define VWAIT() asm volatile("s_waitcnt vmcnt(0)" ::: "memory")
#define DMA_TK(t_) do { const int ui_ = (t_) / NT, j_ = (t_) - ui_ * NT, un_ = vcu + ui_ * G; DMA_K(j_, (un_ >> 7), ((un_ >> 3) & 15), ((t_) % 3)); } while (0)
#define DMA_TV(t_) do { const int ui_ = (t_) / NT, j_ = (t_) - ui_ * NT, un_ = vcu + ui_ * G; DMA_V(j_, (un_ >> 7), ((un_ >> 3) & 15), ((t_) % 3)); } while (0)
#define LOADQ(un_) do { const int qb_ = (un_) & 7, h_ = ((un_) >> 3) & 15, b_ = (un_) >> 7; const bf16_t* Qw = Q + (size_t)(b_ * SEQ + qb_ * 256 + wid * QBLK + r32) * 3072 + h_ * 192 + hi * 8; \
    _Pragma("unroll") for (int d0 = 0; d0 < NQREG; ++d0) qr[d0] = *reinterpret_cast<const bf16x8*>(Qw + d0 * 16); \
    _Pragma("unroll") for (int d0 = NQREG; d0 < 12; ++d0) *reinterpret_cast<bf16x8*>(Qr + (d0 - NQREG) * 8192) = *reinterpret_cast<const bf16x8*>(Qw + d0 * 16); } while (0)
#define EPI_PREFETCH(un_) do { const int qb_ = (un_) & 7, h_ = ((un_) >> 3) & 15, b_ = (un_) >> 7; \
    const size_t ob = (size_t)(b_ * SEQ + qb_ * 256 + wid * QBLK + (lane >> 3)) * DM + h_ * 128 + (lane & 7) * 8; \
    _Pragma("unroll") for (int hf = 0; hf < 2; ++hf) _Pragma("unroll") for (int i4 = 0; i4 < 4; ++i4) gv[hf][i4] = *(const u32x4*)(SG + ob + (size_t)(i4 * 8) * DM + hf * 64); } while (0)
#define EPILOGUE(un_) do { const int qb_ = (un_) & 7, h_ = ((un_) >> 3) & 15, b_ = (un_) >> 7; \
    if (hi == 0) li_l[r32] = l_reg; asm volatile("s_waitcnt lgkmcnt(0)" ::: "memory"); \
    const size_t ob = (size_t)(b_ * SEQ + qb_ * 256 + wid * QBLK + (lane >> 3)) * DM + h_ * 128 + (lane & 7) * 8; \
    _Pragma("unroll") for (int hf = 0; hf < 2; ++hf) { \
      _Pragma("unroll") for (int r = 0; r < 16; ++r) { const float rl = __builtin_amdgcn_rcpf(li_l[crow(r, hi)]); \
        _Pragma("unroll") for (int dd = 0; dd < 2; ++dd) epi[crow(r, hi) * 64 + dd * 32 + r32] = (bf16_t)(cvt_pk_bf16(o[hf * 2 + dd][r] * rl, 0.f) & 0xffffu); } \
      asm volatile("s_waitcnt lgkmcnt(0)" ::: "memory"); \
      _Pragma("unroll") for (int i4 = 0; i4 < 4; ++i4) { const u32x4 ov = *(const u32x4*)(epi + (i4 * 8 + (lane >> 3)) * 64 + (lane & 7) * 8); \
        const size_t gi = (size_t)(b_ * SEQ + qb_ * 256 + wid * QBLK + (lane >> 3) + i4 * 8) * 3072 + h_ * 192 + (lane & 7) * 8 + hf * 64; const u32x4 gvv = gv[hf][i4]; u32x4 zv; \
        zv.x = cvt_pk_bf16(bf_lo(ov.x) * bf_lo(gvv.x), bf_hi(ov.x) * bf_hi(gvv.x)); zv.y = cvt_pk_bf16(bf_lo(ov.y) * bf_lo(gvv.y), bf_hi(ov.y) * bf_hi(gvv.y)); \
        zv.z = cvt_pk_bf16(bf_lo(ov.z) * bf_lo(gvv.z), bf_hi(ov.z) * bf_hi(gvv.z)); zv.w = cvt_pk_bf16(bf_lo(ov.w) * bf_lo(gvv.w), bf_hi(ov.w) * bf_hi(gvv.w)); \
        *(u32x4*)(Zq + gi) = zv; } \
      asm volatile("s_waitcnt lgkmcnt(0)" ::: "memory"); } } while (0)
  bf16_t* Zq = const_cast<bf16_t*>(Q);
  bf16_t* epi = (bf16_t*)(lds + RING_BYTES + NW * 64 * 4 + SHM_QR + wid * 4096);
  if (T > 0) {
    float m_reg = -1e30f, l_reg = 0, mn, al; f32x16 o[4] = {}; bf16x8 qr[NQREG]; f32x16 p0, p1; bf16x8 pa0, pa1, pa2, pa3; u32x4 gv[2][4];
    if (half == 1) { DMA_TK(0); DMA_TK(1); } else { DMA_TV(0); DMA_TV(1); }
    LOADQ(vcu);
    VWAIT(); __syncthreads();
    if (half == 1) ABAR();
    int slot = 0, pslot = 2, t = 0;
#define SEG_S() do { const bool vis_ = (half == 0) && t >= 1 && t + 1 < T; \
      if (half == 1) { if (t + 2 < T) DMA_TK(t + 2); } else if (vis_) DMA_TV(t + 1); \
      partialSM(p0, p1, m_reg, mn, al); RESC(al); finishSM(p0, p1, al, l_reg, pa0, pa1, pa2, pa3); \
      if (half == 0) { if (vis_) asm volatile("s_waitcnt vmcnt(4)" ::: "memory"); else VWAIT(); } \
      SBAR(); ABAR(); pslot = slot; slot = slot == 2 ? 0 : slot + 1; ++t; } while (0)
    for (int ui = 0; ui < nun_wg; ++ui) {
      SBAR();
      if (ui > 0) {
        EPI_PREFETCH(vcu + (ui - 1) * G);
        pv_d0(o, vb0 + pslot * SLOT_V, pa0, pa1, pa2, pa3);
        EPILOGUE(vcu + (ui - 1) * G);
        m_reg = -1e30f; l_reg = 0;
#pragma unroll
        for (int d = 0; d < 4; ++d) o[d] = f32x16{};
      }
      qkt(p0, p1, K_lds + slot * SLOT_K, qr, Qr, kbase);
      if (half == 1) VWAIT();
      SBAR(); ABAR();
      SEG_S();
      for (int j = 1; j < NT; ++j) {
        SBAR();
        qkt_pv(p0, p1, K_lds + slot * SLOT_K, qr, Qr, kbase, o, vb0 + pslot * SLOT_V, pa0, pa1, pa2, pa3);
        if (j == NT - 1 && ui + 1 < nun_wg) LOADQ(vcu + (ui + 1) * G);
        if (half == 1) VWAIT();
        SBAR(); ABAR();
        SEG_S();
      }
    }
#undef SEG_S
    EPI_PREFETCH(vcu + (nun_wg - 1) * G);
    pv_d0(o, vb0 + pslot * SLOT_V, pa0, pa1, pa2, pa3);
    EPILOGUE(vcu + (nun_wg - 1) * G);
    if (half == 0) ABAR();
  }
  asm volatile("s_waitcnt vmcnt(0)" ::: "memory"); __syncthreads();
#undef ABAR
#undef VWAIT
#undef DMA_TK
#undef DMA_TV
#undef LOADQ
#undef EPILOGUE
#undef EPI_PREFETCH
#undef KROW
#undef DMA_K
#undef DMA_V
#undef TILE_SYNC
#undef RESC
}
}


#define XB_TMO      128
#define XB_XCNT(j)  (256  + 64 * (j))
#define XB_XSUB(j)  (1280 + 64 * (j))
#define XB_XGEN(j)  (2304 + 64 * (j))
#define XB_TOP      3328
#define XB_TOPGEN   3392
#define XCD_BAR_WORDS 3456
#define XB_SPIN_CAP (1u << 22)
__device__ __forceinline__ unsigned xb_ld(unsigned* p)              { return __hip_atomic_load(p, __ATOMIC_RELAXED, __HIP_MEMORY_SCOPE_AGENT); }
__device__ __forceinline__ unsigned xb_add(unsigned* p, unsigned v) { return __hip_atomic_fetch_add(p, v, __ATOMIC_RELAXED, __HIP_MEMORY_SCOPE_AGENT); }
__device__ __forceinline__ unsigned xb_xcc_id() { return (unsigned)__builtin_amdgcn_s_getreg((3 << 11) | 20) & 0xFu; }
#define XB_SPIN(cond, bar) do { unsigned _sp = 0; while (cond) { __builtin_amdgcn_s_sleep(1); \
    if ((++_sp & 255u) == 0u) { if (xb_ld(&(bar)[XB_TMO])) break; if (_sp > XB_SPIN_CAP) { atomicAdd(&(bar)[XB_TMO], 1u); break; } } } } while (0)
struct XcdBarrier { unsigned* bar; unsigned x; volatile LAS unsigned* st; };
__device__ __forceinline__ XcdBarrier xcd_barrier_post(unsigned* bar, volatile LAS unsigned* st) {
    XcdBarrier b; b.bar = bar; b.x = xb_xcc_id(); b.st = st;
    if (threadIdx.x == 0) (void)xb_add(&bar[XB_XCNT(b.x)], 1u);
    return b;
}
__device__ __forceinline__ void xcd_barrier_complete(unsigned* bar, unsigned x, unsigned& nloc, unsigned& nx) {
    const unsigned G = gridDim.x;
    unsigned sum, cnt, mine, sp = 0u;
    for (;;) {
        sum = 0u; cnt = 0u; mine = 0u;
#pragma unroll
        for (unsigned j = 0; j < 16; ++j) { const unsigned c = xb_ld(&bar[XB_XCNT(j)]); sum += c; cnt += (c > 0u) ? 1u : 0u; mine = (j == x) ? c : mine; }
        if (sum == G) break;
        __builtin_amdgcn_s_sleep(1);
        if ((++sp & 255u) == 0u) { if (xb_ld(&bar[XB_TMO])) break; if (sp > XB_SPIN_CAP) { atomicAdd(&bar[XB_TMO], 1u); break; } }
    }
    nloc = mine > 0u ? mine : 1u; nx = cnt > 0u ? cnt : 1u;
}
__device__ __forceinline__ void xcd_barrier(const XcdBarrier& b) {
    asm volatile("s_waitcnt vmcnt(0)" ::: "memory");
    __syncthreads();
    if (threadIdx.x == 0) {
        unsigned* bar = b.bar;
        __builtin_amdgcn_s_waitcnt(0);
        unsigned nloc = b.st[0], nx = b.st[1];
        if (nloc == 0u) { xcd_barrier_complete(bar, b.x, nloc, nx); b.st[0] = nloc; b.st[1] = nx; }
        const unsigned old = xb_add(&bar[XB_XSUB(b.x)], 1u);
        const unsigned gen = old / nloc;
        if (old + 1u == (gen + 1u) * nloc) {
            __builtin_amdgcn_fence(__ATOMIC_RELEASE, "agent");
            asm volatile("s_waitcnt vmcnt(0)" ::: "memory");
            const unsigned og = xb_add(&bar[XB_TOP], 1u);
            const unsigned tg = og / nx;
            if (og + 1u == (tg + 1u) * nx) xb_add(&bar[XB_TOPGEN], 1u);
            else XB_SPIN(xb_ld(&bar[XB_TOPGEN]) == tg, bar);
            __builtin_amdgcn_fence(__ATOMIC_ACQUIRE, "agent");
            xb_add(&bar[XB_XGEN(b.x)], 1u);
            asm volatile("s_waitcnt vmcnt(0)" ::: "memory");
        } else {
            XB_SPIN(xb_ld(&bar[XB_XGEN(b.x)]) == gen, bar);
            __builtin_amdgcn_fence(__ATOMIC_ACQUIRE, "agent");
            asm volatile("s_waitcnt vmcnt(0)" ::: "memory");
        }
    }
    __syncthreads();
}
constexpr int NWAVES = 8;
constexpr int LDS_BYTES = 163840;
constexpr int N_PHASES = 12;
constexpr int MISC_OFF = 163840 - 256; static_assert(att::SHM_ATTN <= MISC_OFF, "LDS map");


struct Frame {
    LAS unsigned char* lds;
    int tid, lane, wave, gw, NGW, G;
    unsigned char* ws;
};

struct Args { const float* in[19]; float* out; unsigned char* ws; int ph_lo, ph_hi; };
struct TrDesc { const float* W; bf16_t* WT; const float* gk; int K, N, item; bool reorder; };
__device__ __forceinline__ void tr_load(const TrDesc& d, int lane, f32x4 (&wv)[8]) {
    const int nblk = d.N / 32, kb = d.item / nblk, nb = d.item % nblk, k0 = 64 * kb, n0 = 32 * nb;
#pragma unroll
    for (int i = 0; i < 8; ++i) wv[i] = *(const f32x4*)(d.W + (size_t)(k0 + 8 * i + (lane >> 3)) * d.N + n0 + (lane & 7) * 4);
}
__device__ __forceinline__ void tr_finish(const TrDesc& d, int lane, const f32x4 (&wv)[8], LAS float* scr) {
    const int nblk = d.N / 32, kb = d.item / nblk, nb = d.item % nblk, k0 = 64 * kb, n0 = 32 * nb;
    const int d0 = d.reorder ? (nb < 32 ? n0 : (nb < 34 ? n0 + 2048 : n0 - 64)) : n0;
#pragma unroll
    for (int i = 0; i < 8; ++i) { const int kk = 8 * i + (lane >> 3); f32x4 v = wv[i]; if (d.gk) v = v * d.gk[k0 + kk];
        LAS float* p = scr + kk * 33 + (lane & 7) * 4; p[0] = v[0]; p[1] = v[1]; p[2] = v[2]; p[3] = v[3]; }
    asm volatile("s_waitcnt lgkmcnt(0)" ::: "memory");
    const int c = lane & 7;
#pragma unroll
    for (int j = 0; j < 4; ++j) { const int n = (lane >> 3) + 8 * j; const LAS float* sp = scr + (8 * c) * 33 + n;
        u32x4 o; o.x = cvt_pk_bf16(sp[0 * 33], sp[1 * 33]); o.y = cvt_pk_bf16(sp[2 * 33], sp[3 * 33]); o.z = cvt_pk_bf16(sp[4 * 33], sp[5 * 33]); o.w = cvt_pk_bf16(sp[6 * 33], sp[7 * 33]);
        *(u32x4*)(d.WT + (size_t)(d0 + n) * d.K + k0 + 8 * c) = o; }
    asm volatile("s_waitcnt lgkmcnt(0)" ::: "memory");
}
constexpr int I_WIN = 32 * 128, I_WG = 4 * 8 * 16, I_WOUT = 32 * 64, I_WMLA = 32 * 98, I_WUQ = 8 * 96, I_WUKV = 8 * 128, I_WMO = 32 * 64;
constexpr int I_LIST0 = I_WIN + I_WG + I_WOUT, I_LIST1 = I_WMLA + I_WUQ + I_WUKV, I_LIST2 = I_WMO;
__device__ __forceinline__ TrDesc tr_desc(const Args& a, int list, int r) {
    unsigned char* ws = a.ws; TrDesc d; d.gk = nullptr; d.reorder = false;
    if (list == 0) {
        if (r < I_WIN) { d.W = a.in[8]; d.WT = (bf16_t*)(ws + WS_WIN); d.K = DM; d.N = 4096; d.item = r; return d; } r -= I_WIN;
        if (r < I_WG) { const int g = r / 128; d.W = a.in[9] + (size_t)g * 512 * 512; d.WT = (bf16_t*)(ws + WS_WG) + (size_t)g * 512 * 512; d.K = 512; d.N = 512; d.item = r % 128; return d; } r -= I_WG;
        d.W = a.in[12]; d.WT = (bf16_t*)(ws + WS_WOUT); d.K = DM; d.N = DM; d.item = r; return d;
    }
    if (list == 1) {
    if (r < I_WMLA) { d.W = a.in[13]; d.WT = (bf16_t*)(ws + WS_WMLA); d.K = DM; d.N = 3136; d.item = r; d.reorder = true; return d; } r -= I_WMLA;
    if (r < I_WUQ) { d.W = a.in[16]; d.WT = (bf16_t*)(ws + WS_WUQ); d.K = 512; d.N = 3072; d.item = r; d.gk = a.in[14]; return d; } r -= I_WUQ;
    { d.W = a.in[17]; d.WT = (bf16_t*)(ws + WS_WUKV); d.K = 512; d.N = 4096; d.item = r; d.gk = a.in[15]; return d; } }
    d.W = a.in[18]; d.WT = (bf16_t*)(ws + WS_WMO); d.K = DM; d.N = DM; d.item = r; return d;
}
__device__ __forceinline__ void tr_run(const Args& a, int list, int first, int stride, int lane, LAS float* scr, int n_end = -1) {
    const int n = n_end >= 0 ? n_end : (list == 0 ? I_LIST0 : (list == 1 ? I_LIST1 : I_LIST2));
    int it = first; if (it >= n) return;
    TrDesc d = tr_desc(a, list, it); f32x4 wv[8]; tr_load(d, lane, wv);
    for (;;) {
        const int nit = it + stride; const bool more = nit < n;
        TrDesc dn = d; f32x4 wn[8];
        if (more) { dn = tr_desc(a, list, nit); tr_load(dn, lane, wn); }
        tr_finish(d, lane, wv, scr);
        if (!more) break;
#pragma unroll
        for (int i = 0; i < 8; ++i) wv[i] = wn[i];
        d = dn; it = nit;
    }
}

__device__ __forceinline__ void gemv_item(const float* c, const float* c_ctx, const float* ada_w, const float* ada_b, float* mod, int it, int lane) {
    const int l = it / 768, rem = it % 768, kc = rem / 24, cgp = rem % 24, k0 = kc * 64;
    float s[9];
#pragma unroll
    for (int r = 0; r < 8; ++r) s[r] = silu_f(c[r * DM + k0 + lane]);
    s[8] = silu_f(c_ctx[k0 + lane]);
    const float* W = ada_w + (size_t)l * DM * 6144 + (size_t)k0 * 6144 + cgp * 256 + lane * 4;
    f32x4 acc[9];
#pragma unroll
    for (int r = 0; r < 9; ++r) acc[r] = (f32x4){0.f, 0.f, 0.f, 0.f};
#pragma unroll 16
    for (int kk = 0; kk < 64; ++kk) { const f32x4 w = *(const f32x4*)(W + (size_t)kk * 6144);
#pragma unroll
        for (int r = 0; r < 9; ++r) { const float sk = __uint_as_float(__builtin_amdgcn_readlane(__float_as_uint(s[r]), kk)); acc[r] += w * sk; } }
    const int col = cgp * 256 + lane * 4;
    f32x4 bv = (f32x4){0.f, 0.f, 0.f, 0.f};
    if (kc == 0) bv = *(const f32x4*)(ada_b + l * 6144 + col);
#pragma unroll
    for (int r = 0; r < 9; ++r) { float* m = mod + (size_t)(l * 9 + r) * 6144 + col;
#pragma unroll
        for (int j = 0; j < 4; ++j) atomicAdd(m + j, acc[r][j] + bv[j]); }
}

__device__ __forceinline__ void load_row_f32(const float* p, int lane, f32x4 (&v)[8]) {
#pragma unroll
    for (int j = 0; j < 8; ++j) v[j] = *(const f32x4*)(p + 4 * lane + 256 * j);
}
__device__ __forceinline__ float sumsq8(const f32x4 (&v)[8]) {
    float s = 0.f;
#pragma unroll
    for (int j = 0; j < 8; ++j) s += (v[j][0] * v[j][0] + v[j][1] * v[j][1]) + (v[j][2] * v[j][2] + v[j][3] * v[j][3]);
    return wave_sum(s);
}
__device__ __forceinline__ void modulate_store(const f32x4 (&v)[8], float rstd, const float* pn, const float* modr, bf16_t* orow, int lane) {
#pragma unroll
    for (int j = 0; j < 8; ++j) { const int col = 4 * lane + 256 * j;
        const f32x4 g = *(const f32x4*)(pn + col), sh = *(const f32x4*)(modr + col), sc = *(const f32x4*)(modr + DM + col);
        const f32x4 hh = v[j] * rstd * g * (sc + 1.f) + sh;
        u32x2 w; w.x = cvt_pk_bf16(hh[0], hh[1]); w.y = cvt_pk_bf16(hh[2], hh[3]);
        *(u32x2*)(orow + col) = w; }
}


template <int WIN> __device__ __forceinline__ void pool_chunk(const bf16_t* Ub, bf16_t* Pb, int t0, int L) {
    constexpr int LEFT = WIN / 2, RIGHT = WIN - 1 - LEFT, NR = 8 + WIN - 1;
    u32x4 rw[NR];
#pragma unroll
    for (int k = 0; k < NR; ++k) { const int t = t0 - LEFT + k; rw[k] = (t >= 0 && t < L) ? *(const u32x4*)(Ub + (size_t)t * DM) : (u32x4){0u, 0u, 0u, 0u}; }
    float S8[8];
#pragma unroll
    for (int e = 0; e < 8; ++e) S8[e] = 0.f;
#define ACC8(q_, sgn) do { const u32x4 a_ = (q_); S8[0] += sgn bf_lo(a_.x); S8[1] += sgn bf_hi(a_.x); S8[2] += sgn bf_lo(a_.y); S8[3] += sgn bf_hi(a_.y); \
                          S8[4] += sgn bf_lo(a_.z); S8[5] += sgn bf_hi(a_.z); S8[6] += sgn bf_lo(a_.w); S8[7] += sgn bf_hi(a_.w); } while (0)
#pragma unroll
    for (int k = 0; k < WIN; ++k) ACC8(rw[k], +);
#pragma unroll
    for (int i = 0; i < 8; ++i) { const int t = t0 + i; const int lo_ = t - LEFT < 0 ? 0 : t - LEFT, hi_ = t + RIGHT + 1 > L ? L : t + RIGHT + 1;
        const float inv = 1.f / (float)(hi_ - lo_); const u32x4 w = rw[i + LEFT];
        u32x4 o; o.x = cvt_pk_bf16(S8[0] * inv - bf_lo(w.x), S8[1] * inv - bf_hi(w.x)); o.y = cvt_pk_bf16(S8[2] * inv - bf_lo(w.y), S8[3] * inv - bf_hi(w.y));
        o.z = cvt_pk_bf16(S8[4] * inv - bf_lo(w.z), S8[5] * inv - bf_hi(w.z)); o.w = cvt_pk_bf16(S8[6] * inv - bf_lo(w.w), S8[7] * inv - bf_hi(w.w));
        *(u32x4*)(Pb + (size_t)t * DM) = o;
        if (i < 7) { ACC8(rw[i + WIN], +); ACC8(rw[i], -); } }
#undef ACC8
}

__global__ void __launch_bounds__(NWAVES * 64, 2) mk_fwd(Args args) {
    extern __shared__ __attribute__((aligned(16))) unsigned char lds[];
    cg::grid_group grid = cg::this_grid();
    Frame F;
    F.lds = (LAS unsigned char*)lds;
    F.tid = threadIdx.x; F.lane = F.tid & 63; F.wave = __builtin_amdgcn_readfirstlane(F.tid >> 6);
    F.G = gridDim.x; F.gw = blockIdx.x * NWAVES + F.wave; F.NGW = F.G * NWAVES; F.ws = args.ws;
    unsigned char* ws = args.ws;
    const int lo = args.ph_lo, hi = args.ph_hi;
#ifndef PHASE_MASK
#define PHASE_MASK 0xFFF
#endif
#define IN(k) (((PHASE_MASK >> (k)) & 1) && lo <= (k) && (k) < hi)
#ifndef DBL_MASK
#define DBL_MASK 0
#endif

#define SEAM(k) do { if (IN(k) && IN((k) + 1)) xcd_barrier(bar); } while (0)
    if (args.ph_hi > 4096) grid.sync();
    volatile LAS unsigned* MISC = (volatile LAS unsigned*)(F.lds + MISC_OFF);
    if (F.tid < 16) MISC[F.tid] = 0u;
    __syncthreads();
    XcdBarrier bar; bar.bar = (unsigned*)(args.ws + WS_BAR); bar.x = 0; bar.st = MISC;
    if (hi - lo > 1) bar = xcd_barrier_post((unsigned*)(args.ws + WS_BAR), MISC);
    const float* x = args.in[0]; const float* c = args.in[1]; const float* ctx = args.in[2]; const float* c_ctx = args.in[3];
    const float* ada_w = args.in[4]; const float* ada_b = args.in[5]; const float* pre_norm = args.in[6]; const float* post_norm = args.in[7];
    float* mod = (float*)(ws + WS_MOD); float* ssq = (float*)(ws + WS_SSQ); f32x2* tab = (f32x2*)(ws + WS_TAB);
    bf16_t* WIN = (bf16_t*)(ws + WS_WIN); bf16_t* WG = (bf16_t*)(ws + WS_WG); bf16_t* WOUT = (bf16_t*)(ws + WS_WOUT); bf16_t* WMLA = (bf16_t*)(ws + WS_WMLA);
    bf16_t* WUQ = (bf16_t*)(ws + WS_WUQ); bf16_t* WUKV = (bf16_t*)(ws + WS_WUKV); bf16_t* WMO = (bf16_t*)(ws + WS_WMO);
    bf16_t* H = (bf16_t*)(ws + WS_H); bf16_t* SG = (bf16_t*)(ws + WS_SG); bf16_t* Z = (bf16_t*)(ws + WS_Z); bf16_t* Y = (bf16_t*)(ws + WS_Y);
    bf16_t* U = (bf16_t*)(ws + WS_U); bf16_t* P = (bf16_t*)(ws + WS_P); bf16_t* Q = (bf16_t*)(ws + WS_Q); bf16_t* CQ = (bf16_t*)(ws + WS_CQ);
    bf16_t* CKV = (bf16_t*)(ws + WS_CKV); bf16_t* KR = (bf16_t*)(ws + WS_KR); bf16_t* KN = (bf16_t*)(ws + WS_KN); bf16_t* V = (bf16_t*)(ws + WS_V);
    const int NTHR = F.G * NWAVES * 64;
#define FRESH() int gtid; do { int t_ = threadIdx.x; asm volatile("" : "+v"(t_)); F.tid = t_; F.lane = t_ & 63; gtid = blockIdx.x * (NWAVES * 64) + t_; (void)gtid; } while (0)

    if (IN(0)) { FRESH();
        LAS float* scr = (LAS float*)(F.lds + F.wave * 16384);
        constexpr int I_GEMV = 2 * 32 * 24;
        if (F.G == 256) {
            if (F.wave < 3) gemv_item(c, c_ctx, ada_w, ada_b, mod, (int)blockIdx.x * 3 + F.wave, F.lane);
            const int b0 = (int)blockIdx.x * 26 + (F.wave < 3 ? F.wave * 2 : 6 + (F.wave - 3) * 4);
            tr_run(args, 0, b0, 1, F.lane, scr, b0 + (F.wave < 3 ? 2 : 4));
        } else {
            for (int it = F.gw; it < I_GEMV; it += F.NGW) gemv_item(c, c_ctx, ada_w, ada_b, mod, it, F.lane);
            tr_run(args, 0, F.gw, F.NGW, F.lane, scr); tr_run(args, 1, F.gw, F.NGW, F.lane, scr); tr_run(args, 2, F.gw, F.NGW, F.lane, scr);
        }
        for (int i = gtid; i < (NMLA - 3136) * DM / 8; i += NTHR) *(u32x4*)(WMLA + (size_t)3136 * DM + (size_t)i * 8) = (u32x4){0u, 0u, 0u, 0u};
        if (gtid < 1024) { const int pos = gtid >> 4, i = gtid & 15; const float fr = powf(10000.f, -(float)i / 16.f); const float ang = (float)pos * fr; float sn, cs; sincosf(ang, &sn, &cs); tab[gtid] = (f32x2){cs, sn}; }
    }
    SEAM(0);
    if (IN(1)) { FRESH();
        for (int row0 = F.gw * 3; row0 < MT; row0 += F.NGW * 3) {
            f32x4 v[3][8];
#pragma unroll
            for (int q = 0; q < 3; ++q) { const int row = row0 + q; const float* src = row < ML ? x + (size_t)row * DM : ctx + (size_t)(row - ML) * DM; load_row_f32(src, F.lane, v[q]); }
#pragma unroll
            for (int q = 0; q < 3; ++q) { const int row = row0 + q; const int r = row < ML ? row / SEQ : 8;
                const float rstd = __builtin_amdgcn_rsqf(sumsq8(v[q]) * (1.f / DM) + EPS);
                modulate_store(v[q], rstd, pre_norm, mod + (size_t)r * 6144, H + (size_t)row * DM, F.lane); }
        }
    }
    SEAM(1);
    if (IN(2)) {
        pg8::Gemm g{H, WIN, MT, 4096, DM, DM, DM, 0, 0}; pg8::StaticOrder S; S.init(MT, 4096, F.G, (int)blockIdx.x);
        pg8::EpiPoolIn E{U, SG};
        pg8::gemm_phase<pg8::EpiPoolIn>(F.lds, g, S, E);
        if (F.G == 256 && (int)blockIdx.x >= 128)
            tr_run(args, 1, ((int)blockIdx.x - 128) * NWAVES + F.wave, 128 * NWAVES, threadIdx.x & 63, (LAS float*)(F.lds + F.wave * 16384));
    }
    SEAM(2);
    if (IN(3)) { FRESH();
        for (int item = gtid; item < (MT / 8) * 256; item += NTHR) {
            const int cc = item & 255, row0 = (item >> 8) * 8;
            int base, L; if (row0 < ML) { base = row0 & ~(SEQ - 1); L = SEQ; } else { base = ML + ((row0 - ML) & ~(CTXL - 1)); L = CTXL; }
            const int t0 = row0 - base, gidx = cc >> 6;
            const bf16_t* Ub = U + (size_t)base * DM + cc * 8; bf16_t* Pb = P + (size_t)base * DM + cc * 8;
            switch (gidx) {
                case 0: pool_chunk<2>(Ub, Pb, t0, L); break;
                case 1: pool_chunk<4>(Ub, Pb, t0, L); break;
                case 2: pool_chunk<8>(Ub, Pb, t0, L); break;
                default: pool_chunk<16>(Ub, Pb, t0, L); break;
            }
        }
    }
    SEAM(3);
    if (IN(4)) {
        pg8::Gemm g{P, WG, MT, DM, 512, DM, 512, 2, 0}; pg8::StaticOrder S; S.init(MT, DM, F.G, (int)blockIdx.x);
        pg8::EpiGrp E{SG, Z, args.in[10], args.in[11]};
        pg8::gemm_phase<pg8::EpiGrp>(F.lds, g, S, E);
    }
    SEAM(4);
    if (IN(5)) {
        pg8::Gemm g{Z, WOUT, MT, DM, DM, DM, DM, 0, 0}; pg8::StaticOrder S; S.init(MT, DM, F.G, (int)blockIdx.x);
        pg8::EpiPlain E{Y, DM};
        pg8::gemm_phase<pg8::EpiPlain>(F.lds, g, S, E);
        if (F.G == 256 && (int)blockIdx.x >= 64) {
            const int lb = (int)blockIdx.x - 64;
            if (F.wave < 4) gemv_item(c, c_ctx, ada_w, ada_b, mod, 768 + lb * 4 + F.wave, threadIdx.x & 63);
            else tr_run(args, 2, lb * 4 + (F.wave - 4), 192 * 4, threadIdx.x & 63, (LAS float*)(F.lds + F.wave * 16384));
        }
    }
    SEAM(5);
    if (IN(6)) { FRESH();
        for (int row0 = F.gw * 3; row0 < MT; row0 += F.NGW * 3) {
            f32x4 v[3][8]; u32x2 yw[3][8];
#pragma unroll
            for (int q = 0; q < 3; ++q) { const int row = row0 + q; const float* src = row < ML ? x + (size_t)row * DM : ctx + (size_t)(row - ML) * DM; load_row_f32(src, F.lane, v[q]);
                const bf16_t* yr = Y + (size_t)row * DM;
#pragma unroll
                for (int j = 0; j < 8; ++j) yw[q][j] = *(const u32x2*)(yr + 4 * F.lane + 256 * j); }
#pragma unroll
            for (int q = 0; q < 3; ++q) { const int row = row0 + q; const bool lat = row < ML; const int r = lat ? row / SEQ : 8;
                float sy = 0.f;
#pragma unroll
                for (int j = 0; j < 8; ++j) { const float a = bf_lo(yw[q][j].x), b = bf_hi(yw[q][j].x), c2 = bf_lo(yw[q][j].y), d = bf_hi(yw[q][j].y); sy += (a * a + b * b) + (c2 * c2 + d * d); }
                const float rsy = __builtin_amdgcn_rsqf(wave_sum(sy) * (1.f / DM) + EPS);
                const float* m0 = mod + (size_t)r * 6144;
#pragma unroll
                for (int j = 0; j < 8; ++j) { const int col = 4 * F.lane + 256 * j; const f32x4 gt = *(const f32x4*)(m0 + 2 * DM + col), pn = *(const f32x4*)(post_norm + col);
                    const f32x4 y4 = (f32x4){bf_lo(yw[q][j].x), bf_hi(yw[q][j].x), bf_lo(yw[q][j].y), bf_hi(yw[q][j].y)};
                    v[q][j] = v[q][j] + gt * (y4 * rsy * pn);
                    if (lat) { u32x2 xw; xw.x = cvt_pk_bf16(v[q][j][0], v[q][j][1]); xw.y = cvt_pk_bf16(v[q][j][2], v[q][j][3]); *(u32x2*)(Z + (size_t)row * DM + col) = xw; } }
                const float rstd = __builtin_amdgcn_rsqf(sumsq8(v[q]) * (1.f / DM) + EPS);
                modulate_store(v[q], rstd, pre_norm + DM, mod + (size_t)(9 + r) * 6144, H + (size_t)row * DM, F.lane); }
        }
    }
    SEAM(6);
    if (IN(7)) {
        pg8::Gemm g{H, WMLA, MT, NMLA, DM, DM, DM, 0, 0}; pg8::StaticOrder S; S.init(MT, NMLA, F.G, (int)blockIdx.x);
        pg8::EpiMlaIn E{CQ, CKV, KR, SG, ssq, tab};
        pg8::gemm_phase<pg8::EpiMlaIn>(F.lds, g, S, E);
    }
    SEAM(7);
    if (IN(8)) {
        { pg8::Gemm g{CQ, WUQ, ML, 3072, 512, 512, 512, 0, 0}; pg8::StaticOrder S; S.init(ML, 3072, F.G, (int)blockIdx.x);
          pg8::EpiQ E{Q, ssq, tab};
          pg8::gemm_phase<pg8::EpiQ>(F.lds, g, S, E); }
        { pg8::Gemm g{CKV, WUKV, MT, 4096, 512, 512, 512, 0, 0}; pg8::StaticOrder S; S.init(MT, 4096, F.G, (int)blockIdx.x);
          pg8::EpiKV E{KN, V, ssq + MT};
          pg8::gemm_phase<pg8::EpiKV>(F.lds, g, S, E); }
    }
    SEAM(8);
    if (IN(9)) {
        const int bx = blockIdx.x, vcu = (F.G % 8 == 0) ? (bx % 8) * (F.G / 8) + bx / 8 : bx;
        att::attn_phase(Q, KN, KR, V, SG, Z, vcu, F.G, (char*)lds, F.lds);
    }
    SEAM(9);
    if (IN(10)) {
          pg8::Gemm g{Q, WMO, ML, DM, DM, 3072, DM, 0, 384}; pg8::StaticOrder S; S.init(ML, DM, F.G, (int)blockIdx.x);
        pg8::EpiPlain E{Y, DM};
        pg8::gemm_phase<pg8::EpiPlain>(F.lds, g, S, E);
    }
    SEAM(10);
    if (IN(11)) { FRESH();
        for (int row0 = F.gw * 2; row0 < ML; row0 += F.NGW * 2) {
            f32x4 v[2][8]; u32x2 yw[2][8];
#pragma unroll
            for (int q = 0; q < 2; ++q) { const int row = row0 + q;
#pragma unroll
                for (int j = 0; j < 8; ++j) { const u32x2 xw = *(const u32x2*)(Z + (size_t)row * DM + 4 * F.lane + 256 * j); v[q][j] = (f32x4){bf_lo(xw.x), bf_hi(xw.x), bf_lo(xw.y), bf_hi(xw.y)}; }
                const bf16_t* yr = Y + (size_t)row * DM;
#pragma unroll
                for (int j = 0; j < 8; ++j) yw[q][j] = *(const u32x2*)(yr + 4 * F.lane + 256 * j); }
#pragma unroll
            for (int q = 0; q < 2; ++q) { const int row = row0 + q; const int r = row / SEQ;
                float sy = 0.f;
#pragma unroll
                for (int j = 0; j < 8; ++j) { const float a = bf_lo(yw[q][j].x), b = bf_hi(yw[q][j].x), c2 = bf_lo(yw[q][j].y), d = bf_hi(yw[q][j].y); sy += (a * a + b * b) + (c2 * c2 + d * d); }
                const float rsy = __builtin_amdgcn_rsqf(wave_sum(sy) * (1.f / DM) + EPS);
                const float* m1 = mod + (size_t)(9 + r) * 6144;
#pragma unroll
                for (int j = 0; j < 8; ++j) { const int col = 4 * F.lane + 256 * j; const f32x4 gt = *(const f32x4*)(m1 + 2 * DM + col), pn = *(const f32x4*)(post_norm + DM + col);
                    const f32x4 y4 = (f32x4){bf_lo(yw[q][j].x), bf_hi(yw[q][j].x), bf_lo(yw[q][j].y), bf_hi(yw[q][j].y)};
                    *(f32x4*)(args.out + (size_t)row * DM + col) = v[q][j] + gt * (y4 * rsy * pn); }
            }
        }
    }
#undef IN
#undef SEAM
}

extern "C" void kernel_launch(void* const* d_in, const int* in_sizes, int n_in, void* d_out, int out_size, void* d_ws, size_t ws_size, hipStream_t stream) {
    static int grid = 0;
    if (grid == 0) {
        if (n_in != 19 || out_size != ML * DM || ws_size < WS_END) { fprintf(stderr, "kernel_launch: unexpected shapes (n_in %d out %d ws %zu)\n", n_in, out_size, ws_size); grid = -1; return; }
        int dev = 0, cus = 0, per_cu = 0;
        hipGetDevice(&dev); hipDeviceGetAttribute(&cus, hipDeviceAttributeMultiprocessorCount, dev);
        if (hipFuncSetAttribute((const void*)mk_fwd, hipFuncAttributeMaxDynamicSharedMemorySize, LDS_BYTES) != hipSuccess) { fprintf(stderr, "kernel_launch: hipFuncSetAttribute failed\n"); grid = -1; return; }
        hipOccupancyMaxActiveBlocksPerMultiprocessor(&per_cu, (const void*)mk_fwd, NWAVES * 64, LDS_BYTES);
        (void)hipGetLastError();
        if (per_cu < 1) per_cu = 1;
        grid = cus * 1;
        (void)per_cu;
    }
    if (grid < 0) return;
    hipMemsetAsync((char*)d_ws, 0, CTL_ZERO_BYTES, stream);
    Args a{};
    for (int i = 0; i < 19; ++i) a.in[i] = (const float*)d_in[i];
    a.out = (float*)d_out; a.ws = (unsigned char*)d_ws;
#if MK_N_LAUNCHES == 1
    a.ph_lo = 0; a.ph_hi = N_PHASES;
    void* kargs[] = {&a};
    hipError_t e = hipLaunchCooperativeKernel((const void*)mk_fwd, dim3(grid), dim3(NWAVES * 64), kargs, LDS_BYTES, stream);
    if (e != hipSuccess) fprintf(stderr, "cooperative launch failed: %s (grid %d)\n", hipGetErrorString(e), grid);
#else
    for (int p = 0; p < N_PHASES; ++p) for (int rep = 0; rep < (((DBL_MASK >> p) & 1) ? 2 : 1); ++rep) { a.ph_lo = p; a.ph_hi = p + 1; hipLaunchKernelGGL(mk_fwd, dim3(grid), dim3(NWAVES * 64), LDS_BYTES, stream, a); }
#endif
}
```

```cpp
#include <hip/hip_runtime.h>
#include <hip/hip_cooperative_groups.h>
#include <hip/hip_bf16.h>
#include <cstdio>
#include <cstdint>
namespace cg = cooperative_groups;

#ifndef MK_N_LAUNCHES
#define MK_N_LAUNCHES 1
#endif

#define LAS __attribute__((address_space(3)))
typedef unsigned short bf16_t;
typedef short bf16x8 __attribute__((ext_vector_type(8)));
typedef short s16x4 __attribute__((ext_vector_type(4)));
typedef float f32x4 __attribute__((ext_vector_type(4)));
typedef float f32x2 __attribute__((ext_vector_type(2)));
typedef float f32x16 __attribute__((ext_vector_type(16)));
typedef unsigned u32x4 __attribute__((ext_vector_type(4)));
typedef unsigned u32x2 __attribute__((ext_vector_type(2)));

constexpr int DM = 2048, NB = 8, SEQ = 2048, CTXL = 256;
constexpr int ML = NB * SEQ, MC = NB * CTXL, MT = ML + MC;
constexpr int NMLA = 3328;
constexpr float EPS = 1e-6f;
constexpr float QSCALE = 0.07216878364870322f * 1.4426950408889634f;

constexpr size_t MiB = 1u << 20;
constexpr size_t WS_MOD = 0;
constexpr size_t WS_SSQ = 512 * 1024;
constexpr size_t WS_BAR = 768 * 1024;
constexpr size_t CTL_ZERO_BYTES = 1 * MiB;
constexpr size_t WS_TAB = 1 * MiB;
constexpr size_t WS_WIN = 2 * MiB, WS_WG = 18 * MiB, WS_WOUT = 20 * MiB, WS_WMLA = 28 * MiB, WS_WUQ = 41 * MiB, WS_WUKV = 44 * MiB, WS_WMO = 48 * MiB;
constexpr size_t WS_H = 64 * MiB, WS_SG = 136 * MiB, WS_Z = 208 * MiB, WS_Y = 280 * MiB, WS_U = 352 * MiB, WS_P = 424 * MiB;
constexpr size_t WS_Q = 352 * MiB, WS_CQ = 448 * MiB, WS_CKV = 466 * MiB, WS_KR = 484 * MiB, WS_KN = WS_H, WS_V = WS_Y;
constexpr size_t WS_END = 496 * MiB;

__device__ __forceinline__ unsigned cvt_pk_bf16(float lo, float hi) { unsigned r; asm volatile("v_cvt_pk_bf16_f32 %0, %1, %2" : "=v"(r) : "v"(lo), "v"(hi)); return r; }
__device__ __forceinline__ float bf_lo(unsigned w) { return __uint_as_float(w << 16); }
__device__ __forceinline__ float bf_hi(unsigned w) { return __uint_as_float(w & 0xffff0000u); }
__device__ __forceinline__ float silu_f(float v) { return v * __builtin_amdgcn_rcpf(1.f + __builtin_amdgcn_exp2f(-1.4426950408889634f * v)); }
__device__ __forceinline__ float wave_sum(float v) {
#pragma unroll
    for (int o = 1; o < 64; o <<= 1) v += __shfl_xor(v, o);
    return v;
}

namespace pg8 {
constexpr int BM = 256, BK = 64, HALF = 128, HTB = HALF * BK * 2, STAGE_BYTES = 8 * HTB, NXCD = 8, WGM = 8;
__host__ __device__ __forceinline__ int lds_byte(int r, int c) { const int st = (r >> 4) * 2 + (c >> 5), rr = r & 15, cc = c & 31, ob = rr * 64 + cc * 2; return st * 1024 + (ob ^ (((ob >> 9) & 1) << 5)); }
__host__ __device__ __forceinline__ void stage_rc(int b, int& R, int& C) { const int st = b / 1024, sb = b % 1024, swz = sb ^ (((sb >> 9) & 1) << 5); R = (st >> 1) * 16 + swz / 64; C = (st & 1) * 32 + (swz % 64) / 2; }
__host__ __device__ __forceinline__ int perm32(int rho) { const int n = rho >> 4, i = rho & 15; return 8 * (i >> 2) + 4 * n + (i & 3); }

struct Unit { int pm, pn; };
struct Gemm { const bf16_t* A; const bf16_t* Bt; int M, N, K, lda, ldb, agrp; };

struct StaticOrder {
    int nM, nN, nwg, G, c;
    __host__ __device__ void init(int M, int N, int G_, int c_) { nM = M / BM; nN = N / BM; nwg = nM * nN; G = G_; c = c_; }
    __host__ __device__ bool next(int i, Unit& u) const {
        const long L = (long)i * G + c; if (L >= nwg) return false;
        int wgid = (int)L; { const int q = nwg / NXCD, r = nwg % NXCD, xcd = wgid % NXCD, off = wgid / NXCD; wgid = (xcd < r ? xcd * (q + 1) : r * (q + 1) + (xcd - r) * q) + off; }
        const int nig = WGM * nN, gid = wgid / nig, fm = gid * WGM, gsz = (nM - fm) < WGM ? (nM - fm) : WGM;
        u.pm = fm + ((wgid % nig) % gsz); u.pn = (wgid % nig) / gsz; return true;
    }
};

template <class Epi>
__device__ __forceinline__ void gemm_phase(LAS unsigned char* lds, const Gemm g, const StaticOrder& S, const Epi& E) {
    const int tid = threadIdx.x, wid = __builtin_amdgcn_readfirstlane(tid >> 6), lane = tid & 63, wr = wid >> 2, wc = wid & 3, fr = lane & 15, fq = lane >> 4;
    const int K = g.K, nt = K / BK;
    unsigned voffA[2], voffB[2];
#pragma unroll
    for (int i = 0; i < 2; ++i) { int R, C; stage_rc(tid * 16 + i * 8192, R, C); const int Rb = Epi::PERM ? ((R & ~31) + perm32(R & 31)) : R;
        voffA[i] = (unsigned)(R * g.lda + C) * 2u; voffB[i] = (unsigned)(Rb * g.ldb + C) * 2u; }
    const size_t kstep = (size_t)(BK * 2);
    const size_t hsA = (size_t)HALF * g.lda * 2, hsB = (size_t)HALF * g.ldb * 2;
    const size_t tsA = 2 * hsA, tsB = 2 * hsB;
    const unsigned ldsw = (unsigned)wid * 1024u;
    const int aoff = lds_byte(wr * 64 + fr, fq * 8), boff = lds_byte(wc * 32 + fr, fq * 8);
#define PG8_SA(b, h) (((b) * 2 + (h)) * HTB)
#define PG8_SB(b, h) ((4 + (b) * 2 + (h)) * HTB)
#define PG8_STAGE(bufoff, gbase, voff) do { _Pragma("unroll") for (int _i = 0; _i < 2; ++_i) \
        __builtin_amdgcn_global_load_lds((const unsigned*)((const char*)(gbase) + (voff)[_i]), (LAS unsigned*)(lds + (bufoff) + ldsw + _i * 8192), 16, 0, 0); } while (0)
#define PG8_LDA(dst, b, h) do { _Pragma("unroll") for (int m = 0; m < 4; ++m) _Pragma("unroll") for (int k = 0; k < 2; ++k) dst[m][k] = *(const LAS bf16x8*)(lds + PG8_SA(b, h) + aoff + m * 2048 + k * 1024); } while (0)
#define PG8_LDB(dst, b, h) do { _Pragma("unroll") for (int n = 0; n < 2; ++n) _Pragma("unroll") for (int k = 0; k < 2; ++k) dst[n][k] = *(const LAS bf16x8*)(lds + PG8_SB(b, h) + boff + n * 2048 + k * 1024); } while (0)
#define PG8_MMA(ai, bj, At, Bt) do { __builtin_amdgcn_s_setprio(1); _Pragma("unroll") for (int m = 0; m < 4; ++m) _Pragma("unroll") for (int n = 0; n < 2; ++n) _Pragma("unroll") for (int k = 0; k < 2; ++k) \
        acc[ai][bj][m][n] = __builtin_amdgcn_mfma_f32_16x16x32_bf16(Bt[n][k], At[m][k], acc[ai][bj][m][n], 0, 0, 0); __builtin_amdgcn_s_setprio(0); } while (0)
#define PG8_WAIT_V(n) asm volatile("s_waitcnt vmcnt(" #n ")" ::: "memory")
#define PG8_WAIT_L(n) asm volatile("s_waitcnt lgkmcnt(" #n ")" ::: "memory")
#define PG8_BAR __builtin_amdgcn_s_barrier()
#define PG8_SCHED __builtin_amdgcn_sched_barrier(0)
#define PG8_AOFF(u) ((g.agrp > 0) ? (size_t)((u).pn / g.agrp) * (size_t)K * 2 : (size_t)0)
    Unit cur, nxt; int ui = 0;
    if (!S.next(0, cur)) return;
    f32x4 acc[2][2][4][2];
#pragma unroll
    for (int a = 0; a < 2; ++a)
#pragma unroll
        for (int b = 0; b < 2; ++b)
#pragma unroll
            for (int m = 0; m < 4; ++m)
#pragma unroll
                for (int n = 0; n < 2; ++n) acc[a][b][m][n] = (f32x4){0.f, 0.f, 0.f, 0.f};
    bf16x8 At[4][2], B0[2][2], B1[2][2];
    const char* cA = (const char*)g.A + (size_t)cur.pm * tsA + PG8_AOFF(cur); const char* cB = (const char*)g.Bt + (size_t)cur.pn * tsB;
    PG8_STAGE(PG8_SB(0, 0), cB, voffB); PG8_STAGE(PG8_SB(0, 1), cB + hsB, voffB); PG8_STAGE(PG8_SA(0, 0), cA, voffA); PG8_STAGE(PG8_SA(0, 1), cA + hsA, voffA);
    if (wr == 1) PG8_BAR;
    PG8_WAIT_V(2); PG8_BAR;
    PG8_STAGE(PG8_SB(1, 0), cB + kstep, voffB); PG8_STAGE(PG8_SA(1, 0), cA + kstep, voffA); PG8_STAGE(PG8_SB(1, 1), cB + hsB + kstep, voffB);
    PG8_WAIT_V(6); PG8_BAR;
    for (;;) {
        const bool has_next = S.next(ui + 1, nxt);
        const char* nA = has_next ? (const char*)g.A + (size_t)nxt.pm * tsA + PG8_AOFF(nxt) : cA; const char* nB = has_next ? (const char*)g.Bt + (size_t)nxt.pn * tsB : cB;
        for (int t = 0; t < nt; t += 2) {
            const bool last = (t == nt - 2);
            const char* a1 = cA + (size_t)(t + 1) * kstep;
            const char* a2 = last ? nA : cA + (size_t)(t + 2) * kstep; const char* b2 = last ? nB : cB + (size_t)(t + 2) * kstep;
            const char* a3 = a2 + kstep; const char* b3 = b2 + kstep;
            PG8_LDB(B0, 0, 0); PG8_LDB(B1, 0, 1); PG8_SCHED; PG8_LDA(At, 0, 0); PG8_STAGE(PG8_SA(1, 1), a1 + hsA, voffA);
            PG8_WAIT_V(8); PG8_WAIT_L(0); PG8_BAR; PG8_MMA(0, 0, At, B0); PG8_MMA(0, 1, At, B1); PG8_BAR; PG8_SCHED;
            PG8_LDA(At, 0, 1); PG8_STAGE(PG8_SB(0, 0), b2, voffB); PG8_STAGE(PG8_SB(0, 1), b2 + hsB, voffB); PG8_STAGE(PG8_SA(0, 0), a2, voffA);
            PG8_WAIT_V(8); PG8_WAIT_L(0); PG8_BAR; PG8_MMA(1, 0, At, B0); PG8_MMA(1, 1, At, B1); PG8_BAR; PG8_SCHED;
            PG8_LDB(B0, 1, 0); PG8_LDB(B1, 1, 1); PG8_SCHED; PG8_LDA(At, 1, 0); PG8_STAGE(PG8_SA(0, 1), a2 + hsA, voffA);
            PG8_WAIT_V(8); PG8_WAIT_L(0); PG8_BAR; PG8_MMA(0, 0, At, B0); PG8_MMA(0, 1, At, B1); PG8_BAR; PG8_SCHED;
            PG8_LDA(At, 1, 1); PG8_STAGE(PG8_SB(1, 0), b3, voffB); PG8_STAGE(PG8_SB(1, 1), b3 + hsB, voffB); PG8_STAGE(PG8_SA(1, 0), a3, voffA);
            PG8_WAIT_V(8); PG8_WAIT_L(0); PG8_BAR; PG8_MMA(1, 0, At, B0); PG8_MMA(1, 1, At, B1); PG8_BAR; PG8_SCHED;
        }
        if (wr == 0) PG8_BAR;
        E(acc, cur, wr, wc, fr, fq);
        if (!has_next) break;
#pragma unroll
        for (int a = 0; a < 2; ++a)
#pragma unroll
            for (int b = 0; b < 2; ++b)
#pragma unroll
                for (int m = 0; m < 4; ++m)
#pragma unroll
                    for (int n = 0; n < 2; ++n) acc[a][b][m][n] = (f32x4){0.f, 0.f, 0.f, 0.f};
        cur = nxt; cA = nA; cB = nB; ++ui;
        if (wr == 1) PG8_BAR;
    }
    PG8_WAIT_V(0);
    PG8_BAR;
#undef PG8_SA
#undef PG8_SB
#undef PG8_STAGE
#undef PG8_LDA
#undef PG8_LDB
#undef PG8_MMA
#undef PG8_WAIT_V
#undef PG8_WAIT_L
#undef PG8_BAR
#undef PG8_SCHED
#undef PG8_AOFF
}

__device__ __forceinline__ u32x4 pack8(f32x4 v0, f32x4 v1) { u32x4 w; w.x = cvt_pk_bf16(v0[0], v0[1]); w.y = cvt_pk_bf16(v0[2], v0[3]); w.z = cvt_pk_bf16(v1[0], v1[1]); w.w = cvt_pk_bf16(v1[2], v1[3]); return w; }
__device__ __forceinline__ f32x4 silu4(f32x4 v) { return (f32x4){silu_f(v[0]), silu_f(v[1]), silu_f(v[2]), silu_f(v[3])}; }

struct EpiPlain {
    static constexpr bool PERM = true;
    bf16_t* O; int ldc;
    __device__ __forceinline__ void operator()(const f32x4 (&acc)[2][2][4][2], const Unit& u, int wr, int wc, int fr, int fq) const {
        const int row0 = u.pm * BM + wr * 64 + fr, col0 = u.pn * BM + wc * 32 + 8 * fq;
#pragma unroll
        for (int ai = 0; ai < 2; ++ai)
#pragma unroll
            for (int m = 0; m < 4; ++m) { bf16_t* rowp = O + (size_t)(row0 + ai * HALF + m * 16) * ldc + col0;
#pragma unroll
                for (int bj = 0; bj < 2; ++bj) *(u32x4*)(rowp + bj * HALF) = pack8(acc[ai][bj][m][0], acc[ai][bj][m][1]); }
    }
};
struct EpiPoolIn {
    static constexpr bool PERM = true;
    bf16_t* U; bf16_t* SG;
    __device__ __forceinline__ void operator()(const f32x4 (&acc)[2][2][4][2], const Unit& u, int wr, int wc, int fr, int fq) const {
        const int t = u.pn >> 3; bf16_t* base = t ? SG : U;
        const int row0 = u.pm * BM + wr * 64 + fr, col0 = (u.pn & 7) * BM + wc * 32 + 8 * fq;
#pragma unroll
        for (int ai = 0; ai < 2; ++ai)
#pragma unroll
            for (int m = 0; m < 4; ++m) { bf16_t* rowp = base + (size_t)(row0 + ai * HALF + m * 16) * DM + col0;
#pragma unroll
                for (int bj = 0; bj < 2; ++bj) { f32x4 v0 = acc[ai][bj][m][0], v1 = acc[ai][bj][m][1];
                    if (t) { v0 = silu4(v0); v1 = silu4(v1); }
                    *(u32x4*)(rowp + bj * HALF) = pack8(v0, v1); } }
    }
};
struct EpiGrp {
    static constexpr bool PERM = true;
    const bf16_t* SG; bf16_t* Z; const float* bias; const float* scale;
    __device__ __forceinline__ void operator()(const f32x4 (&acc)[2][2][4][2], const Unit& u, int wr, int wc, int fr, int fq) const {
        const int row0 = u.pm * BM + wr * 64 + fr, col0 = u.pn * BM + wc * 32 + 8 * fq;
        f32x4 bv[2][2], sv[2][2];
#pragma unroll
        for (int bj = 0; bj < 2; ++bj)
#pragma unroll
            for (int n = 0; n < 2; ++n) { bv[bj][n] = *(const f32x4*)(bias + col0 + bj * HALF + 4 * n); sv[bj][n] = *(const f32x4*)(scale + col0 + bj * HALF + 4 * n); }
#pragma unroll
        for (int ai = 0; ai < 2; ++ai)
#pragma unroll
            for (int m = 0; m < 4; ++m) { const size_t off = (size_t)(row0 + ai * HALF + m * 16) * DM + col0;
#pragma unroll
                for (int bj = 0; bj < 2; ++bj) { const u32x4 gw = *(const u32x4*)(SG + off + bj * HALF);
                    f32x4 v0 = (acc[ai][bj][m][0] + bv[bj][0]) * sv[bj][0], v1 = (acc[ai][bj][m][1] + bv[bj][1]) * sv[bj][1];
                    v0 = v0 * (f32x4){bf_lo(gw.x), bf_hi(gw.x), bf_lo(gw.y), bf_hi(gw.y)}; v1 = v1 * (f32x4){bf_lo(gw.z), bf_hi(gw.z), bf_lo(gw.w), bf_hi(gw.w)};
                    *(u32x4*)(Z + off + bj * HALF) = pack8(v0, v1); } }
    }
};
struct EpiMlaIn {
    static constexpr bool PERM = true;
    bf16_t *CQ, *CKV, *KR, *SG; float* ssq; const f32x2* tab;
    __device__ __forceinline__ void operator()(const f32x4 (&acc)[2][2][4][2], const Unit& u, int wr, int wc, int fr, int fq) const {
        const int pn = u.pn, row0 = u.pm * BM + wr * 64 + fr;
        if (pn < 4) {
            bf16_t* base = pn < 2 ? CQ : CKV; float* ss = ssq + (pn < 2 ? 0 : MT);
            const int col0 = (pn & 1) * BM + wc * 32 + 8 * fq;
#pragma unroll
            for (int ai = 0; ai < 2; ++ai)
#pragma unroll
                for (int m = 0; m < 4; ++m) { const int row = row0 + ai * HALF + m * 16; bf16_t* rowp = base + (size_t)row * 512 + col0; float s = 0.f;
#pragma unroll
                    for (int bj = 0; bj < 2; ++bj) { const f32x4 v0 = acc[ai][bj][m][0], v1 = acc[ai][bj][m][1];
                        s += (v0[0] * v0[0] + v0[1] * v0[1]) + (v0[2] * v0[2] + v0[3] * v0[3]) + (v1[0] * v1[0] + v1[1] * v1[1]) + (v1[2] * v1[2] + v1[3] * v1[3]);
                        *(u32x4*)(rowp + bj * HALF) = pack8(v0, v1); }
                    s += __shfl_xor(s, 16); s += __shfl_xor(s, 32);
                    if (fq == 0) atomicAdd(ss + row, s); }
        } else if (pn < 12) {
            if (u.pm < ML / BM) {
                const int col0 = (pn - 4) * BM + wc * 32 + 8 * fq;
#pragma unroll
                for (int ai = 0; ai < 2; ++ai)
#pragma unroll
                    for (int m = 0; m < 4; ++m) { bf16_t* rowp = SG + (size_t)(row0 + ai * HALF + m * 16) * DM + col0;
#pragma unroll
                        for (int bj = 0; bj < 2; ++bj) *(u32x4*)(rowp + bj * HALF) = pack8(silu4(acc[ai][bj][m][0]), silu4(acc[ai][bj][m][1])); }
            }
        } else {
            if (wc < 2) {
                const bool lat = u.pm < ML / BM;
#pragma unroll
                for (int ai = 0; ai < 2; ++ai)
#pragma unroll
                    for (int m = 0; m < 4; ++m) { const int row = row0 + ai * HALF + m * 16;
                        f32x4 v0 = acc[ai][0][m][0], v1 = acc[ai][0][m][1];
                        if (lat) {
                            const int t = row & (SEQ - 1), pos = wc == 0 ? (t >> 6) : (t & 63);
                            const f32x2* tp = tab + pos * 16 + 8 * (fq & 1);
                            f32x4 p0, p1;
#pragma unroll
                            for (int j = 0; j < 4; ++j) { p0[j] = __shfl_xor(v0[j], 32); p1[j] = __shfl_xor(v1[j], 32); }
                            const bool first = fq < 2;
#pragma unroll
                            for (int j = 0; j < 4; ++j) { const f32x2 c0 = tp[j], c1 = tp[4 + j];
                                v0[j] = first ? (v0[j] * c0.x - p0[j] * c0.y) : (p0[j] * c0.y + v0[j] * c0.x);
                                v1[j] = first ? (v1[j] * c1.x - p1[j] * c1.y) : (p1[j] * c1.y + v1[j] * c1.x); }
                        }
                        *(u32x4*)(KR + (size_t)row * 64 + wc * 32 + 8 * fq) = pack8(v0, v1); }
            }
        }
    }
};
struct EpiQ {
    static constexpr bool PERM = true;
    bf16_t* Q; const float* ssq; const f32x2* tab;
    __device__ __forceinline__ void operator()(const f32x4 (&acc)[2][2][4][2], const Unit& u, int wr, int wc, int fr, int fq) const {
        const int row0 = u.pm * BM + wr * 64 + fr; const bool first = fq < 2;
#pragma unroll
        for (int ai = 0; ai < 2; ++ai)
#pragma unroll
            for (int m = 0; m < 4; ++m) { const int row = row0 + ai * HALF + m * 16; const float rs = __builtin_amdgcn_rsqf(ssq[row] * (1.f / 512.f) + EPS) * QSCALE; const int t = row & (SEQ - 1);
#pragma unroll
                for (int bj = 0; bj < 2; ++bj) { const int gcol = u.pn * 8 + bj * 4 + wc, hg = gcol % 6;
                    f32x4 v0 = acc[ai][bj][m][0] * rs, v1 = acc[ai][bj][m][1] * rs;
                    if (hg >= 4) { const int pos = hg == 4 ? (t >> 6) : (t & 63); const f32x2* tp = tab + pos * 16 + 8 * (fq & 1);
                        f32x4 p0, p1;
#pragma unroll
                        for (int j = 0; j < 4; ++j) { p0[j] = __shfl_xor(v0[j], 32); p1[j] = __shfl_xor(v1[j], 32); }
#pragma unroll
                        for (int j = 0; j < 4; ++j) { const f32x2 c0 = tp[j], c1 = tp[4 + j];
                            v0[j] = first ? (v0[j] * c0.x - p0[j] * c0.y) : (p0[j] * c0.y + v0[j] * c0.x);
                            v1[j] = first ? (v1[j] * c1.x - p1[j] * c1.y) : (p1[j] * c1.y + v1[j] * c1.x); } }
                    *(u32x4*)(Q + (size_t)row * 3072 + gcol * 32 + 8 * fq) = pack8(v0, v1); } }
    }
};
struct EpiKV {
    static constexpr bool PERM = true;
    bf16_t* KN; bf16_t* V; const float* ssq;
    __device__ __forceinline__ void operator()(const f32x4 (&acc)[2][2][4][2], const Unit& u, int wr, int wc, int fr, int fq) const {
        const int row0 = u.pm * BM + wr * 64 + fr, col0 = u.pn * 128 + wc * 32 + 8 * fq;
#pragma unroll
        for (int ai = 0; ai < 2; ++ai)
#pragma unroll
            for (int m = 0; m < 4; ++m) { const int row = row0 + ai * HALF + m * 16; const float rs = __builtin_amdgcn_rsqf(ssq[row] * (1.f / 512.f) + EPS);
                *(u32x4*)(KN + (size_t)row * DM + col0) = pack8(acc[ai][0][m][0] * rs, acc[ai][0][m][1] * rs);
                *(u32x4*)(V + (size_t)row * DM + col0) = pack8(acc[ai][1][m][0] * rs, acc[ai][1][m][1] * rs); }
    }
};
}

namespace att {
constexpr int NW = 8, QBLK = 32, KVBLK = 64, NT = (CTXL + SEQ) / KVBLK;
constexpr int SHM_V = KVBLK * 128 * 2, SHM_K = KVBLK * 192 * 2;
#ifndef ATT_NQREG
#define ATT_NQREG 12
#endif
constexpr int NQREG = ATT_NQREG, SHM_QR = (12 - NQREG) * 8192, SHM_ATTN = 3 * SHM_V + 3 * SHM_K + NW * 64 * 4 + SHM_QR + NW * 4096;
constexpr float THRL = 8.f * 1.4426950408889634f;
#define KSWZ(row, colB) ((row) * 384 + ((colB) ^ (((row) & 7) << 4)))
#define SBAR() __builtin_amdgcn_sched_barrier(0)
__device__ __forceinline__ int crow(int r, int hi) { return (r & 3) + 8 * (r >> 2) + 4 * hi; }
__device__ __forceinline__ void partialSM(f32x16& p0, f32x16& p1, float& m_reg, float& mn, float& alpha) {
  float pmax = p0[0];
#pragma unroll
  for (int r = 1; r < 16; ++r) pmax = fmaxf(pmax, p0[r]);
#pragma unroll
  for (int r = 0; r < 16; ++r) pmax = fmaxf(pmax, p1[r]);
  { auto rr = __builtin_amdgcn_permlane32_swap(__float_as_uint(pmax), __float_as_uint(pmax), false, false);
    pmax = fmaxf(__uint_as_float(rr[0]), __uint_as_float(rr[1])); }
  if (__builtin_expect(__all(pmax - m_reg <= THRL), 1)) { mn = m_reg; alpha = 1.f; }
  else { mn = fmaxf(m_reg, pmax); alpha = __builtin_amdgcn_exp2f(m_reg - mn); m_reg = mn; }
#pragma unroll
  for (int r = 0; r < 16; ++r) p0[r] = p0[r] - mn;
#pragma unroll
  for (int r = 0; r < 16; ++r) p1[r] = p1[r] - mn;
#pragma unroll
  for (int r = 0; r < 16; ++r) p0[r] = __builtin_amdgcn_exp2f(p0[r]);
}
__device__ __forceinline__ void finishSM(f32x16& p0, f32x16& p1, float alpha, float& l_reg, bf16x8& pa0, bf16x8& pa1, bf16x8& pa2, bf16x8& pa3) {
#pragma unroll
  for (int r = 0; r < 16; ++r) p1[r] = __builtin_amdgcn_exp2f(p1[r]);
  float ps = 0;
#pragma unroll
  for (int r = 0; r < 16; ++r) ps += p0[r];
#pragma unroll
  for (int r = 0; r < 16; ++r) ps += p1[r];
  { auto rr = __builtin_amdgcn_permlane32_swap(__float_as_uint(ps), __float_as_uint(ps), false, false);
    ps = __uint_as_float(rr[0]) + __uint_as_float(rr[1]); }
  l_reg = l_reg * alpha + ps;
#define PK4(P, BASE, OUT) do { unsigned a0 = cvt_pk_bf16(P[BASE + 0], P[BASE + 1]), a1 = cvt_pk_bf16(P[BASE + 2], P[BASE + 3]);   \
    unsigned b0 = cvt_pk_bf16(P[BASE + 4], P[BASE + 5]), b1 = cvt_pk_bf16(P[BASE + 6], P[BASE + 7]);                              \
    auto r0 = __builtin_amdgcn_permlane32_swap(a0, b0, false, false); auto r1 = __builtin_amdgcn_permlane32_swap(a1, b1, false, false); \
    u32x4 w = {r0[0], r1[0], r0[1], r1[1]}; OUT = *reinterpret_cast<bf16x8*>(&w); } while (0)
  PK4(p0, 0, pa0); PK4(p0, 8, pa1); PK4(p1, 0, pa2); PK4(p1, 8, pa3);
#undef PK4
}
__device__ __forceinline__ void qkt(f32x16& p0, f32x16& p1, const char* Ks, const bf16x8* qr, const char* Qr, int kbase) {
  p0 = f32x16{}; p1 = f32x16{};
  const char* kb = Ks + kbase;
  bf16x8 k0[4], k1[4];
#define KLD(d) do { k0[(d) % 4] = *reinterpret_cast<const bf16x8*>(kb + (d) * 512); k1[(d) % 4] = *reinterpret_cast<const bf16x8*>(kb + 12288 + (d) * 512); } while (0)
  KLD(0); KLD(1); KLD(2);
  __builtin_amdgcn_s_setprio(1);
#pragma unroll
  for (int d0 = 0; d0 < 12; ++d0) {
    if (d0 + 3 < 12) KLD(d0 + 3);
    const bf16x8 qf = d0 < NQREG ? qr[d0 < NQREG ? d0 : 0] : *reinterpret_cast<const bf16x8*>(Qr + (d0 - NQREG) * 8192);
    p0 = __builtin_amdgcn_mfma_f32_32x32x16_bf16(k0[d0 % 4], qf, p0, 0, 0, 0);
    p1 = __builtin_amdgcn_mfma_f32_32x32x16_bf16(k1[d0 % 4], qf, p1, 0, 0, 0);
    SBAR(); }
  __builtin_amdgcn_s_setprio(0);
#undef KLD
}
__device__ __forceinline__ int v_st(int k, int c) { const int kk = (k & ~0xC) | ((k & 4) << 1) | ((k & 8) >> 1); return ((kk >> 3) * 4 + (c >> 5)) * 512 + ((kk & 7) * 32 + (c & 31)) * 2; }
__device__ __forceinline__ int v_rd_base(int lane) { return ((lane & 3) << 3) | (((lane >> 2) & 3) << 6) | (((lane >> 4) & 1) << 5) | (((lane >> 5) & 1) << 8); }
constexpr int v_rd_off(int d0, int ks, int half) { return d0 * 512 + ks * 4096 + half * 2048; }
template <int OFF> __device__ __forceinline__ s16x4 tr_read(int vb) {
  s16x4 r; asm volatile("ds_read_b64_tr_b16 %0, %1 offset:%2" : "=&v"(r) : "v"(vb), "i"(OFF) : "memory"); return r;
}
struct VFrag { s16x4 l0, h0, l1, h1, l2, h2, l3, h3; };
template <int D0> __device__ __forceinline__ void v_read8(VFrag& f, int vb) {
  f.l0 = tr_read<v_rd_off(D0, 0, 0)>(vb); f.h0 = tr_read<v_rd_off(D0, 0, 1)>(vb); f.l1 = tr_read<v_rd_off(D0, 1, 0)>(vb); f.h1 = tr_read<v_rd_off(D0, 1, 1)>(vb);
  f.l2 = tr_read<v_rd_off(D0, 2, 0)>(vb); f.h2 = tr_read<v_rd_off(D0, 2, 1)>(vb); f.l3 = tr_read<v_rd_off(D0, 3, 0)>(vb); f.h3 = tr_read<v_rd_off(D0, 3, 1)>(vb);
}
__device__ __forceinline__ void pv_mma(f32x16& od, const VFrag& f, bf16x8 pa0, bf16x8 pa1, bf16x8 pa2, bf16x8 pa3) {
#define PK(L, H) (bf16x8){L[0], L[1], L[2], L[3], H[0], H[1], H[2], H[3]}
  od = __builtin_amdgcn_mfma_f32_32x32x16_bf16(pa0, PK(f.l0, f.h0), od, 0, 0, 0);
  od = __builtin_amdgcn_mfma_f32_32x32x16_bf16(pa1, PK(f.l1, f.h1), od, 0, 0, 0);
  od = __builtin_amdgcn_mfma_f32_32x32x16_bf16(pa2, PK(f.l2, f.h2), od, 0, 0, 0);
  od = __builtin_amdgcn_mfma_f32_32x32x16_bf16(pa3, PK(f.l3, f.h3), od, 0, 0, 0);
#undef PK
}
__device__ __forceinline__ void pv_d0(f32x16* o, int vb, bf16x8 pa0, bf16x8 pa1, bf16x8 pa2, bf16x8 pa3) {
  VFrag fa, fb;
  v_read8<0>(fa, vb); v_read8<1>(fb, vb);
  asm volatile("s_waitcnt lgkmcnt(8)" ::: "memory"); SBAR(); pv_mma(o[0], fa, pa0, pa1, pa2, pa3); SBAR();
  v_read8<2>(fa, vb);
  asm volatile("s_waitcnt lgkmcnt(8)" ::: "memory"); SBAR(); pv_mma(o[1], fb, pa0, pa1, pa2, pa3); SBAR();
  v_read8<3>(fb, vb);
  asm volatile("s_waitcnt lgkmcnt(8)" ::: "memory"); SBAR(); pv_mma(o[2], fa, pa0, pa1, pa2, pa3); SBAR();
  asm volatile("s_waitcnt lgkmcnt(0)" ::: "memory"); SBAR(); pv_mma(o[3], fb, pa0, pa1, pa2, pa3); SBAR();
}
__device__ __forceinline__ void qkt_pv(f32x16& p0, f32x16& p1, const char* Ks, const bf16x8* qr, const char* Qr, int kbase, f32x16* o, int vb, bf16x8 pa0, bf16x8 pa1, bf16x8 pa2, bf16x8 pa3) {
  p0 = f32x16{}; p1 = f32x16{};
  const char* kb = Ks + kbase;
  bf16x8 k0[4], k1[4]; VFrag fa, fb;
#define KLD(d) do { k0[(d) % 4] = *reinterpret_cast<const bf16x8*>(kb + (d) * 512); k1[(d) % 4] = *reinterpret_cast<const bf16x8*>(kb + 12288 + (d) * 512); } while (0)
  KLD(0); KLD(1); KLD(2);
  __builtin_amdgcn_s_setprio(1);
#pragma unroll
  for (int d0 = 0; d0 < 12; ++d0) {
    if (d0 + 3 < 12) KLD(d0 + 3);
    if (d0 == 10) v_read8<0>(fa, vb);
    const bf16x8 qf = d0 < NQREG ? qr[d0 < NQREG ? d0 : 0] : *reinterpret_cast<const bf16x8*>(Qr + (d0 - NQREG) * 8192);
    p0 = __builtin_amdgcn_mfma_f32_32x32x16_bf16(k0[d0 % 4], qf, p0, 0, 0, 0);
    p1 = __builtin_amdgcn_mfma_f32_32x32x16_bf16(k1[d0 % 4], qf, p1, 0, 0, 0);
    SBAR(); }
#undef KLD
  v_read8<1>(fb, vb);
  asm volatile("s_waitcnt lgkmcnt(8)" ::: "memory"); SBAR(); pv_mma(o[0], fa, pa0, pa1, pa2, pa3); SBAR();
  v_read8<2>(fa, vb);
  asm volatile("s_waitcnt lgkmcnt(8)" ::: "memory"); SBAR(); pv_mma(o[1], fb, pa0, pa1, pa2, pa3); SBAR();
  v_read8<3>(fb, vb);
  asm volatile("s_waitcnt lgkmcnt(8)" ::: "memory"); SBAR(); pv_mma(o[2], fa, pa0, pa1, pa2, pa3); SBAR();
  asm volatile("s_waitcnt lgkmcnt(0)" ::: "memory"); SBAR(); pv_mma(o[3], fb, pa0, pa1, pa2, pa3); SBAR();
  __builtin_amdgcn_s_setprio(0);
}
constexpr int SLOT_K = SHM_K, SLOT_V = SHM_V, RING_BYTES = 3 * (SLOT_K + SLOT_V);
constexpr int NUNITS = NB * 16 * (SEQ / 256);
__device__ __forceinline__ void attn_phase(const bf16_t* __restrict__ Q, const bf16_t* __restrict__ KN, const bf16_t* __restrict__ KR, const bf16_t* __restrict__ V,
                                           const bf16_t* __restrict__ SG, bf16_t* __restrict__ Z, int vcu, int G, char* lds, LAS unsigned char* ldsl) {
  const int tid = threadIdx.x, wid = __builtin_amdgcn_readfirstlane(tid >> 6), lane = tid & 63, r32 = lane & 31, hi = lane >> 5;
  char* K_lds = lds; char* V_lds = lds + 3 * SLOT_K;
  float* wsf = (float*)(lds + RING_BYTES) + wid * 64; float* li_l = wsf; float* al_l = wsf + 32;
  char* Qr = lds + RING_BYTES + NW * 64 * 4 + tid * 16;
  const int vb0 = (int)(uintptr_t)V_lds + v_rd_base(lane);
  const int kbase = ((r32 >> 4) * 384 + (r32 & 15)) * 16 + hi * 256;
  int kofs[6], vofs[4]; bool krope[6];
  const int wq = wid & 3;
#pragma unroll
  for (int i = 0; i < 6; ++i) { const int p = 6 * wq + i, row = (p / 6) * 16 + (lane & 15), chunk = 4 * (p % 6) + (lane >> 4);
    krope[i] = chunk >= 16; kofs[i] = krope[i] ? row * 128 + (chunk - 16) * 16 : row * 4096 + chunk * 16; }
#pragma unroll
  for (int i = 0; i < 4; ++i) { const int B = (4 * wq + i) * 1024 + lane * 16, sub = B >> 9, within = (B & 511) >> 1, kk = (sub >> 2) * 8 + (within >> 5);
    const int k = (kk & ~0xC) | ((kk & 4) << 1) | ((kk & 8) >> 1), c = (sub & 3) * 32 + (within & 31); vofs[i] = k * 4096 + c * 2; }
#define KROW(j, b_) ((j) < 4 ? ML + (b_) * CTXL + (j) * KVBLK : (b_) * SEQ + ((j) - 4) * KVBLK)
#define DMA_K(j, b_, h_, slot) do { const int rb_ = KROW(j, b_); \
    const char* kn_ = (const char*)KN + (size_t)rb_ * 4096 + (h_) * 256; const char* kr_ = (const char*)KR + (size_t)rb_ * 128; \
    _Pragma("unroll") for (int i_ = 0; i_ < 6; ++i_) __builtin_amdgcn_global_load_lds((const unsigned*)((krope[i_] ? kr_ : kn_) + kofs[i_]), (LAS unsigned*)(ldsl + (slot) * SLOT_K + (6 * wq + i_) * 1024), 16, 0, 0); } while (0)
#define DMA_V(j, b_, h_, slot) do { const int rb_ = KROW(j, b_); const char* v_ = (const char*)V + (size_t)rb_ * 4096 + (h_) * 256; \
    _Pragma("unroll") for (int i_ = 0; i_ < 4; ++i_) __builtin_amdgcn_global_load_lds((const unsigned*)(v_ + vofs[i_]), (LAS unsigned*)(ldsl + 3 * SLOT_K + (slot) * SLOT_V + (4 * wq + i_) * 1024), 16, 0, 0); } while (0)
#define TILE_SYNC() do { asm volatile("s_waitcnt vmcnt(0)" ::: "memory"); __syncthreads(); } while (0)
#define RESC(a) do { if (__any((a) < 1.f)) { if (hi == 0) al_l[r32] = (a); asm volatile("s_waitcnt lgkmcnt(0)" ::: "memory"); \
    _Pragma("unroll") for (int d = 0; d < 4; ++d) _Pragma("unroll") for (int r = 0; r < 16; ++r) o[d][r] *= al_l[crow(r, hi)]; } } while (0)
  const int half = wid >> 2;
  const int nun_wg = vcu < NUNITS ? (NUNITS - 1 - vcu) / G + 1 : 0, T = nun_wg * NT;
#define ABAR() do { asm volatile("s_waitcnt lgkmcnt(0)" ::: "memory"); __builtin_amdgcn_s_barrier(); asm volatile("" ::: "memory"); } while (0)
#define VWAIT() asm volatile("s_waitcnt vmcnt(0)" ::: "memory")
#define DMA_TK(t_) do { const int ui_ = (t_) / NT, j_ = (t_) - ui_ * NT, un_ = vcu + ui_ * G; DMA_K(j_, (un_ >> 7), ((un_ >> 3) & 15), ((t_) % 3)); } while (0)
#define DMA_TV(t_) do { const int ui_ = (t_) / NT, j_ = (t_) - ui_ * NT, un_ = vcu + ui_ * G; DMA_V(j_, (un_ >> 7), ((un_ >> 3) & 15), ((t_) % 3)); } while (0)
#define LOADQ(un_) do { const int qb_ = (un_) & 7, h_ = ((un_) >> 3) & 15, b_ = (un_) >> 7; const bf16_t* Qw = Q + (size_t)(b_ * SEQ + qb_ * 256 + wid * QBLK + r32) * 3072 + h_ * 192 + hi * 8; \
    _Pragma("unroll") for (int d0 = 0; d0 < NQREG; ++d0) qr[d0] = *reinterpret_cast<const bf16x8*>(Qw + d0 * 16); \
    _Pragma("unroll") for (int d0 = NQREG; d0 < 12; ++d0) *reinterpret_cast<bf16x8*>(Qr + (d0 - NQREG) * 8192) = *reinterpret_cast<const bf16x8*>(Qw + d0 * 16); } while (0)
#define EPI_PREFETCH(un_) do { const int qb_ = (un_) & 7, h_ = ((un_) >> 3) & 15, b_ = (un_) >> 7; \
    const size_t ob = (size_t)(b_ * SEQ + qb_ * 256 + wid * QBLK + (lane >> 3)) * DM + h_ * 128 + (lane & 7) * 8; \
    _Pragma("unroll") for (int hf = 0; hf < 2; ++hf) _Pragma("unroll") for (int i4 = 0; i4 < 4; ++i4) gv[hf][i4] = *(const u32x4*)(SG + ob + (size_t)(i4 * 8) * DM + hf * 64); } while (0)
#define EPILOGUE(un_) do { const int qb_ = (un_) & 7, h_ = ((un_) >> 3) & 15, b_ = (un_) >> 7; \
    if (hi == 0) li_l[r32] = l_reg; asm volatile("s_waitcnt lgkmcnt(0)" ::: "memory"); \
    const size_t ob = (size_t)(b_ * SEQ + qb_ * 256 + wid * QBLK + (lane >> 3)) * DM + h_ * 128 + (lane & 7) * 8; \
    _Pragma("unroll") for (int hf = 0; hf < 2; ++hf) { \
      _Pragma("unroll") for (int r = 0; r < 16; ++r) { const float rl = __builtin_amdgcn_rcpf(li_l[crow(r, hi)]); \
        _Pragma("unroll") for (int dd = 0; dd < 2; ++dd) epi[crow(r, hi) * 64 + dd * 32 + r32] = (bf16_t)(cvt_pk_bf16(o[hf * 2 + dd][r] * rl, 0.f) & 0xffffu); } \
      asm volatile("s_waitcnt lgkmcnt(0)" ::: "memory"); \
      _Pragma("unroll") for (int i4 = 0; i4 < 4; ++i4) { const u32x4 ov = *(const u32x4*)(epi + (i4 * 8 + (lane >> 3)) * 64 + (lane & 7) * 8); \
        const size_t gi = ob + (size_t)(i4 * 8) * DM + hf * 64; const u32x4 gvv = gv[hf][i4]; u32x4 zv; \
        zv.x = cvt_pk_bf16(bf_lo(ov.x) * bf_lo(gvv.x), bf_hi(ov.x) * bf_hi(gvv.x)); zv.y = cvt_pk_bf16(bf_lo(ov.y) * bf_lo(gvv.y), bf_hi(ov.y) * bf_hi(gvv.y)); \
        zv.z = cvt_pk_bf16(bf_lo(ov.z) * bf_lo(gvv.z), bf_hi(ov.z) * bf_hi(gvv.z)); zv.w = cvt_pk_bf16(bf_lo(ov.w) * bf_lo(gvv.w), bf_hi(ov.w) * bf_hi(gvv.w)); \
        *(u32x4*)(Z + gi) = zv; } \
      asm volatile("s_waitcnt lgkmcnt(0)" ::: "memory"); } } while (0)
  bf16_t* epi = (bf16_t*)(lds + RING_BYTES + NW * 64 * 4 + SHM_QR + wid * 4096);
  if (T > 0) {
    float m_reg = -1e30f, l_reg = 0, mn, al; f32x16 o[4] = {}; bf16x8 qr[NQREG]; f32x16 p0, p1; bf16x8 pa0, pa1, pa2, pa3; u32x4 gv[2][4];
    if (half == 1) { DMA_TK(0); DMA_TK(1); } else { DMA_TV(0); DMA_TV(1); }
    LOADQ(vcu);
    VWAIT(); __syncthreads();
    if (half == 1) ABAR();
    int slot = 0, pslot = 2, t = 0;
#define SEG_S() do { const bool vis_ = (half == 0) && t >= 1 && t + 1 < T; \
      if (half == 1) { if (t + 2 < T) DMA_TK(t + 2); } else if (vis_) DMA_TV(t + 1); \
      partialSM(p0, p1, m_reg, mn, al); RESC(al); finishSM(p0, p1, al, l_reg, pa0, pa1, pa2, pa3); \
      if (half == 0) { if (vis_) asm volatile("s_waitcnt vmcnt(4)" ::: "memory"); else VWAIT(); } \
      SBAR(); ABAR(); pslot = slot; slot = slot == 2 ? 0 : slot + 1; ++t; } while (0)
    for (int ui = 0; ui < nun_wg; ++ui) {
      SBAR();
      if (ui > 0) {
        EPI_PREFETCH(vcu + (ui - 1) * G);
        pv_d0(o, vb0 + pslot * SLOT_V, pa0, pa1, pa2, pa3);
        EPILOGUE(vcu + (ui - 1) * G);
        m_reg = -1e30f; l_reg = 0;
#pragma unroll
        for (int d = 0; d < 4; ++d) o[d] = f32x16{};
      }
      qkt(p0, p1, K_lds + slot * SLOT_K, qr, Qr, kbase);
      if (half == 1) VWAIT();
      SBAR(); ABAR();
      SEG_S();
      for (int j = 1; j < NT; ++j) {
        SBAR();
        qkt_pv(p0, p1, K_lds + slot * SLOT_K, qr, Qr, kbase, o, vb0 + pslot * SLOT_V, pa0, pa1, pa2, pa3);
        if (j == NT - 1 && ui + 1 < nun_wg) LOADQ(vcu + (ui + 1) * G);
        if (half == 1) VWAIT();
        SBAR(); ABAR();
        SEG_S();
      }
    }
#undef SEG_S
    EPI_PREFETCH(vcu + (nun_wg - 1) * G);
    pv_d0(o, vb0 + pslot * SLOT_V, pa0, pa1, pa2, pa3);
    EPILOGUE(vcu + (nun_wg - 1) * G);
    if (half == 0) ABAR();
  }
  asm volatile("s_waitcnt vmcnt(0)" ::: "memory"); __syncthreads();
#undef ABAR
#undef VWAIT
#undef DMA_TK
#undef DMA_TV
#undef LOADQ
#undef EPILOGUE
#undef EPI_PREFETCH
#undef KROW
#undef DMA_K
#undef DMA_V
#undef TILE_SYNC
#undef RESC
}
}


#define XB_TMO      128
#define XB_XCNT(j)  (256  + 64 * (j))
#define XB_XSUB(j)  (1280 + 64 * (j))
#define XB_XGEN(j)  (2304 + 64 * (j))
#define XB_TOP      3328
#define XB_TOPGEN   3392
#define XCD_BAR_WORDS 3456
#define XB_SPIN_CAP (1u << 22)
__device__ __forceinline__ unsigned xb_ld(unsigned* p)              { return __hip_atomic_load(p, __ATOMIC_RELAXED, __HIP_MEMORY_SCOPE_AGENT); }
__device__ __forceinline__ unsigned xb_add(unsigned* p, unsigned v) { return __hip_atomic_fetch_add(p, v, __ATOMIC_RELAXED, __HIP_MEMORY_SCOPE_AGENT); }
__device__ __forceinline__ unsigned xb_xcc_id() { return (unsigned)__builtin_amdgcn_s_getreg((3 << 11) | 20) & 0xFu; }
#define XB_SPIN(cond, bar) do { unsigned _sp = 0; while (cond) { __builtin_amdgcn_s_sleep(1); \
    if ((++_sp & 255u) == 0u) { if (xb_ld(&(bar)[XB_TMO])) break; if (_sp > XB_SPIN_CAP) { atomicAdd(&(bar)[XB_TMO], 1u); break; } } } } while (0)
struct XcdBarrier { unsigned* bar; unsigned x; volatile LAS unsigned* st; };
__device__ __forceinline__ XcdBarrier xcd_barrier_post(unsigned* bar, volatile LAS unsigned* st) {
    XcdBarrier b; b.bar = bar; b.x = xb_xcc_id(); b.st = st;
    if (threadIdx.x == 0) (void)xb_add(&bar[XB_XCNT(b.x)], 1u);
    return b;
}
__device__ __forceinline__ void xcd_barrier_complete(unsigned* bar, unsigned x, unsigned& nloc, unsigned& nx) {
    const unsigned G = gridDim.x;
    unsigned sum, cnt, mine, sp = 0u;
    for (;;) {
        sum = 0u; cnt = 0u; mine = 0u;
#pragma unroll
        for (unsigned j = 0; j < 16; ++j) { const unsigned c = xb_ld(&bar[XB_XCNT(j)]); sum += c; cnt += (c > 0u) ? 1u : 0u; mine = (j == x) ? c : mine; }
        if (sum == G) break;
        __builtin_amdgcn_s_sleep(1);
        if ((++sp & 255u) == 0u) { if (xb_ld(&bar[XB_TMO])) break; if (sp > XB_SPIN_CAP) { atomicAdd(&bar[XB_TMO], 1u); break; } }
    }
    nloc = mine > 0u ? mine : 1u; nx = cnt > 0u ? cnt : 1u;
}
__device__ __forceinline__ void xcd_barrier(const XcdBarrier& b) {
    asm volatile("s_waitcnt vmcnt(0)" ::: "memory");
    __syncthreads();
    if (threadIdx.x == 0) {
        unsigned* bar = b.bar;
        __builtin_amdgcn_s_waitcnt(0);
        unsigned nloc = b.st[0], nx = b.st[1];
        if (nloc == 0u) { xcd_barrier_complete(bar, b.x, nloc, nx); b.st[0] = nloc; b.st[1] = nx; }
        const unsigned old = xb_add(&bar[XB_XSUB(b.x)], 1u);
        const unsigned gen = old / nloc;
        if (old + 1u == (gen + 1u) * nloc) {
            __builtin_amdgcn_fence(__ATOMIC_RELEASE, "agent");
            asm volatile("s_waitcnt vmcnt(0)" ::: "memory");
            const unsigned og = xb_add(&bar[XB_TOP], 1u);
            const unsigned tg = og / nx;
            if (og + 1u == (tg + 1u) * nx) xb_add(&bar[XB_TOPGEN], 1u);
            else XB_SPIN(xb_ld(&bar[XB_TOPGEN]) == tg, bar);
            __builtin_amdgcn_fence(__ATOMIC_ACQUIRE, "agent");
            xb_add(&bar[XB_XGEN(b.x)], 1u);
            asm volatile("s_waitcnt vmcnt(0)" ::: "memory");
        } else {
            XB_SPIN(xb_ld(&bar[XB_XGEN(b.x)]) == gen, bar);
            __builtin_amdgcn_fence(__ATOMIC_ACQUIRE, "agent");
            asm volatile("s_waitcnt vmcnt(0)" ::: "memory");
        }
    }
    __syncthreads();
}
constexpr int NWAVES = 8;
constexpr int LDS_BYTES = 163840;
constexpr int N_PHASES = 12;
constexpr int MISC_OFF = 163840 - 256; static_assert(att::SHM_ATTN <= MISC_OFF, "LDS map");


struct Frame {
    LAS unsigned char* lds;
    int tid, lane, wave, gw, NGW, G;
    unsigned char* ws;
};

struct Args { const float* in[19]; float* out; unsigned char* ws; int ph_lo, ph_hi; };
struct TrDesc { const float* W; bf16_t* WT; const float* gk; int K, N, item; bool reorder; };
__device__ __forceinline__ void tr_load(const TrDesc& d, int lane, f32x4 (&wv)[8]) {
    const int nblk = d.N / 32, kb = d.item / nblk, nb = d.item % nblk, k0 = 64 * kb, n0 = 32 * nb;
#pragma unroll
    for (int i = 0; i < 8; ++i) wv[i] = *(const f32x4*)(d.W + (size_t)(k0 + 8 * i + (lane >> 3)) * d.N + n0 + (lane & 7) * 4);
}
__device__ __forceinline__ void tr_finish(const TrDesc& d, int lane, const f32x4 (&wv)[8], LAS float* scr) {
    const int nblk = d.N / 32, kb = d.item / nblk, nb = d.item % nblk, k0 = 64 * kb, n0 = 32 * nb;
    const int d0 = d.reorder ? (nb < 32 ? n0 : (nb < 34 ? n0 + 2048 : n0 - 64)) : n0;
#pragma unroll
    for (int i = 0; i < 8; ++i) { const int kk = 8 * i + (lane >> 3); f32x4 v = wv[i]; if (d.gk) v = v * d.gk[k0 + kk];
        LAS float* p = scr + kk * 33 + (lane & 7) * 4; p[0] = v[0]; p[1] = v[1]; p[2] = v[2]; p[3] = v[3]; }
    asm volatile("s_waitcnt lgkmcnt(0)" ::: "memory");
    const int c = lane & 7;
#pragma unroll
    for (int j = 0; j < 4; ++j) { const int n = (lane >> 3) + 8 * j; const LAS float* sp = scr + (8 * c) * 33 + n;
        u32x4 o; o.x = cvt_pk_bf16(sp[0 * 33], sp[1 * 33]); o.y = cvt_pk_bf16(sp[2 * 33], sp[3 * 33]); o.z = cvt_pk_bf16(sp[4 * 33], sp[5 * 33]); o.w = cvt_pk_bf16(sp[6 * 33], sp[7 * 33]);
        *(u32x4*)(d.WT + (size_t)(d0 + n) * d.K + k0 + 8 * c) = o; }
    asm volatile("s_waitcnt lgkmcnt(0)" ::: "memory");
}
constexpr int I_WIN = 32 * 128, I_WG = 4 * 8 * 16, I_WOUT = 32 * 64, I_WMLA = 32 * 98, I_WUQ = 8 * 96, I_WUKV = 8 * 128, I_WMO = 32 * 64;
constexpr int I_LIST0 = I_WIN + I_WG + I_WOUT, I_LIST1 = I_WMLA + I_WUQ + I_WUKV, I_LIST2 = I_WMO;
__device__ __forceinline__ TrDesc tr_desc(const Args& a, int list, int r) {
    unsigned char* ws = a.ws; TrDesc d; d.gk = nullptr; d.reorder = false;
    if (list == 0) {
        if (r < I_WIN) { d.W = a.in[8]; d.WT = (bf16_t*)(ws + WS_WIN); d.K = DM; d.N = 4096; d.item = r; return d; } r -= I_WIN;
        if (r < I_WG) { const int g = r / 128; d.W = a.in[9] + (size_t)g * 512 * 512; d.WT = (bf16_t*)(ws + WS_WG) + (size_t)g * 512 * 512; d.K = 512; d.N = 512; d.item = r % 128; return d; } r -= I_WG;
        d.W = a.in[12]; d.WT = (bf16_t*)(ws + WS_WOUT); d.K = DM; d.N = DM; d.item = r; return d;
    }
    if (list == 1) {
    if (r < I_WMLA) { d.W = a.in[13]; d.WT = (bf16_t*)(ws + WS_WMLA); d.K = DM; d.N = 3136; d.item = r; d.reorder = true; return d; } r -= I_WMLA;
    if (r < I_WUQ) { d.W = a.in[16]; d.WT = (bf16_t*)(ws + WS_WUQ); d.K = 512; d.N = 3072; d.item = r; d.gk = a.in[14]; return d; } r -= I_WUQ;
    { d.W = a.in[17]; d.WT = (bf16_t*)(ws + WS_WUKV); d.K = 512; d.N = 4096; d.item = r; d.gk = a.in[15]; return d; } }
    d.W = a.in[18]; d.WT = (bf16_t*)(ws + WS_WMO); d.K = DM; d.N = DM; d.item = r; return d;
}
__device__ __forceinline__ void tr_run(const Args& a, int list, int first, int stride, int lane, LAS float* scr, int n_end = -1) {
    const int n = n_end >= 0 ? n_end : (list == 0 ? I_LIST0 : (list == 1 ? I_LIST1 : I_LIST2));
    int it = first; if (it >= n) return;
    TrDesc d = tr_desc(a, list, it); f32x4 wv[8]; tr_load(d, lane, wv);
    for (;;) {
        const int nit = it + stride; const bool more = nit < n;
        TrDesc dn = d; f32x4 wn[8];
        if (more) { dn = tr_desc(a, list, nit); tr_load(dn, lane, wn); }
        tr_finish(d, lane, wv, scr);
        if (!more) break;
#pragma unroll
        for (int i = 0; i < 8; ++i) wv[i] = wn[i];
        d = dn; it = nit;
    }
}

__device__ __forceinline__ void gemv_item(const float* c, const float* c_ctx, const float* ada_w, const float* ada_b, float* mod, int it, int lane) {
    const int l = it / 768, rem = it % 768, kc = rem / 24, cgp = rem % 24, k0 = kc * 64;
    float s[9];
#pragma unroll
    for (int r = 0; r < 8; ++r) s[r] = silu_f(c[r * DM + k0 + lane]);
    s[8] = silu_f(c_ctx[k0 + lane]);
    const float* W = ada_w + (size_t)l * DM * 6144 + (size_t)k0 * 6144 + cgp * 256 + lane * 4;
    f32x4 acc[9];
#pragma unroll
    for (int r = 0; r < 9; ++r) acc[r] = (f32x4){0.f, 0.f, 0.f, 0.f};
#pragma unroll 16
    for (int kk = 0; kk < 64; ++kk) { const f32x4 w = *(const f32x4*)(W + (size_t)kk * 6144);
#pragma unroll
        for (int r = 0; r < 9; ++r) { const float sk = __uint_as_float(__builtin_amdgcn_readlane(__float_as_uint(s[r]), kk)); acc[r] += w * sk; } }
    const int col = cgp * 256 + lane * 4;
    f32x4 bv = (f32x4){0.f, 0.f, 0.f, 0.f};
    if (kc == 0) bv = *(const f32x4*)(ada_b + l * 6144 + col);
#pragma unroll
    for (int r = 0; r < 9; ++r) { float* m = mod + (size_t)(l * 9 + r) * 6144 + col;
#pragma unroll
        for (int j = 0; j < 4; ++j) atomicAdd(m + j, acc[r][j] + bv[j]); }
}

__device__ __forceinline__ void load_row_f32(const float* p, int lane, f32x4 (&v)[8]) {
#pragma unroll
    for (int j = 0; j < 8; ++j) v[j] = *(const f32x4*)(p + 4 * lane + 256 * j);
}
__device__ __forceinline__ float sumsq8(const f32x4 (&v)[8]) {
    float s = 0.f;
#pragma unroll
    for (int j = 0; j < 8; ++j) s += (v[j][0] * v[j][0] + v[j][1] * v[j][1]) + (v[j][2] * v[j][2] + v[j][3] * v[j][3]);
    return wave_sum(s);
}
__device__ __forceinline__ void modulate_store(const f32x4 (&v)[8], float rstd, const float* pn, const float* modr, bf16_t* orow, int lane) {
#pragma unroll
    for (int j = 0; j < 8; ++j) { const int col = 4 * lane + 256 * j;
        const f32x4 g = *(const f32x4*)(pn + col), sh = *(const f32x4*)(modr + col), sc = *(const f32x4*)(modr + DM + col);
        const f32x4 hh = v[j] * rstd * g * (sc + 1.f) + sh;
        u32x2 w; w.x = cvt_pk_bf16(hh[0], hh[1]); w.y = cvt_pk_bf16(hh[2], hh[3]);
        *(u32x2*)(orow + col) = w; }
}


template <int WIN> __device__ __forceinline__ void pool_chunk(const bf16_t* Ub, bf16_t* Pb, int t0, int L) {
    constexpr int LEFT = WIN / 2, RIGHT = WIN - 1 - LEFT, NR = 8 + WIN - 1;
    u32x4 rw[NR];
#pragma unroll
    for (int k = 0; k < NR; ++k) { const int t = t0 - LEFT + k; rw[k] = (t >= 0 && t < L) ? *(const u32x4*)(Ub + (size_t)t * DM) : (u32x4){0u, 0u, 0u, 0u}; }
    float S8[8];
#pragma unroll
    for (int e = 0; e < 8; ++e) S8[e] = 0.f;
#define ACC8(q_, sgn) do { const u32x4 a_ = (q_); S8[0] += sgn bf_lo(a_.x); S8[1] += sgn bf_hi(a_.x); S8[2] += sgn bf_lo(a_.y); S8[3] += sgn bf_hi(a_.y); \
                          S8[4] += sgn bf_lo(a_.z); S8[5] += sgn bf_hi(a_.z); S8[6] += sgn bf_lo(a_.w); S8[7] += sgn bf_hi(a_.w); } while (0)
#pragma unroll
    for (int k = 0; k < WIN; ++k) ACC8(rw[k], +);
#pragma unroll
    for (int i = 0; i < 8; ++i) { const int t = t0 + i; const int lo_ = t - LEFT < 0 ? 0 : t - LEFT, hi_ = t + RIGHT + 1 > L ? L : t + RIGHT + 1;
        const float inv = 1.f / (float)(hi_ - lo_); const u32x4 w = rw[i + LEFT];
        u32x4 o; o.x = cvt_pk_bf16(S8[0] * inv - bf_lo(w.x), S8[1] * inv - bf_hi(w.x)); o.y = cvt_pk_bf16(S8[2] * inv - bf_lo(w.y), S8[3] * inv - bf_hi(w.y));
        o.z = cvt_pk_bf16(S8[4] * inv - bf_lo(w.z), S8[5] * inv - bf_hi(w.z)); o.w = cvt_pk_bf16(S8[6] * inv - bf_lo(w.w), S8[7] * inv - bf_hi(w.w));
        *(u32x4*)(Pb + (size_t)t * DM) = o;
        if (i < 7) { ACC8(rw[i + WIN], +); ACC8(rw[i], -); } }
#undef ACC8
}

__global__ void __launch_bounds__(NWAVES * 64, 2) mk_fwd(Args args) {
    extern __shared__ __attribute__((aligned(16))) unsigned char lds[];
    cg::grid_group grid = cg::this_grid();
    Frame F;
    F.lds = (LAS unsigned char*)lds;
    F.tid = threadIdx.x; F.lane = F.tid & 63; F.wave = __builtin_amdgcn_readfirstlane(F.tid >> 6);
    F.G = gridDim.x; F.gw = blockIdx.x * NWAVES + F.wave; F.NGW = F.G * NWAVES; F.ws = args.ws;
    unsigned char* ws = args.ws;
    const int lo = args.ph_lo, hi = args.ph_hi;
#ifndef PHASE_MASK
#define PHASE_MASK 0xFFF
#endif
#define IN(k) (((PHASE_MASK >> (k)) & 1) && lo <= (k) && (k) < hi)
#ifndef DBL_MASK
#define DBL_MASK 0
#endif

#define SEAM(k) do { if (IN(k) && IN((k) + 1)) xcd_barrier(bar); } while (0)
    if (args.ph_hi > 4096) grid.sync();
    volatile LAS unsigned* MISC = (volatile LAS unsigned*)(F.lds + MISC_OFF);
    if (F.tid < 16) MISC[F.tid] = 0u;
    __syncthreads();
    XcdBarrier bar; bar.bar = (unsigned*)(args.ws + WS_BAR); bar.x = 0; bar.st = MISC;
    if (hi - lo > 1) bar = xcd_barrier_post((unsigned*)(args.ws + WS_BAR), MISC);
    const float* x = args.in[0]; const float* c = args.in[1]; const float* ctx = args.in[2]; const float* c_ctx = args.in[3];
    const float* ada_w = args.in[4]; const float* ada_b = args.in[5]; const float* pre_norm = args.in[6]; const float* post_norm = args.in[7];
    float* mod = (float*)(ws + WS_MOD); float* ssq = (float*)(ws + WS_SSQ); f32x2* tab = (f32x2*)(ws + WS_TAB);
    bf16_t* WIN = (bf16_t*)(ws + WS_WIN); bf16_t* WG = (bf16_t*)(ws + WS_WG); bf16_t* WOUT = (bf16_t*)(ws + WS_WOUT); bf16_t* WMLA = (bf16_t*)(ws + WS_WMLA);
    bf16_t* WUQ = (bf16_t*)(ws + WS_WUQ); bf16_t* WUKV = (bf16_t*)(ws + WS_WUKV); bf16_t* WMO = (bf16_t*)(ws + WS_WMO);
    bf16_t* H = (bf16_t*)(ws + WS_H); bf16_t* SG = (bf16_t*)(ws + WS_SG); bf16_t* Z = (bf16_t*)(ws + WS_Z); bf16_t* Y = (bf16_t*)(ws + WS_Y);
    bf16_t* U = (bf16_t*)(ws + WS_U); bf16_t* P = (bf16_t*)(ws + WS_P); bf16_t* Q = (bf16_t*)(ws + WS_Q); bf16_t* CQ = (bf16_t*)(ws + WS_CQ);
    bf16_t* CKV = (bf16_t*)(ws + WS_CKV); bf16_t* KR = (bf16_t*)(ws + WS_KR); bf16_t* KN = (bf16_t*)(ws + WS_KN); bf16_t* V = (bf16_t*)(ws + WS_V);
    const int NTHR = F.G * NWAVES * 64;
#define FRESH() int gtid; do { int t_ = threadIdx.x; asm volatile("" : "+v"(t_)); F.tid = t_; F.lane = t_ & 63; gtid = blockIdx.x * (NWAVES * 64) + t_; (void)gtid; } while (0)

    if (IN(0)) { FRESH();
        LAS float* scr = (LAS float*)(F.lds + F.wave * 16384);
        constexpr int I_GEMV = 2 * 32 * 24;
        if (F.G == 256) {
            if (F.wave < 3) gemv_item(c, c_ctx, ada_w, ada_b, mod, (int)blockIdx.x * 3 + F.wave, F.lane);
            const int b0 = (int)blockIdx.x * 26 + (F.wave < 3 ? F.wave * 2 : 6 + (F.wave - 3) * 4);
            tr_run(args, 0, b0, 1, F.lane, scr, b0 + (F.wave < 3 ? 2 : 4));
        } else {
            for (int it = F.gw; it < I_GEMV; it += F.NGW) gemv_item(c, c_ctx, ada_w, ada_b, mod, it, F.lane);
            tr_run(args, 0, F.gw, F.NGW, F.lane, scr); tr_run(args, 1, F.gw, F.NGW, F.lane, scr); tr_run(args, 2, F.gw, F.NGW, F.lane, scr);
        }
        for (int i = gtid; i < (NMLA - 3136) * DM / 8; i += NTHR) *(u32x4*)(WMLA + (size_t)3136 * DM + (size_t)i * 8) = (u32x4){0u, 0u, 0u, 0u};
        if (gtid < 1024) { const int pos = gtid >> 4, i = gtid & 15; const float fr = powf(10000.f, -(float)i / 16.f); const float ang = (float)pos * fr; float sn, cs; sincosf(ang, &sn, &cs); tab[gtid] = (f32x2){cs, sn}; }
    }
    SEAM(0);
    if (IN(1)) { FRESH();
        for (int row0 = F.gw * 3; row0 < MT; row0 += F.NGW * 3) {
            f32x4 v[3][8];
#pragma unroll
            for (int q = 0; q < 3; ++q) { const int row = row0 + q; const float* src = row < ML ? x + (size_t)row * DM : ctx + (size_t)(row - ML) * DM; load_row_f32(src, F.lane, v[q]); }
#pragma unroll
            for (int q = 0; q < 3; ++q) { const int row = row0 + q; const int r = row < ML ? row / SEQ : 8;
                const float rstd = __builtin_amdgcn_rsqf(sumsq8(v[q]) * (1.f / DM) + EPS);
                modulate_store(v[q], rstd, pre_norm, mod + (size_t)r * 6144, H + (size_t)row * DM, F.lane); }
        }
    }
    SEAM(1);
    if (IN(2)) {
        pg8::Gemm g{H, WIN, MT, 4096, DM, DM, DM, 0}; pg8::StaticOrder S; S.init(MT, 4096, F.G, (int)blockIdx.x);
        pg8::EpiPoolIn E{U, SG};
        pg8::gemm_phase<pg8::EpiPoolIn>(F.lds, g, S, E);
        if (F.G == 256 && (int)blockIdx.x >= 128)
            tr_run(args, 1, ((int)blockIdx.x - 128) * NWAVES + F.wave, 128 * NWAVES, threadIdx.x & 63, (LAS float*)(F.lds + F.wave * 16384));
    }
    SEAM(2);
    if (IN(3)) { FRESH();
        for (int item = gtid; item < (MT / 8) * 256; item += NTHR) {
            const int cc = item & 255, row0 = (item >> 8) * 8;
            int base, L; if (row0 < ML) { base = row0 & ~(SEQ - 1); L = SEQ; } else { base = ML + ((row0 - ML) & ~(CTXL - 1)); L = CTXL; }
            const int t0 = row0 - base, gidx = cc >> 6;
            const bf16_t* Ub = U + (size_t)base * DM + cc * 8; bf16_t* Pb = P + (size_t)base * DM + cc * 8;
            switch (gidx) {
                case 0: pool_chunk<2>(Ub, Pb, t0, L); break;
                case 1: pool_chunk<4>(Ub, Pb, t0, L); break;
                case 2: pool_chunk<8>(Ub, Pb, t0, L); break;
                default: pool_chunk<16>(Ub, Pb, t0, L); break;
            }
        }
    }
    SEAM(3);
    if (IN(4)) {
        pg8::Gemm g{P, WG, MT, DM, 512, DM, 512, 2}; pg8::StaticOrder S; S.init(MT, DM, F.G, (int)blockIdx.x);
        pg8::EpiGrp E{SG, Z, args.in[10], args.in[11]};
        pg8::gemm_phase<pg8::EpiGrp>(F.lds, g, S, E);
    }
    SEAM(4);
    if (IN(5)) {
        pg8::Gemm g{Z, WOUT, MT, DM, DM, DM, DM, 0}; pg8::StaticOrder S; S.init(MT, DM, F.G, (int)blockIdx.x);
        pg8::EpiPlain E{Y, DM};
        pg8::gemm_phase<pg8::EpiPlain>(F.lds, g, S, E);
        if (F.G == 256 && (int)blockIdx.x >= 64) {
            const int lb = (int)blockIdx.x - 64;
            if (F.wave < 4) gemv_item(c, c_ctx, ada_w, ada_b, mod, 768 + lb * 4 + F.wave, threadIdx.x & 63);
            else tr_run(args, 2, lb * 4 + (F.wave - 4), 192 * 4, threadIdx.x & 63, (LAS float*)(F.lds + F.wave * 16384));
        }
    }
    SEAM(5);
    if (IN(6)) { FRESH();
        for (int row0 = F.gw * 3; row0 < MT; row0 += F.NGW * 3) {
            f32x4 v[3][8]; u32x2 yw[3][8];
#pragma unroll
            for (int q = 0; q < 3; ++q) { const int row = row0 + q; const float* src = row < ML ? x + (size_t)row * DM : ctx + (size_t)(row - ML) * DM; load_row_f32(src, F.lane, v[q]);
                const bf16_t* yr = Y + (size_t)row * DM;
#pragma unroll
                for (int j = 0; j < 8; ++j) yw[q][j] = *(const u32x2*)(yr + 4 * F.lane + 256 * j); }
#pragma unroll
            for (int q = 0; q < 3; ++q) { const int row = row0 + q; const bool lat = row < ML; const int r = lat ? row / SEQ : 8;
                float sy = 0.f;
#pragma unroll
                for (int j = 0; j < 8; ++j) { const float a = bf_lo(yw[q][j].x), b = bf_hi(yw[q][j].x), c2 = bf_lo(yw[q][j].y), d = bf_hi(yw[q][j].y); sy += (a * a + b * b) + (c2 * c2 + d * d); }
                const float rsy = __builtin_amdgcn_rsqf(wave_sum(sy) * (1.f / DM) + EPS);
                const float* m0 = mod + (size_t)r * 6144;
#pragma unroll
                for (int j = 0; j < 8; ++j) { const int col = 4 * F.lane + 256 * j; const f32x4 gt = *(const f32x4*)(m0 + 2 * DM + col), pn = *(const f32x4*)(post_norm + col);
                    const f32x4 y4 = (f32x4){bf_lo(yw[q][j].x), bf_hi(yw[q][j].x), bf_lo(yw[q][j].y), bf_hi(yw[q][j].y)};
                    v[q][j] = v[q][j] + gt * (y4 * rsy * pn);
                    if (lat) *(f32x4*)(args.out + (size_t)row * DM + col) = v[q][j]; }
                const float rstd = __builtin_amdgcn_rsqf(sumsq8(v[q]) * (1.f / DM) + EPS);
                modulate_store(v[q], rstd, pre_norm + DM, mod + (size_t)(9 + r) * 6144, H + (size_t)row * DM, F.lane); }
        }
    }
    SEAM(6);
    if (IN(7)) {
        pg8::Gemm g{H, WMLA, MT, NMLA, DM, DM, DM, 0}; pg8::StaticOrder S; S.init(MT, NMLA, F.G, (int)blockIdx.x);
        pg8::EpiMlaIn E{CQ, CKV, KR, SG, ssq, tab};
        pg8::gemm_phase<pg8::EpiMlaIn>(F.lds, g, S, E);
    }
    SEAM(7);
    if (IN(8)) {
        { pg8::Gemm g{CQ, WUQ, ML, 3072, 512, 512, 512, 0}; pg8::StaticOrder S; S.init(ML, 3072, F.G, (int)blockIdx.x);
          pg8::EpiQ E{Q, ssq, tab};
          pg8::gemm_phase<pg8::EpiQ>(F.lds, g, S, E); }
        { pg8::Gemm g{CKV, WUKV, MT, 4096, 512, 512, 512, 0}; pg8::StaticOrder S; S.init(MT, 4096, F.G, (int)blockIdx.x);
          pg8::EpiKV E{KN, V, ssq + MT};
          pg8::gemm_phase<pg8::EpiKV>(F.lds, g, S, E); }
    }
    SEAM(8);
    if (IN(9)) {
        const int bx = blockIdx.x, vcu = (F.G % 8 == 0) ? (bx % 8) * (F.G / 8) + bx / 8 : bx;
        att::attn_phase(Q, KN, KR, V, SG, Z, vcu, F.G, (char*)lds, F.lds);
    }
    SEAM(9);
    if (IN(10)) {
        pg8::Gemm g{Z, WMO, ML, DM, DM, DM, DM, 0}; pg8::StaticOrder S; S.init(ML, DM, F.G, (int)blockIdx.x);
        pg8::EpiPlain E{Y, DM};
        pg8::gemm_phase<pg8::EpiPlain>(F.lds, g, S, E);
    }
    SEAM(10);
    if (IN(11)) { FRESH();
        const int per = (ML + F.NGW - 1) / F.NGW, per2 = (per + 1) & ~1, rbeg = F.gw * per2;
        int rcur = -1; f32x4 PA[8];
        for (int row0 = rbeg; row0 < rbeg + per2 && row0 < ML; row0 += 2) {
            f32x4 v[2][8]; u32x2 yw[2][8];
#pragma unroll
            for (int q = 0; q < 2; ++q) { const int row = row0 + q; load_row_f32(args.out + (size_t)row * DM, F.lane, v[q]);
                const bf16_t* yr = Y + (size_t)row * DM;
#pragma unroll
                for (int j = 0; j < 8; ++j) yw[q][j] = *(const u32x2*)(yr + 4 * F.lane + 256 * j); }
#pragma unroll
            for (int q = 0; q < 2; ++q) { const int row = row0 + q; const int r = row / SEQ;
                if (r != rcur) { const float* m1 = mod + (size_t)(9 + r) * 6144; rcur = r;
#pragma unroll
                    for (int j = 0; j < 8; ++j) { const int col = 4 * F.lane + 256 * j; PA[j] = *(const f32x4*)(m1 + 2 * DM + col) * *(const f32x4*)(post_norm + DM + col); } }
                float sy = 0.f;
#pragma unroll
                for (int j = 0; j < 8; ++j) { const float a = bf_lo(yw[q][j].x), b = bf_hi(yw[q][j].x), c2 = bf_lo(yw[q][j].y), d = bf_hi(yw[q][j].y); sy += (a * a + b * b) + (c2 * c2 + d * d); }
                const float rsy = __builtin_amdgcn_rsqf(wave_sum(sy) * (1.f / DM) + EPS);
#pragma unroll
                for (int j = 0; j < 8; ++j) { const int col = 4 * F.lane + 256 * j;
                    const f32x4 y4 = (f32x4){bf_lo(yw[q][j].x), bf_hi(yw[q][j].x), bf_lo(yw[q][j].y), bf_hi(yw[q][j].y)};
                    *(f32x4*)(args.out + (size_t)row * DM + col) = v[q][j] + PA[j] * (y4 * rsy); }
            }
        }
    }
#undef IN
#undef SEAM
}

extern "C" void kernel_launch(void* const* d_in, const int* in_sizes, int n_in, void* d_out, int out_size, void* d_ws, size_t ws_size, hipStream_t stream) {
    static int grid = 0;
    if (grid == 0) {
        if (n_in != 19 || out_size != ML * DM || ws_size < WS_END) { fprintf(stderr, "kernel_launch: unexpected shapes (n_in %d out %d ws %zu)\n", n_in, out_size, ws_size); grid = -1; return; }
        int dev = 0, cus = 0, per_cu = 0;
        hipGetDevice(&dev); hipDeviceGetAttribute(&cus, hipDeviceAttributeMultiprocessorCount, dev);
        if (hipFuncSetAttribute((const void*)mk_fwd, hipFuncAttributeMaxDynamicSharedMemorySize, LDS_BYTES) != hipSuccess) { fprintf(stderr, "kernel_launch: hipFuncSetAttribute failed\n"); grid = -1; return; }
        hipOccupancyMaxActiveBlocksPerMultiprocessor(&per_cu, (const void*)mk_fwd, NWAVES * 64, LDS_BYTES);
        (void)hipGetLastError();
        if (per_cu < 1) per_cu = 1;
        grid = cus * 1;
        (void)per_cu;
    }
    if (grid < 0) return;
    hipMemsetAsync((char*)d_ws, 0, CTL_ZERO_BYTES, stream);
    Args a{};
    for (int i = 0; i < 19; ++i) a.in[i] = (const float*)d_in[i];
    a.out = (float*)d_out; a.ws = (unsigned char*)d_ws;
#if MK_N_LAUNCHES == 1
    a.ph_lo = 0; a.ph_hi = N_PHASES;
    void* kargs[] = {&a};
    hipError_t e = hipLaunchCooperativeKernel((const void*)mk_fwd, dim3(grid), dim3(NWAVES * 64), kargs, LDS_BYTES, stream);
    if (e != hipSuccess) fprintf(stderr, "cooperative launch failed: %s (grid %d)\n", hipGetErrorString(e), grid);
#else
    for (int p = 0; p < N_PHASES; ++p) for (int rep = 0; rep < (((DBL_MASK >> p) & 1) ? 2 : 1); ++rep) { a.ph_lo = p; a.ph_hi = p + 1; hipLaunchKernelGGL(mk_fwd, dim3(grid), dim3(NWAVES * 64), LDS_BYTES, stream, a); }
#endif
}
```

```cpp
#include <hip/hip_runtime.h>
#include <hip/hip_cooperative_groups.h>
#include <hip/hip_bf16.h>
#include <cstdio>
#include <cstdint>
namespace cg = cooperative_groups;

#ifndef MK_N_LAUNCHES
#define MK_N_LAUNCHES 1
#endif

#define LAS __attribute__((address_space(3)))
typedef unsigned short bf16_t;
typedef short bf16x8 __attribute__((ext_vector_type(8)));
typedef short s16x4 __attribute__((ext_vector_type(4)));
typedef float f32x4 __attribute__((ext_vector_type(4)));
typedef float f32x2 __attribute__((ext_vector_type(2)));
typedef float f32x16 __attribute__((ext_vector_type(16)));
typedef unsigned u32x4 __attribute__((ext_vector_type(4)));
typedef unsigned u32x2 __attribute__((ext_vector_type(2)));

constexpr int DM = 2048, NB = 8, SEQ = 2048, CTXL = 256;
constexpr int ML = NB * SEQ, MC = NB * CTXL, MT = ML + MC;
constexpr int NMLA = 3328;
constexpr float EPS = 1e-6f;
constexpr float QSCALE = 0.07216878364870322f * 1.4426950408889634f;

constexpr size_t MiB = 1u << 20;
constexpr size_t WS_MOD = 0;
constexpr size_t WS_SSQ = 512 * 1024;
constexpr size_t WS_BAR = 768 * 1024;
constexpr size_t CTL_ZERO_BYTES = 1 * MiB;
constexpr size_t WS_TAB = 1 * MiB;
constexpr size_t WS_WIN = 2 * MiB, WS_WG = 18 * MiB, WS_WOUT = 20 * MiB, WS_WMLA = 28 * MiB, WS_WUQ = 41 * MiB, WS_WUKV = 44 * MiB, WS_WMO = 48 * MiB;
constexpr size_t WS_H = 64 * MiB, WS_SG = 136 * MiB, WS_Z = 208 * MiB, WS_Y = 280 * MiB, WS_U = 352 * MiB, WS_P = 424 * MiB;
constexpr size_t WS_Q = 352 * MiB, WS_CQ = 448 * MiB, WS_CKV = 466 * MiB, WS_KR = 484 * MiB, WS_KN = WS_H, WS_V = WS_Y;
constexpr size_t WS_END = 496 * MiB;

__device__ __forceinline__ unsigned cvt_pk_bf16(float lo, float hi) { unsigned r; asm volatile("v_cvt_pk_bf16_f32 %0, %1, %2" : "=v"(r) : "v"(lo), "v"(hi)); return r; }
__device__ __forceinline__ float bf_lo(unsigned w) { return __uint_as_float(w << 16); }
__device__ __forceinline__ float bf_hi(unsigned w) { return __uint_as_float(w & 0xffff0000u); }
__device__ __forceinline__ float silu_f(float v) { return v * __builtin_amdgcn_rcpf(1.f + __builtin_amdgcn_exp2f(-1.4426950408889634f * v)); }
__device__ __forceinline__ float wave_sum(float v) {
#pragma unroll
    for (int o = 1; o < 64; o <<= 1) v += __shfl_xor(v, o);
    return v;
}

namespace pg8 {
constexpr int BM = 256, BK = 64, HALF = 128, HTB = HALF * BK * 2, STAGE_BYTES = 8 * HTB, NXCD = 8, WGM = 8;
__host__ __device__ __forceinline__ int lds_byte(int r, int c) { const int st = (r >> 4) * 2 + (c >> 5), rr = r & 15, cc = c & 31, ob = rr * 64 + cc * 2; return st * 1024 + (ob ^ (((ob >> 9) & 1) << 5)); }
__host__ __device__ __forceinline__ void stage_rc(int b, int& R, int& C) { const int st = b / 1024, sb = b % 1024, swz = sb ^ (((sb >> 9) & 1) << 5); R = (st >> 1) * 16 + swz / 64; C = (st & 1) * 32 + (swz % 64) / 2; }
__host__ __device__ __forceinline__ int perm32(int rho) { const int n = rho >> 4, i = rho & 15; return 8 * (i >> 2) + 4 * n + (i & 3); }

struct Unit { int pm, pn; };
struct Gemm { const bf16_t* A; const bf16_t* Bt; int M, N, K, lda, ldb, agrp; };

struct StaticOrder {
    int nM, nN, nwg, G, c;
    __host__ __device__ void init(int M, int N, int G_, int c_) { nM = M / BM; nN = N / BM; nwg = nM * nN; G = G_; c = c_; }
    __host__ __device__ bool next(int i, Unit& u) const {
        const long L = (long)i * G + c; if (L >= nwg) return false;
        int wgid = (int)L; { const int q = nwg / NXCD, r = nwg % NXCD, xcd = wgid % NXCD, off = wgid / NXCD; wgid = (xcd < r ? xcd * (q + 1) : r * (q + 1) + (xcd - r) * q) + off; }
        const int nig = WGM * nN, gid = wgid / nig, fm = gid * WGM, gsz = (nM - fm) < WGM ? (nM - fm) : WGM;
        u.pm = fm + ((wgid % nig) % gsz); u.pn = (wgid % nig) / gsz; return true;
    }
};

template <class Epi>
__device__ __forceinline__ void gemm_phase(LAS unsigned char* lds, const Gemm g, const StaticOrder& S, const Epi& E) {
    const int tid = threadIdx.x, wid = __builtin_amdgcn_readfirstlane(tid >> 6), lane = tid & 63, wr = wid >> 2, wc = wid & 3, fr = lane & 15, fq = lane >> 4;
    const int K = g.K, nt = K / BK;
    unsigned voffA[2], voffB[2];
#pragma unroll
    for (int i = 0; i < 2; ++i) { int R, C; stage_rc(tid * 16 + i * 8192, R, C); const int Rb = Epi::PERM ? ((R & ~31) + perm32(R & 31)) : R;
        voffA[i] = (unsigned)(R * g.lda + C) * 2u; voffB[i] = (unsigned)(Rb * g.ldb + C) * 2u; }
    const size_t kstep = (size_t)(BK * 2);
    const size_t hsA = (size_t)HALF * g.lda * 2, hsB = (size_t)HALF * g.ldb * 2;
    const size_t tsA = 2 * hsA, tsB = 2 * hsB;
    const unsigned ldsw = (unsigned)wid * 1024u;
    const int aoff = lds_byte(wr * 64 + fr, fq * 8), boff = lds_byte(wc * 32 + fr, fq * 8);
#define PG8_SA(b, h) (((b) * 2 + (h)) * HTB)
#define PG8_SB(b, h) ((4 + (b) * 2 + (h)) * HTB)
#define PG8_STAGE(bufoff, gbase, voff) do { _Pragma("unroll") for (int _i = 0; _i < 2; ++_i) \
        __builtin_amdgcn_global_load_lds((const unsigned*)((const char*)(gbase) + (voff)[_i]), (LAS unsigned*)(lds + (bufoff) + ldsw + _i * 8192), 16, 0, 0); } while (0)
#define PG8_LDA(dst, b, h) do { _Pragma("unroll") for (int m = 0; m < 4; ++m) _Pragma("unroll") for (int k = 0; k < 2; ++k) dst[m][k] = *(const LAS bf16x8*)(lds + PG8_SA(b, h) + aoff + m * 2048 + k * 1024); } while (0)
#define PG8_LDB(dst, b, h) do { _Pragma("unroll") for (int n = 0; n < 2; ++n) _Pragma("unroll") for (int k = 0; k < 2; ++k) dst[n][k] = *(const LAS bf16x8*)(lds + PG8_SB(b, h) + boff + n * 2048 + k * 1024); } while (0)
#define PG8_MMA(ai, bj, At, Bt) do { __builtin_amdgcn_s_setprio(1); _Pragma("unroll") for (int m = 0; m < 4; ++m) _Pragma("unroll") for (int n = 0; n < 2; ++n) _Pragma("unroll") for (int k = 0; k < 2; ++k) \
        acc[ai][bj][m][n] = __builtin_amdgcn_mfma_f32_16x16x32_bf16(Bt[n][k], At[m][k], acc[ai][bj][m][n], 0, 0, 0); __builtin_amdgcn_s_setprio(0); } while (0)
#define PG8_WAIT_V(n) asm volatile("s_waitcnt vmcnt(" #n ")" ::: "memory")
#define PG8_WAIT_L(n) asm volatile("s_waitcnt lgkmcnt(" #n ")" ::: "memory")
#define PG8_BAR __builtin_amdgcn_s_barrier()
#define PG8_SCHED __builtin_amdgcn_sched_barrier(0)
#define PG8_AOFF(u) ((g.agrp > 0) ? (size_t)((u).pn / g.agrp) * (size_t)K * 2 : (size_t)0)
    Unit cur, nxt; int ui = 0;
    if (!S.next(0, cur)) return;
    f32x4 acc[2][2][4][2];
#pragma unroll
    for (int a = 0; a < 2; ++a)
#pragma unroll
        for (int b = 0; b < 2; ++b)
#pragma unroll
            for (int m = 0; m < 4; ++m)
#pragma unroll
                for (int n = 0; n < 2; ++n) acc[a][b][m][n] = (f32x4){0.f, 0.f, 0.f, 0.f};
    bf16x8 At[4][2], B0[2][2], B1[2][2];
    const char* cA = (const char*)g.A + (size_t)cur.pm * tsA + PG8_AOFF(cur); const char* cB = (const char*)g.Bt + (size_t)cur.pn * tsB;
    PG8_STAGE(PG8_SB(0, 0), cB, voffB); PG8_STAGE(PG8_SB(0, 1), cB + hsB, voffB); PG8_STAGE(PG8_SA(0, 0), cA, voffA); PG8_STAGE(PG8_SA(0, 1), cA + hsA, voffA);
    if (wr == 1) PG8_BAR;
    PG8_WAIT_V(2); PG8_BAR;
    PG8_STAGE(PG8_SB(1, 0), cB + kstep, voffB); PG8_STAGE(PG8_SA(1, 0), cA + kstep, voffA); PG8_STAGE(PG8_SB(1, 1), cB + hsB + kstep, voffB);
    PG8_WAIT_V(6); PG8_BAR;
    for (;;) {
        const bool has_next = S.next(ui + 1, nxt);
        const char* nA = has_next ? (const char*)g.A + (size_t)nxt.pm * tsA + PG8_AOFF(nxt) : cA; const char* nB = has_next ? (const char*)g.Bt + (size_t)nxt.pn * tsB : cB;
        for (int t = 0; t < nt; t += 2) {
            const bool last = (t == nt - 2);
            const char* a1 = cA + (size_t)(t + 1) * kstep;
            const char* a2 = last ? nA : cA + (size_t)(t + 2) * kstep; const char* b2 = last ? nB : cB + (size_t)(t + 2) * kstep;
            const char* a3 = a2 + kstep; const char* b3 = b2 + kstep;
            PG8_LDB(B0, 0, 0); PG8_LDB(B1, 0, 1); PG8_SCHED; PG8_LDA(At, 0, 0); PG8_STAGE(PG8_SA(1, 1), a1 + hsA, voffA);
            PG8_WAIT_V(8); PG8_WAIT_L(0); PG8_BAR; PG8_MMA(0, 0, At, B0); PG8_MMA(0, 1, At, B1); PG8_BAR; PG8_SCHED;
            PG8_LDA(At, 0, 1); PG8_STAGE(PG8_SB(0, 0), b2, voffB); PG8_STAGE(PG8_SB(0, 1), b2 + hsB, voffB); PG8_STAGE(PG8_SA(0, 0), a2, voffA);
            PG8_WAIT_V(8); PG8_WAIT_L(0); PG8_BAR; PG8_MMA(1, 0, At, B0); PG8_MMA(1, 1, At, B1); PG8_BAR; PG8_SCHED;
            PG8_LDB(B0, 1, 0); PG8_LDB(B1, 1, 1); PG8_SCHED; PG8_LDA(At, 1, 0); PG8_STAGE(PG8_SA(0, 1), a2 + hsA, voffA);
            PG8_WAIT_V(8); PG8_WAIT_L(0); PG8_BAR; PG8_MMA(0, 0, At, B0); PG8_MMA(0, 1, At, B1); PG8_BAR; PG8_SCHED;
            PG8_LDA(At, 1, 1); PG8_STAGE(PG8_SB(1, 0), b3, voffB); PG8_STAGE(PG8_SB(1, 1), b3 + hsB, voffB); PG8_STAGE(PG8_SA(1, 0), a3, voffA);
            PG8_WAIT_V(8); PG8_WAIT_L(0); PG8_BAR; PG8_MMA(1, 0, At, B0); PG8_MMA(1, 1, At, B1); PG8_BAR; PG8_SCHED;
        }
        if (wr == 0) PG8_BAR;
        E(acc, cur, wr, wc, fr, fq);
        if (!has_next) break;
#pragma unroll
        for (int a = 0; a < 2; ++a)
#pragma unroll
            for (int b = 0; b < 2; ++b)
#pragma unroll
                for (int m = 0; m < 4; ++m)
#pragma unroll
                    for (int n = 0; n < 2; ++n) acc[a][b][m][n] = (f32x4){0.f, 0.f, 0.f, 0.f};
        cur = nxt; cA = nA; cB = nB; ++ui;
        if (wr == 1) PG8_BAR;
    }
    PG8_WAIT_V(0);
    PG8_BAR;
#undef PG8_SA
#undef PG8_SB
#undef PG8_STAGE
#undef PG8_LDA
#undef PG8_LDB
#undef PG8_MMA
#undef PG8_WAIT_V
#undef PG8_WAIT_L
#undef PG8_BAR
#undef PG8_SCHED
#undef PG8_AOFF
}

__device__ __forceinline__ u32x4 pack8(f32x4 v0, f32x4 v1) { u32x4 w; w.x = cvt_pk_bf16(v0[0], v0[1]); w.y = cvt_pk_bf16(v0[2], v0[3]); w.z = cvt_pk_bf16(v1[0], v1[1]); w.w = cvt_pk_bf16(v1[2], v1[3]); return w; }
__device__ __forceinline__ f32x4 silu4(f32x4 v) { return (f32x4){silu_f(v[0]), silu_f(v[1]), silu_f(v[2]), silu_f(v[3])}; }

struct EpiPlain {
    static constexpr bool PERM = true;
    bf16_t* O; int ldc;
    __device__ __forceinline__ void operator()(const f32x4 (&acc)[2][2][4][2], const Unit& u, int wr, int wc, int fr, int fq) const {
        const int row0 = u.pm * BM + wr * 64 + fr, col0 = u.pn * BM + wc * 32 + 8 * fq;
#pragma unroll
        for (int ai = 0; ai < 2; ++ai)
#pragma unroll
            for (int m = 0; m < 4; ++m) { bf16_t* rowp = O + (size_t)(row0 + ai * HALF + m * 16) * ldc + col0;
#pragma unroll
                for (int bj = 0; bj < 2; ++bj) *(u32x4*)(rowp + bj * HALF) = pack8(acc[ai][bj][m][0], acc[ai][bj][m][1]); }
    }
};
struct EpiPoolIn {
    static constexpr bool PERM = true;
    bf16_t* U; bf16_t* SG;
    __device__ __forceinline__ void operator()(const f32x4 (&acc)[2][2][4][2], const Unit& u, int wr, int wc, int fr, int fq) const {
        const int t = u.pn >> 3; bf16_t* base = t ? SG : U;
        const int row0 = u.pm * BM + wr * 64 + fr, col0 = (u.pn & 7) * BM + wc * 32 + 8 * fq;
#pragma unroll
        for (int ai = 0; ai < 2; ++ai)
#pragma unroll
            for (int m = 0; m < 4; ++m) { bf16_t* rowp = base + (size_t)(row0 + ai * HALF + m * 16) * DM + col0;
#pragma unroll
                for (int bj = 0; bj < 2; ++bj) { f32x4 v0 = acc[ai][bj][m][0], v1 = acc[ai][bj][m][1];
                    if (t) { v0 = silu4(v0); v1 = silu4(v1); }
                    *(u32x4*)(rowp + bj * HALF) = pack8(v0, v1); } }
    }
};
struct EpiGrp {
    static constexpr bool PERM = true;
    const bf16_t* SG; bf16_t* Z; const float* bias; const float* scale;
    __device__ __forceinline__ void operator()(const f32x4 (&acc)[2][2][4][2], const Unit& u, int wr, int wc, int fr, int fq) const {
        const int row0 = u.pm * BM + wr * 64 + fr, col0 = u.pn * BM + wc * 32 + 8 * fq;
        f32x4 bv[2][2], sv[2][2];
#pragma unroll
        for (int bj = 0; bj < 2; ++bj)
#pragma unroll
            for (int n = 0; n < 2; ++n) { bv[bj][n] = *(const f32x4*)(bias + col0 + bj * HALF + 4 * n); sv[bj][n] = *(const f32x4*)(scale + col0 + bj * HALF + 4 * n); }
#pragma unroll
        for (int ai = 0; ai < 2; ++ai)
#pragma unroll
            for (int m = 0; m < 4; ++m) { const size_t off = (size_t)(row0 + ai * HALF + m * 16) * DM + col0;
#pragma unroll
                for (int bj = 0; bj < 2; ++bj) { const u32x4 gw = *(const u32x4*)(SG + off + bj * HALF);
                    f32x4 v0 = (acc[ai][bj][m][0] + bv[bj][0]) * sv[bj][0], v1 = (acc[ai][bj][m][1] + bv[bj][1]) * sv[bj][1];
                    v0 = v0 * (f32x4){bf_lo(gw.x), bf_hi(gw.x), bf_lo(gw.y), bf_hi(gw.y)}; v1 = v1 * (f32x4){bf_lo(gw.z), bf_hi(gw.z), bf_lo(gw.w), bf_hi(gw.w)};
                    *(u32x4*)(Z + off + bj * HALF) = pack8(v0, v1); } }
    }
};
struct EpiMlaIn {
    static constexpr bool PERM = true;
    bf16_t *CQ, *CKV, *KR, *SG; float* ssq; const f32x2* tab;
    __device__ __forceinline__ void operator()(const f32x4 (&acc)[2][2][4][2], const Unit& u, int wr, int wc, int fr, int fq) const {
        const int pn = u.pn, row0 = u.pm * BM + wr * 64 + fr;
        if (pn < 4) {
            bf16_t* base = pn < 2 ? CQ : CKV; float* ss = ssq + (pn < 2 ? 0 : MT);
            const int col0 = (pn & 1) * BM + wc * 32 + 8 * fq;
#pragma unroll
            for (int ai = 0; ai < 2; ++ai)
#pragma unroll
                for (int m = 0; m < 4; ++m) { const int row = row0 + ai * HALF + m * 16; bf16_t* rowp = base + (size_t)row * 512 + col0; float s = 0.f;
#pragma unroll
                    for (int bj = 0; bj < 2; ++bj) { const f32x4 v0 = acc[ai][bj][m][0], v1 = acc[ai][bj][m][1];
                        s += (v0[0] * v0[0] + v0[1] * v0[1]) + (v0[2] * v0[2] + v0[3] * v0[3]) + (v1[0] * v1[0] + v1[1] * v1[1]) + (v1[2] * v1[2] + v1[3] * v1[3]);
                        *(u32x4*)(rowp + bj * HALF) = pack8(v0, v1); }
                    s += __shfl_xor(s, 16); s += __shfl_xor(s, 32);
                    if (fq == 0) atomicAdd(ss + row, s); }
        } else if (pn < 12) {
            if (u.pm < ML / BM) {
                const int col0 = (pn - 4) * BM + wc * 32 + 8 * fq;
#pragma unroll
                for (int ai = 0; ai < 2; ++ai)
#pragma unroll
                    for (int m = 0; m < 4; ++m) { bf16_t* rowp = SG + (size_t)(row0 + ai * HALF + m * 16) * DM + col0;
#pragma unroll
                        for (int bj = 0; bj < 2; ++bj) *(u32x4*)(rowp + bj * HALF) = pack8(silu4(acc[ai][bj][m][0]), silu4(acc[ai][bj][m][1])); }
            }
        } else {
            if (wc < 2) {
                const bool lat = u.pm < ML / BM;
#pragma unroll
                for (int ai = 0; ai < 2; ++ai)
#pragma unroll
                    for (int m = 0; m < 4; ++m) { const int row = row0 + ai * HALF + m * 16;
                        f32x4 v0 = acc[ai][0][m][0], v1 = acc[ai][0][m][1];
                        if (lat) {
                            const int t = row & (SEQ - 1), pos = wc == 0 ? (t >> 6) : (t & 63);
                            const f32x2* tp = tab + pos * 16 + 8 * (fq & 1);
                            f32x4 p0, p1;
#pragma unroll
                            for (int j = 0; j < 4; ++j) { p0[j] = __shfl_xor(v0[j], 32); p1[j] = __shfl_xor(v1[j], 32); }
                            const bool first = fq < 2;
#pragma unroll
                            for (int j = 0; j < 4; ++j) { const f32x2 c0 = tp[j], c1 = tp[4 + j];
                                v0[j] = first ? (v0[j] * c0.x - p0[j] * c0.y) : (p0[j] * c0.y + v0[j] * c0.x);
                                v1[j] = first ? (v1[j] * c1.x - p1[j] * c1.y) : (p1[j] * c1.y + v1[j] * c1.x); }
                        }
                        *(u32x4*)(KR + (size_t)row * 64 + wc * 32 + 8 * fq) = pack8(v0, v1); }
            }
        }
    }
};
struct EpiQ {
    static constexpr bool PERM = true;
    bf16_t* Q; const float* ssq; const f32x2* tab;
    __device__ __forceinline__ void operator()(const f32x4 (&acc)[2][2][4][2], const Unit& u, int wr, int wc, int fr, int fq) const {
        const int row0 = u.pm * BM + wr * 64 + fr; const bool first = fq < 2;
#pragma unroll
        for (int ai = 0; ai < 2; ++ai)
#pragma unroll
            for (int m = 0; m < 4; ++m) { const int row = row0 + ai * HALF + m * 16; const float rs = __builtin_amdgcn_rsqf(ssq[row] * (1.f / 512.f) + EPS) * QSCALE; const int t = row & (SEQ - 1);
#pragma unroll
                for (int bj = 0; bj < 2; ++bj) { const int gcol = u.pn * 8 + bj * 4 + wc, hg = gcol % 6;
                    f32x4 v0 = acc[ai][bj][m][0] * rs, v1 = acc[ai][bj][m][1] * rs;
                    if (hg >= 4) { const int pos = hg == 4 ? (t >> 6) : (t & 63); const f32x2* tp = tab + pos * 16 + 8 * (fq & 1);
                        f32x4 p0, p1;
#pragma unroll
                        for (int j = 0; j < 4; ++j) { p0[j] = __shfl_xor(v0[j], 32); p1[j] = __shfl_xor(v1[j], 32); }
#pragma unroll
                        for (int j = 0; j < 4; ++j) { const f32x2 c0 = tp[j], c1 = tp[4 + j];
                            v0[j] = first ? (v0[j] * c0.x - p0[j] * c0.y) : (p0[j] * c0.y + v0[j] * c0.x);
                            v1[j] = first ? (v1[j] * c1.x - p1[j] * c1.y) : (p1[j] * c1.y + v1[j] * c1.x); } }
                    *(u32x4*)(Q + (size_t)row * 3072 + gcol * 32 + 8 * fq) = pack8(v0, v1); } }
    }
};
struct EpiKV {
    static constexpr bool PERM = true;
    bf16_t* KN; bf16_t* V; const float* ssq;
    __device__ __forceinline__ void operator()(const f32x4 (&acc)[2][2][4][2], const Unit& u, int wr, int wc, int fr, int fq) const {
        const int row0 = u.pm * BM + wr * 64 + fr, col0 = u.pn * 128 + wc * 32 + 8 * fq;
#pragma unroll
        for (int ai = 0; ai < 2; ++ai)
#pragma unroll
            for (int m = 0; m < 4; ++m) { const int row = row0 + ai * HALF + m * 16; const float rs = __builtin_amdgcn_rsqf(ssq[row] * (1.f / 512.f) + EPS);
                *(u32x4*)(KN + (size_t)row * DM + col0) = pack8(acc[ai][0][m][0] * rs, acc[ai][0][m][1] * rs);
                *(u32x4*)(V + (size_t)row * DM + col0) = pack8(acc[ai][1][m][0] * rs, acc[ai][1][m][1] * rs); }
    }
};
}

namespace att {
constexpr int NW = 8, QBLK = 32, KVBLK = 64, NT = (CTXL + SEQ) / KVBLK;
constexpr int SHM_V = KVBLK * 128 * 2, SHM_K = KVBLK * 192 * 2;
#ifndef ATT_NQREG
#define ATT_NQREG 12
#endif
constexpr int NQREG = ATT_NQREG, SHM_QR = (12 - NQREG) * 8192, SHM_ATTN = 3 * SHM_V + 3 * SHM_K + NW * 64 * 4 + SHM_QR + NW * 4096;
constexpr float THRL = 8.f * 1.4426950408889634f;
#define KSWZ(row, colB) ((row) * 384 + ((colB) ^ (((row) & 7) << 4)))
#define SBAR() __builtin_amdgcn_sched_barrier(0)
__device__ __forceinline__ int crow(int r, int hi) { return (r & 3) + 8 * (r >> 2) + 4 * hi; }
__device__ __forceinline__ void partialSM(f32x16& p0, f32x16& p1, float& m_reg, float& mn, float& alpha) {
  float pmax = p0[0];
#pragma unroll
  for (int r = 1; r < 16; ++r) pmax = fmaxf(pmax, p0[r]);
#pragma unroll
  for (int r = 0; r < 16; ++r) pmax = fmaxf(pmax, p1[r]);
  { auto rr = __builtin_amdgcn_permlane32_swap(__float_as_uint(pmax), __float_as_uint(pmax), false, false);
    pmax = fmaxf(__uint_as_float(rr[0]), __uint_as_float(rr[1])); }
  if (__builtin_expect(__all(pmax - m_reg <= THRL), 1)) { mn = m_reg; alpha = 1.f; }
  else { mn = fmaxf(m_reg, pmax); alpha = __builtin_amdgcn_exp2f(m_reg - mn); m_reg = mn; }
#pragma unroll
  for (int r = 0; r < 16; ++r) p0[r] = p0[r] - mn;
#pragma unroll
  for (int r = 0; r < 16; ++r) p1[r] = p1[r] - mn;
#pragma unroll
  for (int r = 0; r < 16; ++r) p0[r] = __builtin_amdgcn_exp2f(p0[r]);
}
__device__ __forceinline__ void finishSM(f32x16& p0, f32x16& p1, float alpha, float& l_reg, bf16x8& pa0, bf16x8& pa1, bf16x8& pa2, bf16x8& pa3) {
#pragma unroll
  for (int r = 0; r < 16; ++r) p1[r] = __builtin_amdgcn_exp2f(p1[r]);
  float ps = 0;
#pragma unroll
  for (int r = 0; r < 16; ++r) ps += p0[r];
#pragma unroll
  for (int r = 0; r < 16; ++r) ps += p1[r];
  { auto rr = __builtin_amdgcn_permlane32_swap(__float_as_uint(ps), __float_as_uint(ps), false, false);
    ps = __uint_as_float(rr[0]) + __uint_as_float(rr[1]); }
  l_reg = l_reg * alpha + ps;
#define PK4(P, BASE, OUT) do { unsigned a0 = cvt_pk_bf16(P[BASE + 0], P[BASE + 1]), a1 = cvt_pk_bf16(P[BASE + 2], P[BASE + 3]);   \
    unsigned b0 = cvt_pk_bf16(P[BASE + 4], P[BASE + 5]), b1 = cvt_pk_bf16(P[BASE + 6], P[BASE + 7]);                              \
    auto r0 = __builtin_amdgcn_permlane32_swap(a0, b0, false, false); auto r1 = __builtin_amdgcn_permlane32_swap(a1, b1, false, false); \
    u32x4 w = {r0[0], r1[0], r0[1], r1[1]}; OUT = *reinterpret_cast<bf16x8*>(&w); } while (0)
  PK4(p0, 0, pa0); PK4(p0, 8, pa1); PK4(p1, 0, pa2); PK4(p1, 8, pa3);
#undef PK4
}
__device__ __forceinline__ void qkt(f32x16& p0, f32x16& p1, const char* Ks, const bf16x8* qr, const char* Qr, int kbase) {
  p0 = f32x16{}; p1 = f32x16{};
  const char* kb = Ks + kbase;
  bf16x8 k0[4], k1[4];
#define KLD(d) do { k0[(d) % 4] = *reinterpret_cast<const bf16x8*>(kb + (d) * 512); k1[(d) % 4] = *reinterpret_cast<const bf16x8*>(kb + 12288 + (d) * 512); } while (0)
  KLD(0); KLD(1); KLD(2);
  __builtin_amdgcn_s_setprio(1);
#pragma unroll
  for (int d0 = 0; d0 < 12; ++d0) {
    if (d0 + 3 < 12) KLD(d0 + 3);
    const bf16x8 qf = d0 < NQREG ? qr[d0 < NQREG ? d0 : 0] : *reinterpret_cast<const bf16x8*>(Qr + (d0 - NQREG) * 8192);
    p0 = __builtin_amdgcn_mfma_f32_32x32x16_bf16(k0[d0 % 4], qf, p0, 0, 0, 0);
    p1 = __builtin_amdgcn_mfma_f32_32x32x16_bf16(k1[d0 % 4], qf, p1, 0, 0, 0);
    SBAR(); }
  __builtin_amdgcn_s_setprio(0);
#undef KLD
}
__device__ __forceinline__ int v_st(int k, int c) { const int kk = (k & ~0xC) | ((k & 4) << 1) | ((k & 8) >> 1); return ((kk >> 3) * 4 + (c >> 5)) * 512 + ((kk & 7) * 32 + (c & 31)) * 2; }
__device__ __forceinline__ int v_rd_base(int lane) { return ((lane & 3) << 3) | (((lane >> 2) & 3) << 6) | (((lane >> 4) & 1) << 5) | (((lane >> 5) & 1) << 8); }
constexpr int v_rd_off(int d0, int ks, int half) { return d0 * 512 + ks * 4096 + half * 2048; }
template <int OFF> __device__ __forceinline__ s16x4 tr_read(int vb) {
  s16x4 r; asm volatile("ds_read_b64_tr_b16 %0, %1 offset:%2" : "=&v"(r) : "v"(vb), "i"(OFF) : "memory"); return r;
}
struct VFrag { s16x4 l0, h0, l1, h1, l2, h2, l3, h3; };
template <int D0> __device__ __forceinline__ void v_read8(VFrag& f, int vb) {
  f.l0 = tr_read<v_rd_off(D0, 0, 0)>(vb); f.h0 = tr_read<v_rd_off(D0, 0, 1)>(vb); f.l1 = tr_read<v_rd_off(D0, 1, 0)>(vb); f.h1 = tr_read<v_rd_off(D0, 1, 1)>(vb);
  f.l2 = tr_read<v_rd_off(D0, 2, 0)>(vb); f.h2 = tr_read<v_rd_off(D0, 2, 1)>(vb); f.l3 = tr_read<v_rd_off(D0, 3, 0)>(vb); f.h3 = tr_read<v_rd_off(D0, 3, 1)>(vb);
}
__device__ __forceinline__ void pv_mma(f32x16& od, const VFrag& f, bf16x8 pa0, bf16x8 pa1, bf16x8 pa2, bf16x8 pa3) {
#define PK(L, H) (bf16x8){L[0], L[1], L[2], L[3], H[0], H[1], H[2], H[3]}
  od = __builtin_amdgcn_mfma_f32_32x32x16_bf16(pa0, PK(f.l0, f.h0), od, 0, 0, 0);
  od = __builtin_amdgcn_mfma_f32_32x32x16_bf16(pa1, PK(f.l1, f.h1), od, 0, 0, 0);
  od = __builtin_amdgcn_mfma_f32_32x32x16_bf16(pa2, PK(f.l2, f.h2), od, 0, 0, 0);
  od = __builtin_amdgcn_mfma_f32_32x32x16_bf16(pa3, PK(f.l3, f.h3), od, 0, 0, 0);
#undef PK
}
__device__ __forceinline__ void pv_d0(f32x16* o, int vb, bf16x8 pa0, bf16x8 pa1, bf16x8 pa2, bf16x8 pa3) {
  VFrag fa, fb;
  v_read8<0>(fa, vb); v_read8<1>(fb, vb);
  asm volatile("s_waitcnt lgkmcnt(8)" ::: "memory"); SBAR(); pv_mma(o[0], fa, pa0, pa1, pa2, pa3); SBAR();
  v_read8<2>(fa, vb);
  asm volatile("s_waitcnt lgkmcnt(8)" ::: "memory"); SBAR(); pv_mma(o[1], fb, pa0, pa1, pa2, pa3); SBAR();
  v_read8<3>(fb, vb);
  asm volatile("s_waitcnt lgkmcnt(8)" ::: "memory"); SBAR(); pv_mma(o[2], fa, pa0, pa1, pa2, pa3); SBAR();
  asm volatile("s_waitcnt lgkmcnt(0)" ::: "memory"); SBAR(); pv_mma(o[3], fb, pa0, pa1, pa2, pa3); SBAR();
}
__device__ __forceinline__ void qkt_pv(f32x16& p0, f32x16& p1, const char* Ks, const bf16x8* qr, const char* Qr, int kbase, f32x16* o, int vb, bf16x8 pa0, bf16x8 pa1, bf16x8 pa2, bf16x8 pa3) {
  p0 = f32x16{}; p1 = f32x16{};
  const char* kb = Ks + kbase;
  bf16x8 k0[4], k1[4]; VFrag fa, fb;
#define KLD(d) do { k0[(d) % 4] = *reinterpret_cast<const bf16x8*>(kb + (d) * 512); k1[(d) % 4] = *reinterpret_cast<const bf16x8*>(kb + 12288 + (d) * 512); } while (0)
  KLD(0); KLD(1); KLD(2);
  __builtin_amdgcn_s_setprio(1);
#pragma unroll
  for (int d0 = 0; d0 < 12; ++d0) {
    if (d0 + 3 < 12) KLD(d0 + 3);
    if (d0 == 10) v_read8<0>(fa, vb);
    const bf16x8 qf = d0 < NQREG ? qr[d0 < NQREG ? d0 : 0] : *reinterpret_cast<const bf16x8*>(Qr + (d0 - NQREG) * 8192);
    p0 = __builtin_amdgcn_mfma_f32_32x32x16_bf16(k0[d0 % 4], qf, p0, 0, 0, 0);
    p1 = __builtin_amdgcn_mfma_f32_32x32x16_bf16(k1[d0 % 4], qf, p1, 0, 0, 0);
    SBAR(); }
#undef KLD
  v_read8<1>(fb, vb);
  asm volatile("s_waitcnt lgkmcnt(8)" ::: "memory"); SBAR(); pv_mma(o[0], fa, pa0, pa1, pa2, pa3); SBAR();
  v_read8<2>(fa, vb);
  asm volatile("s_waitcnt lgkmcnt(8)" ::: "memory"); SBAR(); pv_mma(o[1], fb, pa0, pa1, pa2, pa3); SBAR();
  v_read8<3>(fb, vb);
  asm volatile("s_waitcnt lgkmcnt(8)" ::: "memory"); SBAR(); pv_mma(o[2], fa, pa0, pa1, pa2, pa3); SBAR();
  asm volatile("s_waitcnt lgkmcnt(0)" ::: "memory"); SBAR(); pv_mma(o[3], fb, pa0, pa1, pa2, pa3); SBAR();
  __builtin_amdgcn_s_setprio(0);
}
constexpr int SLOT_K = SHM_K, SLOT_V = SHM_V, RING_BYTES = 3 * (SLOT_K + SLOT_V);
constexpr int NUNITS = NB * 16 * (SEQ / 256);
__device__ __forceinline__ void attn_phase(const bf16_t* __restrict__ Q, const bf16_t* __restrict__ KN, const bf16_t* __restrict__ KR, const bf16_t* __restrict__ V,
                                           const bf16_t* __restrict__ SG, bf16_t* __restrict__ Z, int vcu, int G, char* lds, LAS unsigned char* ldsl) {
  const int tid = threadIdx.x, wid = __builtin_amdgcn_readfirstlane(tid >> 6), lane = tid & 63, r32 = lane & 31, hi = lane >> 5;
  char* K_lds = lds; char* V_lds = lds + 3 * SLOT_K;
  float* wsf = (float*)(lds + RING_BYTES) + wid * 64; float* li_l = wsf; float* al_l = wsf + 32;
  char* Qr = lds + RING_BYTES + NW * 64 * 4 + tid * 16;
  const int vb0 = (int)(uintptr_t)V_lds + v_rd_base(lane);
  const int kbase = ((r32 >> 4) * 384 + (r32 & 15)) * 16 + hi * 256;
  int kofs[6], vofs[4]; bool krope[6];
  const int wq = wid & 3;
#pragma unroll
  for (int i = 0; i < 6; ++i) { const int p = 6 * wq + i, row = (p / 6) * 16 + (lane & 15), chunk = 4 * (p % 6) + (lane >> 4);
    krope[i] = chunk >= 16; kofs[i] = krope[i] ? row * 128 + (chunk - 16) * 16 : row * 4096 + chunk * 16; }
#pragma unroll
  for (int i = 0; i < 4; ++i) { const int B = (4 * wq + i) * 1024 + lane * 16, sub = B >> 9, within = (B & 511) >> 1, kk = (sub >> 2) * 8 + (within >> 5);
    const int k = (kk & ~0xC) | ((kk & 4) << 1) | ((kk & 8) >> 1), c = (sub & 3) * 32 + (within & 31); vofs[i] = k * 4096 + c * 2; }
#define KROW(j, b_) ((j) < 4 ? ML + (b_) * CTXL + (j) * KVBLK : (b_) * SEQ + ((j) - 4) * KVBLK)
#define DMA_K(j, b_, h_, slot) do { const int rb_ = KROW(j, b_); \
    const char* kn_ = (const char*)KN + (size_t)rb_ * 4096 + (h_) * 256; const char* kr_ = (const char*)KR + (size_t)rb_ * 128; \
    _Pragma("unroll") for (int i_ = 0; i_ < 6; ++i_) __builtin_amdgcn_global_load_lds((const unsigned*)((krope[i_] ? kr_ : kn_) + kofs[i_]), (LAS unsigned*)(ldsl + (slot) * SLOT_K + (6 * wq + i_) * 1024), 16, 0, 0); } while (0)
#define DMA_V(j, b_, h_, slot) do { const int rb_ = KROW(j, b_); const char* v_ = (const char*)V + (size_t)rb_ * 4096 + (h_) * 256; \
    _Pragma("unroll") for (int i_ = 0; i_ < 4; ++i_) __builtin_amdgcn_global_load_lds((const unsigned*)(v_ + vofs[i_]), (LAS unsigned*)(ldsl + 3 * SLOT_K + (slot) * SLOT_V + (4 * wq + i_) * 1024), 16, 0, 0); } while (0)
#define TILE_SYNC() do { asm volatile("s_waitcnt vmcnt(0)" ::: "memory"); __syncthreads(); } while (0)
#define RESC(a) do { if (__any((a) < 1.f)) { if (hi == 0) al_l[r32] = (a); asm volatile("s_waitcnt lgkmcnt(0)" ::: "memory"); \
    _Pragma("unroll") for (int d = 0; d < 4; ++d) _Pragma("unroll") for (int r = 0; r < 16; ++r) o[d][r] *= al_l[crow(r, hi)]; } } while (0)
  const int half = wid >> 2;
  const int nun_wg = vcu < NUNITS ? (NUNITS - 1 - vcu) / G + 1 : 0, T = nun_wg * NT;
#define ABAR() do { asm volatile("s_waitcnt lgkmcnt(0)" ::: "memory"); __builtin_amdgcn_s_barrier(); asm volatile("" ::: "memory"); } while (0)
#define VWAIT() asm volatile("s_waitcnt vmcnt(0)" ::: "memory")
#define DMA_TK(t_) do { const int ui_ = (t_) / NT, j_ = (t_) - ui_ * NT, un_ = vcu + ui_ * G; DMA_K(j_, (un_ >> 7), ((un_ >> 3) & 15), ((t_) % 3)); } while (0)
#define DMA_TV(t_) do { const int ui_ = (t_) / NT, j_ = (t_) - ui_ * NT, un_ = vcu + ui_ * G; DMA_V(j_, (un_ >> 7), ((un_ >> 3) & 15), ((t_) % 3)); } while (0)
#define LOADQ(un_) do { const int qb_ = (un_) & 7, h_ = ((un_) >> 3) & 15, b_ = (un_) >> 7; const bf16_t* Qw = Q + (size_t)(b_ * SEQ + qb_ * 256 + wid * QBLK + r32) * 3072 + h_ * 192 + hi * 8; \
    _Pragma("unroll") for (int d0 = 0; d0 < NQREG; ++d0) qr[d0] = *reinterpret_cast<const bf16x8*>(Qw + d0 * 16); \
    _Pragma("unroll") for (int d0 = NQREG; d0 < 12; ++d0) *reinterpret_cast<bf16x8*>(Qr + (d0 - NQREG) * 8192) = *reinterpret_cast<const bf16x8*>(Qw + d0 * 16); } while (0)
#define EPI_PREFETCH(un_) do { const int qb_ = (un_) & 7, h_ = ((un_) >> 3) & 15, b_ = (un_) >> 7; \
    const size_t ob = (size_t)(b_ * SEQ + qb_ * 256 + wid * QBLK + (lane >> 3)) * DM + h_ * 128 + (lane & 7) * 8; \
    _Pragma("unroll") for (int hf = 0; hf < 2; ++hf) _Pragma("unroll") for (int i4 = 0; i4 < 4; ++i4) gv[hf][i4] = *(const u32x4*)(SG + ob + (size_t)(i4 * 8) * DM + hf * 64); } while (0)
#define EPILOGUE(un_) do { const int qb_ = (un_) & 7, h_ = ((un_) >> 3) & 15, b_ = (un_) >> 7; \
    if (hi == 0) li_l[r32] = l_reg; asm volatile("s_waitcnt lgkmcnt(0)" ::: "memory"); \
    const size_t ob = (size_t)(b_ * SEQ + qb_ * 256 + wid * QBLK + (lane >> 3)) * DM + h_ * 128 + (lane & 7) * 8; \
    _Pragma("unroll") for (int hf = 0; hf < 2; ++hf) { \
      _Pragma("unroll") for (int r = 0; r < 16; ++r) { const float rl = __builtin_amdgcn_rcpf(li_l[crow(r, hi)]); \
        _Pragma("unroll") for (int dd = 0; dd < 2; ++dd) epi[crow(r, hi) * 64 + dd * 32 + r32] = (bf16_t)(cvt_pk_bf16(o[hf * 2 + dd][r] * rl, 0.f) & 0xffffu); } \
      asm volatile("s_waitcnt lgkmcnt(0)" ::: "memory"); \
      _Pragma("unroll") for (int i4 = 0; i4 < 4; ++i4) { const u32x4 ov = *(const u32x4*)(epi + (i4 * 8 + (lane >> 3)) * 64 + (lane & 7) * 8); \
        const size_t gi = ob + (size_t)(i4 * 8) * DM + hf * 64; const u32x4 gvv = gv[hf][i4]; u32x4 zv; \
        zv.x = cvt_pk_bf16(bf_lo(ov.x) * bf_lo(gvv.x), bf_hi(ov.x) * bf_hi(gvv.x)); zv.y = cvt_pk_bf16(bf_lo(ov.y) * bf_lo(gvv.y), bf_hi(ov.y) * bf_hi(gvv.y)); \
        zv.z = cvt_pk_bf16(bf_lo(ov.z) * bf_lo(gvv.z), bf_hi(ov.z) * bf_hi(gvv.z)); zv.w = cvt_pk_bf16(bf_lo(ov.w) * bf_lo(gvv.w), bf_hi(ov.w) * bf_hi(gvv.w)); \
        *(u32x4*)(Z + gi) = zv; } \
      asm volatile("s_waitcnt lgkmcnt(0)" ::: "memory"); } } while (0)
  bf16_t* epi = (bf16_t*)(lds + RING_BYTES + NW * 64 * 4 + SHM_QR + wid * 4096);
  if (T > 0) {
    float m_reg = -1e30f, l_reg = 0, mn, al; f32x16 o[4] = {}; bf16x8 qr[NQREG]; f32x16 p0, p1; bf16x8 pa0, pa1, pa2, pa3; u32x4 gv[2][4];
    if (half == 1) { DMA_TK(0); DMA_TK(1); } else { DMA_TV(0); DMA_TV(1); }
    LOADQ(vcu);
    VWAIT(); __syncthreads();
    if (half == 1) ABAR();
    int slot = 0, pslot = 2, t = 0;
#define SEG_S() do { const bool vis_ = (half == 0) && t >= 1 && t + 1 < T; \
      if (half == 1) { if (t + 2 < T) DMA_TK(t + 2); } else if (vis_) DMA_TV(t + 1); \
      partialSM(p0, p1, m_reg, mn, al); RESC(al); finishSM(p0, p1, al, l_reg, pa0, pa1, pa2, pa3); \
      if (half == 0) { if (vis_) asm volatile("s_waitcnt vmcnt(4)" ::: "memory"); else VWAIT(); } \
      SBAR(); ABAR(); pslot = slot; slot = slot == 2 ? 0 : slot + 1; ++t; } while (0)
    for (int ui = 0; ui < nun_wg; ++ui) {
      SBAR();
      if (ui > 0) {
        EPI_PREFETCH(vcu + (ui - 1) * G);
        pv_d0(o, vb0 + pslot * SLOT_V, pa0, pa1, pa2, pa3);
        EPILOGUE(vcu + (ui - 1) * G);
        m_reg = -1e30f; l_reg = 0;
#pragma unroll
        for (int d = 0; d < 4; ++d) o[d] = f32x16{};
      }
      qkt(p0, p1, K_lds + slot * SLOT_K, qr, Qr, kbase);
      if (half == 1) VWAIT();
      SBAR(); ABAR();
      SEG_S();
      for (int j = 1; j < NT; ++j) {
        SBAR();
        qkt_pv(p0, p1, K_lds + slot * SLOT_K, qr, Qr, kbase, o, vb0 + pslot * SLOT_V, pa0, pa1, pa2, pa3);
        const bool qpre_ = (j == NT - 1 && ui + 1 < nun_wg);
        if (qpre_) LOADQ(vcu + (ui + 1) * G);
        if (half == 1) { if (qpre_) asm volatile("s_waitcnt vmcnt(12)" ::: "memory"); else VWAIT(); }
        SBAR(); ABAR();
        SEG_S();
      }
    }
#undef SEG_S
    EPI_PREFETCH(vcu + (nun_wg - 1) * G);
    pv_d0(o, vb0 + pslot * SLOT_V, pa0, pa1, pa2, pa3);
    EPILOGUE(vcu + (nun_wg - 1) * G);
    if (half == 0) ABAR();
  }
  asm volatile("s_waitcnt vmcnt(0)" ::: "memory"); __syncthreads();
#undef ABAR
#undef VWAIT
#undef DMA_TK
#undef DMA_TV
#undef LOADQ
#undef EPILOGUE
#undef EPI_PREFETCH
#undef KROW
#undef DMA_K
#undef DMA_V
#undef TILE_SYNC
#undef RESC
}
}


#define XB_TMO      128
#define XB_XCNT(j)  (256  + 64 * (j))
#define XB_XSUB(j)  (1280 + 64 * (j))
#define XB_XGEN(j)  (2304 + 64 * (j))
#define XB_TOP      3328
#define XB_TOPGEN   3392
#define XCD_BAR_WORDS 3456
#define XB_SPIN_CAP (1u << 22)
__device__ __forceinline__ unsigned xb_ld(unsigned* p)              { return __hip_atomic_load(p, __ATOMIC_RELAXED, __HIP_MEMORY_SCOPE_AGENT); }
__device__ __forceinline__ unsigned xb_add(unsigned* p, unsigned v) { return __hip_atomic_fetch_add(p, v, __ATOMIC_RELAXED, __HIP_MEMORY_SCOPE_AGENT); }
__device__ __forceinline__ unsigned xb_xcc_id() { return (unsigned)__builtin_amdgcn_s_getreg((3 << 11) | 20) & 0xFu; }
#define XB_SPIN(cond, bar) do { unsigned _sp = 0; while (cond) { __builtin_amdgcn_s_sleep(1); \
    if ((++_sp & 255u) == 0u) { if (xb_ld(&(bar)[XB_TMO])) break; if (_sp > XB_SPIN_CAP) { atomicAdd(&(bar)[XB_TMO], 1u); break; } } } } while (0)
struct XcdBarrier { unsigned* bar; unsigned x; volatile LAS unsigned* st; };
__device__ __forceinline__ XcdBarrier xcd_barrier_post(unsigned* bar, volatile LAS unsigned* st) {
    XcdBarrier b; b.bar = bar; b.x = xb_xcc_id(); b.st = st;
    if (threadIdx.x == 0) (void)xb_add(&bar[XB_XCNT(b.x)], 1u);
    return b;
}
__device__ __forceinline__ void xcd_barrier_complete(unsigned* bar, unsigned x, unsigned& nloc, unsigned& nx) {
    const unsigned G = gridDim.x;
    unsigned sum, cnt, mine, sp = 0u;
    for (;;) {
        sum = 0u; cnt = 0u; mine = 0u;
#pragma unroll
        for (unsigned j = 0; j < 16; ++j) { const unsigned c = xb_ld(&bar[XB_XCNT(j)]); sum += c; cnt += (c > 0u) ? 1u : 0u; mine = (j == x) ? c : mine; }
        if (sum == G) break;
        __builtin_amdgcn_s_sleep(1);
        if ((++sp & 255u) == 0u) { if (xb_ld(&bar[XB_TMO])) break; if (sp > XB_SPIN_CAP) { atomicAdd(&bar[XB_TMO], 1u); break; } }
    }
    nloc = mine > 0u ? mine : 1u; nx = cnt > 0u ? cnt : 1u;
}
__device__ __forceinline__ void xcd_barrier(const XcdBarrier& b) {
    asm volatile("s_waitcnt vmcnt(0)" ::: "memory");
    __syncthreads();
    if (threadIdx.x == 0) {
        unsigned* bar = b.bar;
        __builtin_amdgcn_s_waitcnt(0);
        unsigned nloc = b.st[0], nx = b.st[1];
        if (nloc == 0u) { xcd_barrier_complete(bar, b.x, nloc, nx); b.st[0] = nloc; b.st[1] = nx; }
        const unsigned old = xb_add(&bar[XB_XSUB(b.x)], 1u);
        const unsigned gen = old / nloc;
        if (old + 1u == (gen + 1u) * nloc) {
            __builtin_amdgcn_fence(__ATOMIC_RELEASE, "agent");
            asm volatile("s_waitcnt vmcnt(0)" ::: "memory");
            const unsigned og = xb_add(&bar[XB_TOP], 1u);
            const unsigned tg = og / nx;
            if (og + 1u == (tg + 1u) * nx) xb_add(&bar[XB_TOPGEN], 1u);
            else XB_SPIN(xb_ld(&bar[XB_TOPGEN]) == tg, bar);
            __builtin_amdgcn_fence(__ATOMIC_ACQUIRE, "agent");
            xb_add(&bar[XB_XGEN(b.x)], 1u);
            asm volatile("s_waitcnt vmcnt(0)" ::: "memory");
        } else {
            XB_SPIN(xb_ld(&bar[XB_XGEN(b.x)]) == gen, bar);
            __builtin_amdgcn_fence(__ATOMIC_ACQUIRE, "agent");
            asm volatile("s_waitcnt vmcnt(0)" ::: "memory");
        }
    }
    __syncthreads();
}
constexpr int NWAVES = 8;
constexpr int LDS_BYTES = 163840;
constexpr int N_PHASES = 12;
constexpr int MISC_OFF = 163840 - 256; static_assert(att::SHM_ATTN <= MISC_OFF, "LDS map");


struct Frame {
    LAS unsigned char* lds;
    int tid, lane, wave, gw, NGW, G;
    unsigned char* ws;
};

struct Args { const float* in[19]; float* out; unsigned char* ws; int ph_lo, ph_hi; };
struct TrDesc { const float* W; bf16_t* WT; const float* gk; int K, N, item; bool reorder; };
__device__ __forceinline__ void tr_load(const TrDesc& d, int lane, f32x4 (&wv)[8]) {
    const int nblk = d.N / 32, kb = d.item / nblk, nb = d.item % nblk, k0 = 64 * kb, n0 = 32 * nb;
#pragma unroll
    for (int i = 0; i < 8; ++i) wv[i] = *(const f32x4*)(d.W + (size_t)(k0 + 8 * i + (lane >> 3)) * d.N + n0 + (lane & 7) * 4);
}
__device__ __forceinline__ void tr_finish(const TrDesc& d, int lane, const f32x4 (&wv)[8], LAS float* scr) {
    const int nblk = d.N / 32, kb = d.item / nblk, nb = d.item % nblk, k0 = 64 * kb, n0 = 32 * nb;
    const int d0 = d.reorder ? (nb < 32 ? n0 : (nb < 34 ? n0 + 2048 : n0 - 64)) : n0;
#pragma unroll
    for (int i = 0; i < 8; ++i) { const int kk = 8 * i + (lane >> 3); f32x4 v = wv[i]; if (d.gk) v = v * d.gk[k0 + kk];
        LAS float* p = scr + kk * 33 + (lane & 7) * 4; p[0] = v[0]; p[1] = v[1]; p[2] = v[2]; p[3] = v[3]; }
    asm volatile("s_waitcnt lgkmcnt(0)" ::: "memory");
    const int c = lane & 7;
#pragma unroll
    for (int j = 0; j < 4; ++j) { const int n = (lane >> 3) + 8 * j; const LAS float* sp = scr + (8 * c) * 33 + n;
        u32x4 o; o.x = cvt_pk_bf16(sp[0 * 33], sp[1 * 33]); o.y = cvt_pk_bf16(sp[2 * 33], sp[3 * 33]); o.z = cvt_pk_bf16(sp[4 * 33], sp[5 * 33]); o.w = cvt_pk_bf16(sp[6 * 33], sp[7 * 33]);
        *(u32x4*)(d.WT + (size_t)(d0 + n) * d.K + k0 + 8 * c) = o; }
    asm volatile("s_waitcnt lgkmcnt(0)" ::: "memory");
}
constexpr int I_WIN = 32 * 128, I_WG = 4 * 8 * 16, I_WOUT = 32 * 64, I_WMLA = 32 * 98, I_WUQ = 8 * 96, I_WUKV = 8 * 128, I_WMO = 32 * 64;
constexpr int I_LIST0 = I_WIN + I_WG + I_WOUT, I_LIST1 = I_WMLA + I_WUQ + I_WUKV, I_LIST2 = I_WMO;
__device__ __forceinline__ TrDesc tr_desc(const Args& a, int list, int r) {
    unsigned char* ws = a.ws; TrDesc d; d.gk = nullptr; d.reorder = false;
    if (list == 0) {
        if (r < I_WIN) { d.W = a.in[8]; d.WT = (bf16_t*)(ws + WS_WIN); d.K = DM; d.N = 4096; d.item = r; return d; } r -= I_WIN;
        if (r < I_WG) { const int g = r / 128; d.W = a.in[9] + (size_t)g * 512 * 512; d.WT = (bf16_t*)(ws + WS_WG) + (size_t)g * 512 * 512; d.K = 512; d.N = 512; d.item = r % 128; return d; } r -= I_WG;
        d.W = a.in[12]; d.WT = (bf16_t*)(ws + WS_WOUT); d.K = DM; d.N = DM; d.item = r; return d;
    }
    if (list == 1) {
    if (r < I_WMLA) { d.W = a.in[13]; d.WT = (bf16_t*)(ws + WS_WMLA); d.K = DM; d.N = 3136; d.item = r; d.reorder = true; return d; } r -= I_WMLA;
    if (r < I_WUQ) { d.W = a.in[16]; d.WT = (bf16_t*)(ws + WS_WUQ); d.K = 512; d.N = 3072; d.item = r; d.gk = a.in[14]; return d; } r -= I_WUQ;
    { d.W = a.in[17]; d.WT = (bf16_t*)(ws + WS_WUKV); d.K = 512; d.N = 4096; d.item = r; d.gk = a.in[15]; return d; } }
    d.W = a.in[18]; d.WT = (bf16_t*)(ws + WS_WMO); d.K = DM; d.N = DM; d.item = r; return d;
}
__device__ __forceinline__ void tr_run(const Args& a, int list, int first, int stride, int lane, LAS float* scr, int n_end = -1) {
    const int n = n_end >= 0 ? n_end : (list == 0 ? I_LIST0 : (list == 1 ? I_LIST1 : I_LIST2));
    int it = first; if (it >= n) return;
    TrDesc d = tr_desc(a, list, it); f32x4 wv[8]; tr_load(d, lane, wv);
    for (;;) {
        const int nit = it + stride; const bool more = nit < n;
        TrDesc dn = d; f32x4 wn[8];
        if (more) { dn = tr_desc(a, list, nit); tr_load(dn, lane, wn); }
        tr_finish(d, lane, wv, scr);
        if (!more) break;
#pragma unroll
        for (int i = 0; i < 8; ++i) wv[i] = wn[i];
        d = dn; it = nit;
    }
}

__device__ __forceinline__ void gemv_item(const float* c, const float* c_ctx, const float* ada_w, const float* ada_b, float* mod, int it, int lane) {
    const int l = it / 768, rem = it % 768, kc = rem / 24, cgp = rem % 24, k0 = kc * 64;
    float s[9];
#pragma unroll
    for (int r = 0; r < 8; ++r) s[r] = silu_f(c[r * DM + k0 + lane]);
    s[8] = silu_f(c_ctx[k0 + lane]);
    const float* W = ada_w + (size_t)l * DM * 6144 + (size_t)k0 * 6144 + cgp * 256 + lane * 4;
    f32x4 acc[9];
#pragma unroll
    for (int r = 0; r < 9; ++r) acc[r] = (f32x4){0.f, 0.f, 0.f, 0.f};
#pragma unroll 16
    for (int kk = 0; kk < 64; ++kk) { const f32x4 w = *(const f32x4*)(W + (size_t)kk * 6144);
#pragma unroll
        for (int r = 0; r < 9; ++r) { const float sk = __uint_as_float(__builtin_amdgcn_readlane(__float_as_uint(s[r]), kk)); acc[r] += w * sk; } }
    const int col = cgp * 256 + lane * 4;
    f32x4 bv = (f32x4){0.f, 0.f, 0.f, 0.f};
    if (kc == 0) bv = *(const f32x4*)(ada_b + l * 6144 + col);
#pragma unroll
    for (int r = 0; r < 9; ++r) { float* m = mod + (size_t)(l * 9 + r) * 6144 + col;
#pragma unroll
        for (int j = 0; j < 4; ++j) atomicAdd(m + j, acc[r][j] + bv[j]); }
}

__device__ __forceinline__ void load_row_f32(const float* p, int lane, f32x4 (&v)[8]) {
#pragma unroll
    for (int j = 0; j < 8; ++j) v[j] = *(const f32x4*)(p + 4 * lane + 256 * j);
}
__device__ __forceinline__ float sumsq8(const f32x4 (&v)[8]) {
    float s = 0.f;
#pragma unroll
    for (int j = 0; j < 8; ++j) s += (v[j][0] * v[j][0] + v[j][1] * v[j][1]) + (v[j][2] * v[j][2] + v[j][3] * v[j][3]);
    return wave_sum(s);
}
__device__ __forceinline__ void modulate_store(const f32x4 (&v)[8], float rstd, const float* pn, const float* modr, bf16_t* orow, int lane) {
#pragma unroll
    for (int j = 0; j < 8; ++j) { const int col = 4 * lane + 256 * j;
        const f32x4 g = *(const f32x4*)(pn + col), sh = *(const f32x4*)(modr + col), sc = *(const f32x4*)(modr + DM + col);
        const f32x4 hh = v[j] * rstd * g * (sc + 1.f) + sh;
        u32x2 w; w.x = cvt_pk_bf16(hh[0], hh[1]); w.y = cvt_pk_bf16(hh[2], hh[3]);
        *(u32x2*)(orow + col) = w; }
}


template <int WIN> __device__ __forceinline__ void pool_chunk(const bf16_t* Ub, bf16_t* Pb, int t0, int L) {
    constexpr int LEFT = WIN / 2, RIGHT = WIN - 1 - LEFT, NR = 8 + WIN - 1;
    u32x4 rw[NR];
#pragma unroll
    for (int k = 0; k < NR; ++k) { const int t = t0 - LEFT + k; rw[k] = (t >= 0 && t < L) ? *(const u32x4*)(Ub + (size_t)t * DM) : (u32x4){0u, 0u, 0u, 0u}; }
    float S8[8];
#pragma unroll
    for (int e = 0; e < 8; ++e) S8[e] = 0.f;
#define ACC8(q_, sgn) do { const u32x4 a_ = (q_); S8[0] += sgn bf_lo(a_.x); S8[1] += sgn bf_hi(a_.x); S8[2] += sgn bf_lo(a_.y); S8[3] += sgn bf_hi(a_.y); \
                          S8[4] += sgn bf_lo(a_.z); S8[5] += sgn bf_hi(a_.z); S8[6] += sgn bf_lo(a_.w); S8[7] += sgn bf_hi(a_.w); } while (0)
#pragma unroll
    for (int k = 0; k < WIN; ++k) ACC8(rw[k], +);
#pragma unroll
    for (int i = 0; i < 8; ++i) { const int t = t0 + i; const int lo_ = t - LEFT < 0 ? 0 : t - LEFT, hi_ = t + RIGHT + 1 > L ? L : t + RIGHT + 1;
        const float inv = 1.f / (float)(hi_ - lo_); const u32x4 w = rw[i + LEFT];
        u32x4 o; o.x = cvt_pk_bf16(S8[0] * inv - bf_lo(w.x), S8[1] * inv - bf_hi(w.x)); o.y = cvt_pk_bf16(S8[2] * inv - bf_lo(w.y), S8[3] * inv - bf_hi(w.y));
        o.z = cvt_pk_bf16(S8[4] * inv - bf_lo(w.z), S8[5] * inv - bf_hi(w.z)); o.w = cvt_pk_bf16(S8[6] * inv - bf_lo(w.w), S8[7] * inv - bf_hi(w.w));
        *(u32x4*)(Pb + (size_t)t * DM) = o;
        if (i < 7) { ACC8(rw[i + WIN], +); ACC8(rw[i], -); } }
#undef ACC8
}

__global__ void __launch_bounds__(NWAVES * 64, 2) mk_fwd(Args args) {
    extern __shared__ __attribute__((aligned(16))) unsigned char lds[];
    cg::grid_group grid = cg::this_grid();
    Frame F;
    F.lds = (LAS unsigned char*)lds;
    F.tid = threadIdx.x; F.lane = F.tid & 63; F.wave = __builtin_amdgcn_readfirstlane(F.tid >> 6);
    F.G = gridDim.x; F.gw = blockIdx.x * NWAVES + F.wave; F.NGW = F.G * NWAVES; F.ws = args.ws;
    unsigned char* ws = args.ws;
    const int lo = args.ph_lo, hi = args.ph_hi;
#ifndef PHASE_MASK
#define PHASE_MASK 0xFFF
#endif
#define IN(k) (((PHASE_MASK >> (k)) & 1) && lo <= (k) && (k) < hi)
#ifndef DBL_MASK
#define DBL_MASK 0
#endif

#define SEAM(k) do { if (IN(k) && IN((k) + 1)) xcd_barrier(bar); } while (0)
    if (args.ph_hi > 4096) grid.sync();
    volatile LAS unsigned* MISC = (volatile LAS unsigned*)(F.lds + MISC_OFF);
    if (F.tid < 16) MISC[F.tid] = 0u;
    __syncthreads();
    XcdBarrier bar; bar.bar = (unsigned*)(args.ws + WS_BAR); bar.x = 0; bar.st = MISC;
    if (hi - lo > 1) bar = xcd_barrier_post((unsigned*)(args.ws + WS_BAR), MISC);
    const float* x = args.in[0]; const float* c = args.in[1]; const float* ctx = args.in[2]; const float* c_ctx = args.in[3];
    const float* ada_w = args.in[4]; const float* ada_b = args.in[5]; const float* pre_norm = args.in[6]; const float* post_norm = args.in[7];
    float* mod = (float*)(ws + WS_MOD); float* ssq = (float*)(ws + WS_SSQ); f32x2* tab = (f32x2*)(ws + WS_TAB);
    bf16_t* WIN = (bf16_t*)(ws + WS_WIN); bf16_t* WG = (bf16_t*)(ws + WS_WG); bf16_t* WOUT = (bf16_t*)(ws + WS_WOUT); bf16_t* WMLA = (bf16_t*)(ws + WS_WMLA);
    bf16_t* WUQ = (bf16_t*)(ws + WS_WUQ); bf16_t* WUKV = (bf16_t*)(ws + WS_WUKV); bf16_t* WMO = (bf16_t*)(ws + WS_WMO);
    bf16_t* H = (bf16_t*)(ws + WS_H); bf16_t* SG = (bf16_t*)(ws + WS_SG); bf16_t* Z = (bf16_t*)(ws + WS_Z); bf16_t* Y = (bf16_t*)(ws + WS_Y);
    bf16_t* U = (bf16_t*)(ws + WS_U); bf16_t* P = (bf16_t*)(ws + WS_P); bf16_t* Q = (bf16_t*)(ws + WS_Q); bf16_t* CQ = (bf16_t*)(ws + WS_CQ);
    bf16_t* CKV = (bf16_t*)(ws + WS_CKV); bf16_t* KR = (bf16_t*)(ws + WS_KR); bf16_t* KN = (bf16_t*)(ws + WS_KN); bf16_t* V = (bf16_t*)(ws + WS_V);
    const int NTHR = F.G * NWAVES * 64;
#define FRESH() int gtid; do { int t_ = threadIdx.x; asm volatile("" : "+v"(t_)); F.tid = t_; F.lane = t_ & 63; gtid = blockIdx.x * (NWAVES * 64) + t_; (void)gtid; } while (0)

    if (IN(0)) { FRESH();
        LAS float* scr = (LAS float*)(F.lds + F.wave * 16384);
        constexpr int I_GEMV = 2 * 32 * 24;
        if (F.G == 256) {
            if (F.wave < 3) gemv_item(c, c_ctx, ada_w, ada_b, mod, (int)blockIdx.x * 3 + F.wave, F.lane);
            const int b0 = (int)blockIdx.x * 26 + (F.wave < 3 ? F.wave * 2 : 6 + (F.wave - 3) * 4);
            tr_run(args, 0, b0, 1, F.lane, scr, b0 + (F.wave < 3 ? 2 : 4));
        } else {
            for (int it = F.gw; it < I_GEMV; it += F.NGW) gemv_item(c, c_ctx, ada_w, ada_b, mod, it, F.lane);
            tr_run(args, 0, F.gw, F.NGW, F.lane, scr); tr_run(args, 1, F.gw, F.NGW, F.lane, scr); tr_run(args, 2, F.gw, F.NGW, F.lane, scr);
        }
        for (int i = gtid; i < (NMLA - 3136) * DM / 8; i += NTHR) *(u32x4*)(WMLA + (size_t)3136 * DM + (size_t)i * 8) = (u32x4){0u, 0u, 0u, 0u};
        if (gtid < 1024) { const int pos = gtid >> 4, i = gtid & 15; const float fr = powf(10000.f, -(float)i / 16.f); const float ang = (float)pos * fr; float sn, cs; sincosf(ang, &sn, &cs); tab[gtid] = (f32x2){cs, sn}; }
    }
    SEAM(0);
    if (IN(1)) { FRESH();
        for (int row0 = F.gw * 3; row0 < MT; row0 += F.NGW * 3) {
            f32x4 v[3][8];
#pragma unroll
            for (int q = 0; q < 3; ++q) { const int row = row0 + q; const float* src = row < ML ? x + (size_t)row * DM : ctx + (size_t)(row - ML) * DM; load_row_f32(src, F.lane, v[q]); }
#pragma unroll
            for (int q = 0; q < 3; ++q) { const int row = row0 + q; const int r = row < ML ? row / SEQ : 8;
                const float rstd = __builtin_amdgcn_rsqf(sumsq8(v[q]) * (1.f / DM) + EPS);
                modulate_store(v[q], rstd, pre_norm, mod + (size_t)r * 6144, H + (size_t)row * DM, F.lane); }
        }
    }
    SEAM(1);
    if (IN(2)) {
        pg8::Gemm g{H, WIN, MT, 4096, DM, DM, DM, 0}; pg8::StaticOrder S; S.init(MT, 4096, F.G, (int)blockIdx.x);
        pg8::EpiPoolIn E{U, SG};
        pg8::gemm_phase<pg8::EpiPoolIn>(F.lds, g, S, E);
        if (F.G == 256 && (int)blockIdx.x >= 128)
            tr_run(args, 1, ((int)blockIdx.x - 128) * NWAVES + F.wave, 128 * NWAVES, threadIdx.x & 63, (LAS float*)(F.lds + F.wave * 16384));
    }
    SEAM(2);
    if (IN(3)) { FRESH();
        for (int item = gtid; item < (MT / 8) * 256; item += NTHR) {
            const int cc = item & 255, row0 = (item >> 8) * 8;
            int base, L; if (row0 < ML) { base = row0 & ~(SEQ - 1); L = SEQ; } else { base = ML + ((row0 - ML) & ~(CTXL - 1)); L = CTXL; }
            const int t0 = row0 - base, gidx = cc >> 6;
            const bf16_t* Ub = U + (size_t)base * DM + cc * 8; bf16_t* Pb = P + (size_t)base * DM + cc * 8;
            switch (gidx) {
                case 0: pool_chunk<2>(Ub, Pb, t0, L); break;
                case 1: pool_chunk<4>(Ub, Pb, t0, L); break;
                case 2: pool_chunk<8>(Ub, Pb, t0, L); break;
                default: pool_chunk<16>(Ub, Pb, t0, L); break;
            }
        }
    }
    SEAM(3);
    if (IN(4)) {
        pg8::Gemm g{P, WG, MT, DM, 512, DM, 512, 2}; pg8::StaticOrder S; S.init(MT, DM, F.G, (int)blockIdx.x);
        pg8::EpiGrp E{SG, Z, args.in[10], args.in[11]};
        pg8::gemm_phase<pg8::EpiGrp>(F.lds, g, S, E);
    }
    SEAM(4);
    if (IN(5)) {
        pg8::Gemm g{Z, WOUT, MT, DM, DM, DM, DM, 0}; pg8::StaticOrder S; S.init(MT, DM, F.G, (int)blockIdx.x);
        pg8::EpiPlain E{Y, DM};
        pg8::gemm_phase<pg8::EpiPlain>(F.lds, g, S, E);
        if (F.G == 256 && (int)blockIdx.x >= 64) {
            const int lb = (int)blockIdx.x - 64;
            if (F.wave < 4) gemv_item(c, c_ctx, ada_w, ada_b, mod, 768 + lb * 4 + F.wave, threadIdx.x & 63);
            else tr_run(args, 2, lb * 4 + (F.wave - 4), 192 * 4, threadIdx.x & 63, (LAS float*)(F.lds + F.wave * 16384));
        }
    }
    SEAM(5);
    if (IN(6)) { FRESH();
        for (int row0 = F.gw * 3; row0 < MT; row0 += F.NGW * 3) {
            f32x4 v[3][8]; u32x2 yw[3][8];
#pragma unroll
            for (int q = 0; q < 3; ++q) { const int row = row0 + q; const float* src = row < ML ? x + (size_t)row * DM : ctx + (size_t)(row - ML) * DM; load_row_f32(src, F.lane, v[q]);
                const bf16_t* yr = Y + (size_t)row * DM;
#pragma unroll
                for (int j = 0; j < 8; ++j) yw[q][j] = *(const u32x2*)(yr + 4 * F.lane + 256 * j); }
#pragma unroll
            for (int q = 0; q < 3; ++q) { const int row = row0 + q; const bool lat = row < ML; const int r = lat ? row / SEQ : 8;
                float sy = 0.f;
#pragma unroll
                for (int j = 0; j < 8; ++j) { const float a = bf_lo(yw[q][j].x), b = bf_hi(yw[q][j].x), c2 = bf_lo(yw[q][j].y), d = bf_hi(yw[q][j].y); sy += (a * a + b * b) + (c2 * c2 + d * d); }
                const float rsy = __builtin_amdgcn_rsqf(wave_sum(sy) * (1.f / DM) + EPS);
                const float* m0 = mod + (size_t)r * 6144;
#pragma unroll
                for (int j = 0; j < 8; ++j) { const int col = 4 * F.lane + 256 * j; const f32x4 gt = *(const f32x4*)(m0 + 2 * DM + col), pn = *(const f32x4*)(post_norm + col);
                    const f32x4 y4 = (f32x4){bf_lo(yw[q][j].x), bf_hi(yw[q][j].x), bf_lo(yw[q][j].y), bf_hi(yw[q][j].y)};
                    v[q][j] = v[q][j] + gt * (y4 * rsy * pn);
                    if (lat) *(f32x4*)(args.out + (size_t)row * DM + col) = v[q][j]; }
                const float rstd = __builtin_amdgcn_rsqf(sumsq8(v[q]) * (1.f / DM) + EPS);
                modulate_store(v[q], rstd, pre_norm + DM, mod + (size_t)(9 + r) * 6144, H + (size_t)row * DM, F.lane); }
        }
    }
    SEAM(6);
    if (IN(7)) {
        pg8::Gemm g{H, WMLA, MT, NMLA, DM, DM, DM, 0}; pg8::StaticOrder S; S.init(MT, NMLA, F.G, (int)blockIdx.x);
        pg8::EpiMlaIn E{CQ, CKV, KR, SG, ssq, tab};
        pg8::gemm_phase<pg8::EpiMlaIn>(F.lds, g, S, E);
    }
    SEAM(7);
    if (IN(8)) {
        { pg8::Gemm g{CQ, WUQ, ML, 3072, 512, 512, 512, 0}; pg8::StaticOrder S; S.init(ML, 3072, F.G, (int)blockIdx.x);
          pg8::EpiQ E{Q, ssq, tab};
          pg8::gemm_phase<pg8::EpiQ>(F.lds, g, S, E); }
        { pg8::Gemm g{CKV, WUKV, MT, 4096, 512, 512, 512, 0}; pg8::StaticOrder S; S.init(MT, 4096, F.G, (int)blockIdx.x);
          pg8::EpiKV E{KN, V, ssq + MT};
          pg8::gemm_phase<pg8::EpiKV>(F.lds, g, S, E); }
    }
    SEAM(8);
    if (IN(9)) {
        const int bx = blockIdx.x, vcu = (F.G % 8 == 0) ? (bx % 8) * (F.G / 8) + bx / 8 : bx;
        att::attn_phase(Q, KN, KR, V, SG, Z, vcu, F.G, (char*)lds, F.lds);
    }
    SEAM(9);
    if (IN(10)) {
        pg8::Gemm g{Z, WMO, ML, DM, DM, DM, DM, 0}; pg8::StaticOrder S; S.init(ML, DM, F.G, (int)blockIdx.x);
        pg8::EpiPlain E{Y, DM};
        pg8::gemm_phase<pg8::EpiPlain>(F.lds, g, S, E);
    }
    SEAM(10);
    if (IN(11)) { FRESH();
        const int per = (ML + F.NGW - 1) / F.NGW, per2 = (per + 1) & ~1, rbeg = F.gw * per2;
        int rcur = -1; f32x4 PA[8];
        for (int row0 = rbeg; row0 < rbeg + per2 && row0 < ML; row0 += 2) {
            f32x4 v[2][8]; u32x2 yw[2][8];
#pragma unroll
            for (int q = 0; q < 2; ++q) { const int row = row0 + q; load_row_f32(args.out + (size_t)row * DM, F.lane, v[q]);
                const bf16_t* yr = Y + (size_t)row * DM;
#pragma unroll
                for (int j = 0; j < 8; ++j) yw[q][j] = *(const u32x2*)(yr + 4 * F.lane + 256 * j); }
#pragma unroll
            for (int q = 0; q < 2; ++q) { const int row = row0 + q; const int r = row / SEQ;
                if (r != rcur) { const float* m1 = mod + (size_t)(9 + r) * 6144; rcur = r;
#pragma unroll
                    for (int j = 0; j < 8; ++j) { const int col = 4 * F.lane + 256 * j; PA[j] = *(const f32x4*)(m1 + 2 * DM + col) * *(const f32x4*)(post_norm + DM + col); } }
                float sy = 0.f;
#pragma unroll
                for (int j = 0; j < 8; ++j) { const float a = bf_lo(yw[q][j].x), b = bf_hi(yw[q][j].x), c2 = bf_lo(yw[q][j].y), d = bf_hi(yw[q][j].y); sy += (a * a + b * b) + (c2 * c2 + d * d); }
                const float rsy = __builtin_amdgcn_rsqf(wave_sum(sy) * (1.f / DM) + EPS);
#pragma unroll
                for (int j = 0; j < 8; ++j) { const int col = 4 * F.lane + 256 * j;
                    const f32x4 y4 = (f32x4){bf_lo(yw[q][j].x), bf_hi(yw[q][j].x), bf_lo(yw[q][j].y), bf_hi(yw[q][j].y)};
                    *(f32x4*)(args.out + (size_t)row * DM + col) = v[q][j] + PA[j] * (y4 * rsy); }
            }
        }
    }
#undef IN
#undef SEAM
}

extern "C" void kernel_launch(void* const* d_in, const int* in_sizes, int n_in, void* d_out, int out_size, void* d_ws, size_t ws_size, hipStream_t stream) {
    static int grid = 0;
    if (grid == 0) {
        if (n_in != 19 || out_size != ML * DM || ws_size < WS_END) { fprintf(stderr, "kernel_launch: unexpected shapes (n_in %d out %d ws %zu)\n", n_in, out_size, ws_size); grid = -1; return; }
        int dev = 0, cus = 0, per_cu = 0;
        hipGetDevice(&dev); hipDeviceGetAttribute(&cus, hipDeviceAttributeMultiprocessorCount, dev);
        if (hipFuncSetAttribute((const void*)mk_fwd, hipFuncAttributeMaxDynamicSharedMemorySize, LDS_BYTES) != hipSuccess) { fprintf(stderr, "kernel_launch: hipFuncSetAttribute failed\n"); grid = -1; return; }
        hipOccupancyMaxActiveBlocksPerMultiprocessor(&per_cu, (const void*)mk_fwd, NWAVES * 64, LDS_BYTES);
        (void)hipGetLastError();
        if (per_cu < 1) per_cu = 1;
        grid = cus * 1;
        (void)per_cu;
    }
    if (grid < 0) return;
    hipMemsetAsync((char*)d_ws, 0, CTL_ZERO_BYTES, stream);
    Args a{};
    for (int i = 0; i < 19; ++i) a.in[i] = (const float*)d_in[i];
    a.out = (float*)d_out; a.ws = (unsigned char*)d_ws;
#if MK_N_LAUNCHES == 1
    a.ph_lo = 0; a.ph_hi = N_PHASES;
    void* kargs[] = {&a};
    hipError_t e = hipLaunchCooperativeKernel((const void*)mk_fwd, dim3(grid), dim3(NWAVES * 64), kargs, LDS_BYTES, stream);
    if (e != hipSuccess) fprintf(stderr, "cooperative launch failed: %s (grid %d)\n", hipGetErrorString(e), grid);
#else
    for (int p = 0; p < N_PHASES; ++p) for (int rep = 0; rep < (((DBL_MASK >> p) & 1) ? 2 : 1); ++rep) { a.ph_lo = p; a.ph_hi = p + 1; hipLaunchKernelGGL(mk_fwd, dim3(grid), dim3(NWAVES * 64), LDS_BYTES, stream, a); }
#endif
}
```
